# Optimizing an MI355X kernel written in HIP

```python
import math
import jax
import jax.numpy as jnp
from jax import lax
import numpy as np


D_MODEL = 1024
BATCH = 8
SEQ = 8192
DEPTH = 2

CHUNK = 64
Q_BLOCK = 128
MEM_LEN = 256
N_MIXERS = 2
ROPE_THETA = 500000.0
LN_EPS = 1e-5
DEEPNORM_ALPHA = (2.0 * DEPTH) ** 0.25
DEEPNORM_BETA = (8.0 * DEPTH) ** -0.25

DIFF_HEADS = 8
DIFF_HEAD_DIM = 64
DIFF_ROPE_DIM = DIFF_HEAD_DIM // 4

MLA_HEADS = 8
MLA_Q_RANK = 256
MLA_KV_RANK = 256
MLA_ROPE_DIM = 32
MLA_NOPE_DIM = 96
MLA_V_DIM = 128
IDX_HEADS = 16
IDX_DIM = 64
IDX_ROPE_DIM = IDX_DIM // 4
IDX_TOPK_MAX = 256

MEM_HEADS = 4
MEM_HEAD_DIM = D_MODEL // MEM_HEADS

N_GROUPS = 4
EXPERTS_PER_GROUP = 4
N_EXPERTS = N_GROUPS * EXPERTS_PER_GROUP
EXPERT_TOP_K = 2
EXPERT_FF = 512

N_DIFF_LAYERS = (DEPTH + 1) // 2
N_DSA_LAYERS = DEPTH // 2

kernel_name = "hybrid_diff_dsa_hmoe_deepnorm_encoder"


def layer_norm(x, g, b):
    xf = x.astype(jnp.float32)
    mu = jnp.mean(xf, axis=-1, keepdims=True)
    xc = xf - mu
    var = jnp.mean(xc * xc, axis=-1, keepdims=True)
    y = xc * lax.rsqrt(var + LN_EPS) * g.astype(jnp.float32) + b.astype(jnp.float32)
    return y.astype(x.dtype)


def rms_norm(x, g):
    xf = x.astype(jnp.float32)
    y = xf * lax.rsqrt(jnp.mean(xf * xf, axis=-1, keepdims=True) + LN_EPS) * g.astype(jnp.float32)
    return y.astype(x.dtype)


def rope_tables(positions, rot_dim):
    inv_freq = ROPE_THETA ** (-jnp.arange(0, rot_dim, 2, dtype=jnp.float32) / rot_dim)
    ang = positions.astype(jnp.float32)[..., None] * inv_freq
    return jnp.cos(ang), jnp.sin(ang)


def apply_partial_rope(x, cos, sin):
    half = cos.shape[-1]
    c = cos[:, :, None, :].astype(x.dtype)
    s = sin[:, :, None, :].astype(x.dtype)
    x1 = x[..., :half]
    x2 = x[..., half:2 * half]
    return jnp.concatenate([x1 * c - x2 * s, x2 * c + x1 * s, x[..., 2 * half:]], axis=-1)


def to_blocks(a, blk):
    b, s = a.shape[0], a.shape[1]
    return jnp.moveaxis(a.reshape((b, s // blk, blk) + a.shape[2:]), 1, 0)


def from_blocks(a):
    nb, b, blk = a.shape[0], a.shape[1], a.shape[2]
    return jnp.moveaxis(a, 0, 1).reshape((b, nb * blk) + a.shape[3:])


def diff_lambda_init(layer_idx):
    return 0.8 - 0.6 * math.exp(-0.3 * layer_idx)


def differential_attention(x, cos, sin, w_in, lam, subln_g, w_out, lambda_init):
    bsz, seq, _ = x.shape
    h, d = DIFF_HEADS, DIFF_HEAD_DIM
    q, k, v = jnp.split(x @ w_in, 3, axis=-1)
    q = apply_partial_rope(q.reshape(bsz, seq, 2 * h, d), cos, sin) * (d ** -0.5)
    k = apply_partial_rope(k.reshape(bsz, seq, 2 * h, d), cos, sin)
    q = q.reshape(bsz, seq, h, 2, d)
    k = k.reshape(bsz, seq, h, 2, d)
    v = v.reshape(bsz, seq, h, 2 * d)
    lamf = lam.astype(jnp.float32)
    lam_full = jnp.exp(jnp.sum(lamf[0] * lamf[1])) - jnp.exp(jnp.sum(lamf[2] * lamf[3])) + lambda_init
    key_chunk = jnp.arange(seq) // CHUNK

    def block(args):
        q_blk, blk_idx = args
        q_chunk = (blk_idx * Q_BLOCK + jnp.arange(Q_BLOCK)) // CHUNK
        allowed = key_chunk[None, :] <= q_chunk[:, None]
        s = jnp.einsum('bqhcd,bkhcd->bhcqk', q_blk, k).astype(jnp.float32)
        p = jax.nn.softmax(jnp.where(allowed, s, -jnp.inf), axis=-1)
        p_diff = p[:, :, 0] - lam_full * p[:, :, 1]
        return jnp.einsum('bhqk,bkhe->bqhe', p_diff.astype(v.dtype), v)

    o = from_blocks(lax.map(block, (to_blocks(q, Q_BLOCK), jnp.arange(seq // Q_BLOCK))))
    o = rms_norm(o, subln_g) * (1.0 - lambda_init)
    return o.reshape(bsz, seq, h * 2 * d) @ w_out


def dsa_sparse_mla(x, cos_r, sin_r, cos_i, sin_i, w_in, q_norm_g, kv_norm_g, w_uq, w_qidx, w_uk, w_uv, w_out):
    bsz, seq, _ = x.shape
    h = MLA_HEADS
    splits = [MLA_Q_RANK,
              MLA_Q_RANK + MLA_KV_RANK,
              MLA_Q_RANK + MLA_KV_RANK + MLA_ROPE_DIM,
              MLA_Q_RANK + MLA_KV_RANK + MLA_ROPE_DIM + IDX_DIM]
    c_q, c_kv, k_rope, k_idx, w_idx = jnp.split(x @ w_in, splits, axis=-1)
    c_q = rms_norm(c_q, q_norm_g)
    c_kv = rms_norm(c_kv, kv_norm_g)
    q = (c_q @ w_uq).reshape(bsz, seq, h, MLA_ROPE_DIM + MLA_NOPE_DIM)
    q_rope = apply_partial_rope(q[..., :MLA_ROPE_DIM], cos_r, sin_r)
    q_lat = jnp.einsum('bshn,hrn->bshr', q[..., MLA_ROPE_DIM:], w_uk)
    q_full = jnp.concatenate([q_lat, q_rope], axis=-1) * ((MLA_ROPE_DIM + MLA_NOPE_DIM) ** -0.5)
    k_rope = apply_partial_rope(k_rope[:, :, None, :], cos_r, sin_r)[:, :, 0]
    kv_lat = jnp.concatenate([c_kv, k_rope], axis=-1)
    q_idx = apply_partial_rope((c_q @ w_qidx).reshape(bsz, seq, IDX_HEADS, IDX_DIM), cos_i, sin_i)
    k_idx = apply_partial_rope(k_idx[:, :, None, :], cos_i, sin_i)[:, :, 0]
    w_idx = w_idx * ((IDX_HEADS * IDX_DIM) ** -0.5)
    top_k = min(IDX_TOPK_MAX, seq // 4)
    key_chunk = jnp.arange(seq) // CHUNK
    gather = jax.vmap(lambda table, idx: table[idx])

    def block(args):
        qf, qi, wi, chunk_idx = args
        logits = jnp.einsum('bqhd,bkd->bqhk', qi, k_idx)
        score = jnp.einsum('bqh,bqhk->bqk', wi, jax.nn.relu(logits)).astype(jnp.float32)
        score = jnp.where((key_chunk <= chunk_idx)[None, None, :], score, -jnp.inf)
        top_score, top_idx = lax.top_k(score, top_k)
        valid = jnp.isfinite(top_score)
        sel = gather(kv_lat, top_idx)
        s = jnp.einsum('bqhd,bqkd->bhqk', qf, sel).astype(jnp.float32)
        p = jax.nn.softmax(jnp.where(valid[:, None], s, -jnp.inf), axis=-1)
        return jnp.einsum('bhqk,bqkr->bqhr', p.astype(sel.dtype), sel[..., :MLA_KV_RANK])

    o_lat = from_blocks(lax.map(block, (to_blocks(q_full, CHUNK), to_blocks(q_idx, CHUNK),
                                        to_blocks(w_idx, CHUNK), jnp.arange(seq // CHUNK))))
    o = jnp.einsum('bshr,hrv->bshv', o_lat, w_uv).reshape(bsz, seq, h * MLA_V_DIM)
    return o @ w_out


def memory_cross_attention(x, mem_k, mem_v, w_q, w_out):
    bsz, seq, _ = x.shape
    q = (x @ w_q).reshape(bsz, seq, MEM_HEADS, MEM_HEAD_DIM) * (MEM_HEAD_DIM ** -0.5)
    s = jnp.einsum('bshd,bmhd->bhsm', q, mem_k).astype(jnp.float32)
    p = jax.nn.softmax(s, axis=-1)
    o = jnp.einsum('bhsm,bmhd->bshd', p.astype(mem_v.dtype), mem_v).reshape(bsz, seq, MEM_HEADS * MEM_HEAD_DIM)
    return o @ w_out


def hierarchical_moe(x, w_group, b_group, w_expert, b_expert, w_gate, w_up, w_down):
    bsz, seq, dm = x.shape
    n_tok = bsz * seq
    t = x.reshape(n_tok, dm)
    g_logits = (t @ w_group + b_group).astype(jnp.float32)
    g_sel = jnp.argmax(g_logits, axis=-1)
    g_gate = jnp.max(jax.nn.softmax(g_logits, axis=-1), axis=-1, keepdims=True)
    e_logits = (t @ w_expert + b_expert).astype(jnp.float32).reshape(n_tok, N_GROUPS, EXPERTS_PER_GROUP)
    e_logits = e_logits[jnp.arange(n_tok), g_sel]
    top_val, top_idx = lax.top_k(e_logits, EXPERT_TOP_K)
    top_w = jax.nn.softmax(top_val, axis=-1) * g_gate
    expert_id = g_sel[:, None] * EXPERTS_PER_GROUP + top_idx
    combine = jnp.sum(jax.nn.one_hot(expert_id, N_EXPERTS, dtype=jnp.float32) * top_w[..., None], axis=1).astype(t.dtype)
    y = jnp.zeros_like(t)
    for e in range(N_EXPERTS):
        hid = jax.nn.silu(t @ w_gate[e]) * (t @ w_up[e])
        y = y + combine[:, e:e + 1] * (hid @ w_down[e])
    return y.reshape(bsz, seq, dm)


def setup_inputs(seed: int = 0) -> dict:
    key = jax.random.key(seed)
    ks = iter(jax.random.split(key, 40))
    beta = DEEPNORM_BETA
    d = D_MODEL

    def nrm(shape, scale):
        return jax.random.normal(next(ks), shape, jnp.float32) * scale

    x = nrm((BATCH, SEQ, d), 1.0)
    mem = nrm((BATCH, MEM_LEN, d), 1.0)
    offsets = jax.random.randint(next(ks), (BATCH, 1), 0, 1024) * CHUNK
    positions = (offsets + jnp.arange(SEQ)[None, :]).astype(jnp.int32)

    diff_w = DIFF_HEADS * 2 * DIFF_HEAD_DIM
    a_w_in = jnp.concatenate([nrm((N_DIFF_LAYERS, d, 2 * diff_w), d ** -0.5),
                              nrm((N_DIFF_LAYERS, d, diff_w), beta * d ** -0.5)], axis=-1)
    a_lambda = nrm((N_DIFF_LAYERS, 4, DIFF_HEAD_DIM), 0.1)
    a_subln_g = 1.0 + nrm((N_DIFF_LAYERS, 2 * DIFF_HEAD_DIM), 0.02)
    a_w_out = nrm((N_DIFF_LAYERS, diff_w, d), beta * diff_w ** -0.5)

    b_in_w = MLA_Q_RANK + MLA_KV_RANK + MLA_ROPE_DIM + IDX_DIM + IDX_HEADS
    b_w_in = nrm((N_DSA_LAYERS, d, b_in_w), d ** -0.5)
    b_q_norm_g = 1.0 + nrm((N_DSA_LAYERS, MLA_Q_RANK), 0.02)
    b_kv_norm_g = 1.0 + nrm((N_DSA_LAYERS, MLA_KV_RANK), 0.02)
    b_w_uq = nrm((N_DSA_LAYERS, MLA_Q_RANK, MLA_HEADS * (MLA_ROPE_DIM + MLA_NOPE_DIM)), MLA_Q_RANK ** -0.5)
    b_w_qidx = nrm((N_DSA_LAYERS, MLA_Q_RANK, IDX_HEADS * IDX_DIM), MLA_Q_RANK ** -0.5)
    b_w_uk = nrm((N_DSA_LAYERS, MLA_HEADS, MLA_KV_RANK, MLA_NOPE_DIM), MLA_KV_RANK ** -0.5)
    b_w_uv = nrm((N_DSA_LAYERS, MLA_HEADS, MLA_KV_RANK, MLA_V_DIM), beta * MLA_KV_RANK ** -0.5)
    b_w_out = nrm((N_DSA_LAYERS, MLA_HEADS * MLA_V_DIM, d), beta * (MLA_HEADS * MLA_V_DIM) ** -0.5)

    mem_w = MEM_HEADS * MEM_HEAD_DIM
    mem_w_kv = jnp.concatenate([nrm((d, mem_w), d ** -0.5), nrm((d, mem_w), beta * d ** -0.5)], axis=-1)
    xa_w_q = nrm((DEPTH, d, mem_w), d ** -0.5)
    xa_w_out = nrm((DEPTH, mem_w, d), beta * mem_w ** -0.5)

    moe_w_group = nrm((DEPTH, d, N_GROUPS), d ** -0.5)
    moe_b_group = nrm((DEPTH, N_GROUPS), 0.01)
    moe_w_expert = nrm((DEPTH, d, N_EXPERTS), d ** -0.5)
    moe_b_expert = nrm((DEPTH, N_EXPERTS), 0.01)
    moe_w_gate = nrm((DEPTH, N_EXPERTS, d, EXPERT_FF), d ** -0.5)
    moe_w_up = nrm((DEPTH, N_EXPERTS, d, EXPERT_FF), beta * d ** -0.5)
    moe_w_down = nrm((DEPTH, N_EXPERTS, EXPERT_FF, d), beta * EXPERT_FF ** -0.5)

    ln_g = 1.0 + nrm((DEPTH, 3, d), 0.02)
    ln_b = nrm((DEPTH, 3, d), 0.02)

    return {"x": x, "mem": mem, "positions": positions,
            "a_w_in": a_w_in, "a_lambda": a_lambda, "a_subln_g": a_subln_g, "a_w_out": a_w_out,
            "b_w_in": b_w_in, "b_q_norm_g": b_q_norm_g, "b_kv_norm_g": b_kv_norm_g,
            "b_w_uq": b_w_uq, "b_w_qidx": b_w_qidx, "b_w_uk": b_w_uk, "b_w_uv": b_w_uv, "b_w_out": b_w_out,
            "mem_w_kv": mem_w_kv, "xa_w_q": xa_w_q, "xa_w_out": xa_w_out,
            "moe_w_group": moe_w_group, "moe_b_group": moe_b_group,
            "moe_w_expert": moe_w_expert, "moe_b_expert": moe_b_expert,
            "moe_w_gate": moe_w_gate, "moe_w_up": moe_w_up, "moe_w_down": moe_w_down,
            "ln_g": ln_g, "ln_b": ln_b}


def reference(x, mem, positions, a_w_in, a_lambda, a_subln_g, a_w_out,
              b_w_in, b_q_norm_g, b_kv_norm_g, b_w_uq, b_w_qidx, b_w_uk, b_w_uv, b_w_out,
              mem_w_kv, xa_w_q, xa_w_out,
              moe_w_group, moe_b_group, moe_w_expert, moe_b_expert, moe_w_gate, moe_w_up, moe_w_down,
              ln_g, ln_b):
    bsz = x.shape[0]
    n_mem = mem.shape[1]
    cos_d, sin_d = rope_tables(positions, DIFF_ROPE_DIM)
    cos_r, sin_r = rope_tables(positions, MLA_ROPE_DIM)
    cos_i, sin_i = rope_tables(positions, IDX_ROPE_DIM)
    mem_k, mem_v = jnp.split(mem @ mem_w_kv, 2, axis=-1)
    mem_k = mem_k.reshape(bsz, n_mem, MEM_HEADS, MEM_HEAD_DIM)
    mem_v = mem_v.reshape(bsz, n_mem, MEM_HEADS, MEM_HEAD_DIM)
    alpha = DEEPNORM_ALPHA
    h = x
    for i in range(DEPTH):
        j = i // N_MIXERS
        if i % N_MIXERS == 0:
            mix = differential_attention(h, cos_d, sin_d, a_w_in[j], a_lambda[j], a_subln_g[j], a_w_out[j],
                                         diff_lambda_init(i))
        else:
            mix = dsa_sparse_mla(h, cos_r, sin_r, cos_i, sin_i, b_w_in[j], b_q_norm_g[j], b_kv_norm_g[j],
                                 b_w_uq[j], b_w_qidx[j], b_w_uk[j], b_w_uv[j], b_w_out[j])
        h = layer_norm(alpha * h + mix, ln_g[i, 0], ln_b[i, 0])
        h = layer_norm(alpha * h + memory_cross_attention(h, mem_k, mem_v, xa_w_q[i], xa_w_out[i]),
                       ln_g[i, 1], ln_b[i, 1])
        h = layer_norm(alpha * h + hierarchical_moe(h, moe_w_group[i], moe_b_group[i], moe_w_expert[i],
                                                    moe_b_expert[i], moe_w_gate[i], moe_w_up[i], moe_w_down[i]),
                       ln_g[i, 2], ln_b[i, 2])
    return h
```

```cpp
#include <hip/hip_runtime.h>
#include <cstdio>
#include <cstdint>

#ifndef MK_PER_PHASE
#define MK_PER_PHASE 0
#endif
#ifndef MK_DBG
#define MK_DBG 0
#endif

#define GAS __attribute__((address_space(1)))
#define LAS __attribute__((address_space(3)))
typedef unsigned short bf16;
typedef unsigned v4u __attribute__((ext_vector_type(4)));
typedef unsigned v2u __attribute__((ext_vector_type(2)));
typedef int v4i __attribute__((ext_vector_type(4)));
typedef float f32x4 __attribute__((ext_vector_type(4)));
typedef float f32x2 __attribute__((ext_vector_type(2)));
typedef float f32x16 __attribute__((ext_vector_type(16)));
typedef short bf16x8 __attribute__((ext_vector_type(8)));
typedef short s16x4 __attribute__((ext_vector_type(4)));
typedef GAS unsigned gu32;
#define RLX_AGENT __ATOMIC_RELAXED, __HIP_MEMORY_SCOPE_AGENT
#define LDS_WAIT() asm volatile("s_waitcnt lgkmcnt(0)" ::: "memory")
#define VM_WAIT() asm volatile("s_waitcnt vmcnt(0)" ::: "memory")
__device__ __forceinline__ unsigned pk2(float lo, float hi) { unsigned r; asm("v_cvt_pk_bf16_f32 %0, %1, %2" : "=v"(r) : "v"(lo), "v"(hi)); return r; }
__device__ __forceinline__ unsigned f2bf(float f) { return pk2(f, 0.f) & 0xffffu; }
__device__ __forceinline__ float bf2f(unsigned short b) { return __builtin_bit_cast(float, (unsigned)b << 16); }
__device__ __forceinline__ float bflo(unsigned w) { return __builtin_bit_cast(float, w << 16); }
__device__ __forceinline__ float bfhi(unsigned w) { return __builtin_bit_cast(float, w & 0xffff0000u); }
__device__ __forceinline__ float dpp_f(float old, float x, const int ctrl, const int rmask) {
    switch (ctrl) {
        case 0xB1: return __builtin_bit_cast(float, __builtin_amdgcn_update_dpp(__builtin_bit_cast(int, old), __builtin_bit_cast(int, x), 0xB1, 0xf, 0xf, false));
        case 0x4E: return __builtin_bit_cast(float, __builtin_amdgcn_update_dpp(__builtin_bit_cast(int, old), __builtin_bit_cast(int, x), 0x4E, 0xf, 0xf, false));
        case 0x141: return __builtin_bit_cast(float, __builtin_amdgcn_update_dpp(__builtin_bit_cast(int, old), __builtin_bit_cast(int, x), 0x141, 0xf, 0xf, false));
        case 0x140: return __builtin_bit_cast(float, __builtin_amdgcn_update_dpp(__builtin_bit_cast(int, old), __builtin_bit_cast(int, x), 0x140, 0xf, 0xf, false));
        case 0x142: return __builtin_bit_cast(float, __builtin_amdgcn_update_dpp(__builtin_bit_cast(int, old), __builtin_bit_cast(int, x), 0x142, 0xa, 0xf, false));
        default: return __builtin_bit_cast(float, __builtin_amdgcn_update_dpp(__builtin_bit_cast(int, old), __builtin_bit_cast(int, x), 0x143, 0xc, 0xf, false));
    }
    (void)rmask;
}
__device__ __forceinline__ float wave_sum(float v) {
    v += dpp_f(v, v, 0xB1, 0xf);
    v += dpp_f(v, v, 0x4E, 0xf);
    v += dpp_f(v, v, 0x141, 0xf);
    v += dpp_f(v, v, 0x140, 0xf);
    v += dpp_f(0.f, v, 0x142, 0xa);
    v += dpp_f(0.f, v, 0x143, 0xc);
    return __builtin_bit_cast(float, __builtin_amdgcn_readlane(__builtin_bit_cast(int, v), 63));
}

constexpr int NB = 8, SEQ = 8192, D = 1024, T = NB * SEQ;
constexpr int MEML = 256, MEMROWS = NB * MEML;
constexpr int NEXP = 16, FF = 512;
constexpr int BIN_W = 624, BIN_LD = 768;
constexpr int KVW = 288;
constexpr int TOPK = 256;
constexpr float LN_EPS = 1e-5f;
constexpr float ALPHA = 1.41421356237309515f;
constexpr float LOG2E = 1.4426950408889634f;
constexpr float C2 = 0.125f * LOG2E;
constexpr float SC2 = 0.08838834764831845f * LOG2E;
constexpr float XQS = 0.0625f * LOG2E;
constexpr int MOE_ROWS = 2 * T + NEXP * 256;
constexpr int MOE_TILES = MOE_ROWS / 256;

constexpr size_t MiB = 1u << 20;
constexpr size_t WS_CTL = 0, CTL_ZERO_BYTES = 1 * MiB;
constexpr size_t WS_SMALL = 1 * MiB;
constexpr size_t WS_ROT16 = 2 * MiB;
constexpr size_t WS_ROT32 = 6 * MiB;
constexpr size_t WS_W = 16 * MiB;
constexpr size_t W_QKV = WS_W;
constexpr size_t W_O = W_QKV + 6 * MiB;
constexpr size_t W_MKV = W_O + 2 * MiB;
constexpr size_t W_XQ = W_MKV + 4 * MiB;
constexpr size_t W_XO = W_XQ + 4 * MiB;
constexpr size_t W_BIN = W_XO + 4 * MiB;
constexpr size_t W_Q2 = W_BIN + 2 * MiB;
constexpr size_t W_UVO = W_Q2 + 2 * MiB;
constexpr size_t W_GU = W_UVO + 4 * MiB;
constexpr size_t W_DN = W_GU + 64 * MiB;
constexpr size_t WS_W_END = W_DN + 32 * MiB;
constexpr size_t WS_PREB = 144 * MiB;
constexpr size_t WS_STAT = 272 * MiB;
constexpr size_t WS_MISC = 288 * MiB;
constexpr size_t WS_STATF = WS_MISC;
constexpr size_t WS_ROUTE = WS_STATF + T * 8;
constexpr size_t WS_ROUTEW = WS_ROUTE + (size_t)T * 16;
constexpr size_t WS_POS2 = WS_ROUTEW + (size_t)T * 8;
constexpr size_t WS_ROWIDX = WS_POS2 + (size_t)T * 8;
constexpr size_t WS_WSORT = WS_ROWIDX + (size_t)MOE_ROWS * 4;
constexpr size_t WS_TILEE = WS_WSORT + (size_t)MOE_ROWS * 4;
constexpr size_t WS_WGB = WS_TILEE + 4096;
constexpr size_t WS_MK = 292 * MiB;
constexpr size_t WS_MVT = 296 * MiB;
constexpr size_t WS_MEMB = 300 * MiB;
constexpr size_t WS_BIG = 304 * MiB;
constexpr size_t S_XB = WS_PREB, S_O0 = WS_BIG;
constexpr size_t S_Q = WS_BIG + 128 * MiB, S_ON = S_Q;
constexpr size_t S_K = WS_BIG + 256 * MiB, S_V = WS_BIG + 384 * MiB, S_O1 = WS_BIG + 512 * MiB;
constexpr size_t S_QX = WS_BIG, S_P = WS_BIG + 128 * MiB, S_OX = WS_BIG + 256 * MiB;
constexpr size_t S_XH = WS_BIG, S_HID = WS_BIG + 128 * MiB, S_Y = WS_BIG + 264 * MiB;
constexpr size_t S_KVL = WS_BIG;
constexpr size_t S_KIDX = S_KVL + 36 * MiB;
constexpr size_t S_WIDX = S_KIDX + 8 * MiB;
constexpr size_t S_IDX = S_WIDX + 4 * MiB;
constexpr size_t S_CQ = S_IDX + 32 * MiB;
constexpr size_t S_QF = S_CQ + 32 * MiB;
constexpr size_t S_SC = S_QF;
constexpr size_t S_QI = S_SC + 256 * MiB;
constexpr size_t S_OL = S_QF + 288 * MiB;
constexpr size_t S_BIN = S_QI + 128 * MiB;
constexpr size_t S_WQK = WS_BIG + 688 * MiB;
constexpr size_t S_WVO = WS_BIG + 704 * MiB;
constexpr size_t WS_END = WS_BIG + 720 * MiB;
static_assert(WS_W_END <= WS_PREB && (MOE_TILES + 16) * 4 <= 4096 && WS_WGB + 256 * 16 * 4 <= WS_MK, "ws map");
static_assert(S_BIN + (size_t)T * BIN_LD * 4 <= WS_END && S_OL + (size_t)T * 2048 * 2 <= WS_END && S_Y + (size_t)MOE_ROWS * 1024 * 2 <= WS_END && S_O1 + 128 * MiB <= WS_END, "ws map");
static_assert(S_HID + (size_t)MOE_ROWS * 512 * 2 <= S_Y && S_QF + (size_t)T * 8 * KVW * 2 <= S_OL && WS_END == 1024 * MiB, "ws map");
constexpr int SM_LAM = 0;
constexpr int SM_GW = 64;
constexpr int SM_GWB = 8192;
constexpr int CW_BAR = 4096;
constexpr int CW_CNT = 8192;
constexpr int CW_ERR = 16384;

constexpr int RING_OFF = 0, RING_BYTES = 131072;
constexpr int XCH_OFF = RING_BYTES;
constexpr int MISC_OFF = 160 * 1024 - 256;
constexpr int LDS_BYTES = 160 * 1024;
constexpr int NWAVES = 8;
namespace pg8 {
#define PG8_LAS __attribute__((address_space(3)))
typedef unsigned short bf16_t;
constexpr int BM = 256, BK = 64, HALF = 128, HTB = HALF * BK * 2  , STAGE_BYTES = 8 * HTB, NXCD = 8, WGM = 8;

__host__ __device__ __forceinline__ int lds_byte(int r, int c) { const int st = (r >> 4) * 2 + (c >> 5), rr = r & 15, cc = c & 31, ob = rr * 64 + cc * 2; return st * 1024 + (ob ^ (((ob >> 9) & 1) << 5)); }
__host__ __device__ __forceinline__ void stage_rc(int b, int& R, int& C) { const int st = b / 1024, sb = b % 1024, swz = sb ^ (((sb >> 9) & 1) << 5); R = (st >> 1) * 16 + swz / 64; C = (st & 1) * 32 + (swz % 64) / 2; }
__host__ __device__ __forceinline__ int perm32(int rho) { const int n = rho >> 4, i = rho & 15; return 8 * (i >> 2) + 4 * n + (i & 3); }

struct Unit { int pm, pn, e; long aoff, boff; };
struct Gemm { const bf16_t* A; const bf16_t* Bt; int lda, ldb, K; const int* gidx; };

struct StaticOrder {
    int nM, nN, nwg, G, c; long tsA, tsB;
    __device__ void init(int M, int N, int lda, int ldb, int G_, int c_) { nM = M / BM; nN = N / BM; nwg = nM * nN; G = G_; c = c_; tsA = (long)BM * lda * 2; tsB = (long)BM * ldb * 2; }
    __device__ bool next(int i, Unit& u) const {
        const long L = (long)i * G + c; if (L >= nwg) return false;
        int wgid = (int)L; { const int q = nwg / NXCD, r = nwg % NXCD, xcd = wgid % NXCD, off = wgid / NXCD; wgid = (xcd < r ? xcd * (q + 1) : r * (q + 1) + (xcd - r) * q) + off; }
        const int nig = WGM * nN, gid = wgid / nig, fm = gid * WGM, gsz = (nM - fm) < WGM ? (nM - fm) : WGM;
        u.pm = fm + ((wgid % nig) % gsz); u.pn = (wgid % nig) / gsz; u.e = 0; u.aoff = u.pm * tsA; u.boff = u.pn * tsB; return true;
    }
};

__device__ __forceinline__ unsigned cvt_pk_bf16(float lo, float hi) { unsigned r; asm volatile("v_cvt_pk_bf16_f32 %0, %1, %2" : "=v"(r) : "v"(lo), "v"(hi)); return r; }
typedef f32x4 Acc[2][2][4][2];

template <class Epi, class Sched, bool GATHER = false>
__device__ __forceinline__ void gemm_phase(PG8_LAS unsigned char* lds, const Gemm g, const Sched& S, const Epi& E, const int wid) {
    int lane_; asm volatile("v_mbcnt_lo_u32_b32 %0, -1, 0\n\tv_mbcnt_hi_u32_b32 %0, -1, %0" : "=v"(lane_));
    const int lane = lane_, tid = wid * 64 + lane, wr = wid >> 2, wc = wid & 3, fr = lane & 15, fq = lane >> 4;
    int Kq = g.K; asm volatile("" : "+s"(Kq));
    const int nt = Kq / BK;
    unsigned vA[2][2], nvA[2][2], voffB[2];
#pragma unroll
    for (int i = 0; i < 2; ++i) { int R, C; stage_rc(tid * 16 + i * 8192, R, C); const int Rb = Epi::PERM ? ((R & ~31) + perm32(R & 31)) : R;
        voffB[i] = (unsigned)(Rb * g.ldb + C) * 2u;
        vA[0][i] = (unsigned)(R * g.lda + C) * 2u; vA[1][i] = vA[0][i]; nvA[0][i] = vA[0][i]; nvA[1][i] = vA[0][i]; }
    const size_t hsA = GATHER ? (size_t)0 : (size_t)HALF * g.lda * 2;
    const size_t kstep = (size_t)(BK * 2);
    const size_t hstepB = (size_t)HALF * g.ldb * 2;
    const unsigned ldsw = (unsigned)wid * 1024u;
    const int aoff = lds_byte(wr * 64 + fr, fq * 8), boff = lds_byte(wc * 32 + fr, fq * 8);
#define PG8_SA(b, h) (((b) * 2 + (h)) * HTB)
#define PG8_SB(b, h) ((4 + (b) * 2 + (h)) * HTB)
#define PG8_STAGE(bufoff, gbase, voff) do { _Pragma("unroll") for (int _i = 0; _i < 2; ++_i) \
        __builtin_amdgcn_global_load_lds((const unsigned*)((const char*)(gbase) + (voff)[_i]), (PG8_LAS unsigned*)(lds + (bufoff) + ldsw + _i * 8192), 16, 0, 0); } while (0)
#define PG8_LDA(dst, b, h) do { _Pragma("unroll") for (int m = 0; m < 4; ++m) _Pragma("unroll") for (int k = 0; k < 2; ++k) dst[m][k] = *(const PG8_LAS bf16x8*)(lds + PG8_SA(b, h) + aoff + m * 2048 + k * 1024); } while (0)
#define PG8_LDB(dst, b, h) do { _Pragma("unroll") for (int n = 0; n < 2; ++n) _Pragma("unroll") for (int k = 0; k < 2; ++k) dst[n][k] = *(const PG8_LAS bf16x8*)(lds + PG8_SB(b, h) + boff + n * 2048 + k * 1024); } while (0)
#define PG8_MMA(ai, bj, At, Bt) do { __builtin_amdgcn_s_setprio(1); _Pragma("unroll") for (int m = 0; m < 4; ++m) _Pragma("unroll") for (int n = 0; n < 2; ++n) _Pragma("unroll") for (int k = 0; k < 2; ++k) \
        acc[ai][bj][m][n] = __builtin_amdgcn_mfma_f32_16x16x32_bf16(Bt[n][k], At[m][k], acc[ai][bj][m][n], 0, 0, 0); __builtin_amdgcn_s_setprio(0); } while (0)
#define PG8_WAIT_V(n) asm volatile("s_waitcnt vmcnt(" #n ")" ::: "memory")
#define PG8_WAIT_L(n) asm volatile("s_waitcnt lgkmcnt(" #n ")" ::: "memory")
#define PG8_BAR __builtin_amdgcn_s_barrier()
#define PG8_SCHED __builtin_amdgcn_sched_barrier(0)
#define PG8_GIDX(dst, u) do { if constexpr (GATHER) { int _t = tid; asm volatile("" : "+v"(_t)); _Pragma("unroll") for (int _i = 0; _i < 2; ++_i) { int _R, _C; stage_rc(_t * 16 + _i * 8192, _R, _C); \
        _Pragma("unroll") for (int _h = 0; _h < 2; ++_h) dst[_h][_i] = (unsigned)(g.gidx[(u).pm * BM + _h * HALF + _R] * g.lda + _C) * 2u; } } } while (0)
    int c_pm, c_pn, c_e, ui = 0; const char* cA; const char* cB;
    { Unit u0; if (!S.next(0, u0)) return; PG8_GIDX(vA, u0); c_pm = u0.pm; c_pn = u0.pn; c_e = u0.e; cA = (const char*)g.A + u0.aoff; cB = (const char*)g.Bt + u0.boff; }
    Acc acc;
#pragma unroll
    for (int a = 0; a < 2; ++a)
#pragma unroll
        for (int b = 0; b < 2; ++b)
#pragma unroll
            for (int m = 0; m < 4; ++m)
#pragma unroll
                for (int n = 0; n < 2; ++n) acc[a][b][m][n] = (f32x4){0.f, 0.f, 0.f, 0.f};
    bf16x8 At[4][2], B0[2][2], B1[2][2];
    PG8_STAGE(PG8_SB(0, 0), cB, voffB); PG8_STAGE(PG8_SB(0, 1), cB + hstepB, voffB); PG8_STAGE(PG8_SA(0, 0), cA, vA[0]); PG8_STAGE(PG8_SA(0, 1), cA + hsA, vA[GATHER ? 1 : 0]);
    if (wr == 1) PG8_BAR;
    PG8_WAIT_V(2); PG8_BAR;
    PG8_STAGE(PG8_SB(1, 0), cB + kstep, voffB); PG8_STAGE(PG8_SA(1, 0), cA + kstep, vA[0]); PG8_STAGE(PG8_SB(1, 1), cB + hstepB + kstep, voffB);
    PG8_WAIT_V(6); PG8_BAR;
    for (;;) {
        Unit nxt; const bool has_next = S.next(ui + 1, nxt);
        const char* nA = has_next ? (const char*)g.A + nxt.aoff : cA; const char* nB = has_next ? (const char*)g.Bt + nxt.boff : cB;
        if constexpr (GATHER) { if (has_next) { PG8_GIDX(nvA, nxt); } else { nvA[0][0] = vA[0][0]; nvA[0][1] = vA[0][1]; nvA[1][0] = vA[1][0]; nvA[1][1] = vA[1][1]; } }
#pragma unroll 1
        for (int t = 0; t < nt; t += 2) {
            const bool last = (t == nt - 2);
            const char* a1 = cA + (size_t)(t + 1) * kstep;
            const char* a2 = last ? nA : cA + (size_t)(t + 2) * kstep; const char* b2 = last ? nB : cB + (size_t)(t + 2) * kstep;
            const char* a3 = a2 + kstep; const char* b3 = b2 + kstep;
            unsigned w0[2], w1[2];
            if constexpr (GATHER) { w0[0] = last ? nvA[0][0] : vA[0][0]; w0[1] = last ? nvA[0][1] : vA[0][1]; w1[0] = last ? nvA[1][0] : vA[1][0]; w1[1] = last ? nvA[1][1] : vA[1][1]; }
            else { w0[0] = vA[0][0]; w0[1] = vA[0][1]; w1[0] = vA[0][0]; w1[1] = vA[0][1]; }
            PG8_LDB(B0, 0, 0); PG8_LDB(B1, 0, 1); PG8_SCHED; PG8_LDA(At, 0, 0); PG8_STAGE(PG8_SA(1, 1), a1 + hsA, vA[GATHER ? 1 : 0]);
            PG8_WAIT_V(8); PG8_WAIT_L(0); PG8_BAR; PG8_MMA(0, 0, At, B0); PG8_MMA(0, 1, At, B1); PG8_BAR; PG8_SCHED;
            PG8_LDA(At, 0, 1); PG8_STAGE(PG8_SB(0, 0), b2, voffB); PG8_STAGE(PG8_SB(0, 1), b2 + hstepB, voffB); PG8_STAGE(PG8_SA(0, 0), a2, w0);
            PG8_WAIT_V(8); PG8_WAIT_L(0); PG8_BAR; PG8_MMA(1, 0, At, B0); PG8_MMA(1, 1, At, B1); PG8_BAR; PG8_SCHED;
            PG8_LDB(B0, 1, 0); PG8_LDB(B1, 1, 1); PG8_SCHED; PG8_LDA(At, 1, 0); PG8_STAGE(PG8_SA(0, 1), a2 + hsA, w1);
            PG8_WAIT_V(8); PG8_WAIT_L(0); PG8_BAR; PG8_MMA(0, 0, At, B0); PG8_MMA(0, 1, At, B1); PG8_BAR; PG8_SCHED;
            PG8_LDA(At, 1, 1); PG8_STAGE(PG8_SB(1, 0), b3, voffB); PG8_STAGE(PG8_SB(1, 1), b3 + hstepB, voffB); PG8_STAGE(PG8_SA(1, 0), a3, w0);
            PG8_WAIT_V(8); PG8_WAIT_L(0); PG8_BAR; PG8_MMA(1, 0, At, B0); PG8_MMA(1, 1, At, B1); PG8_BAR; PG8_SCHED;
        }
        if (wr == 0) PG8_BAR;
        { Unit cu; cu.pm = c_pm; cu.pn = c_pn; cu.e = c_e; cu.aoff = 0; cu.boff = 0; E(acc, cu, wr, wc, fr, fq); }
        if (!has_next) break;
#pragma unroll
        for (int a = 0; a < 2; ++a)
#pragma unroll
            for (int b = 0; b < 2; ++b)
#pragma unroll
                for (int m = 0; m < 4; ++m)
#pragma unroll
                    for (int n = 0; n < 2; ++n) acc[a][b][m][n] = (f32x4){0.f, 0.f, 0.f, 0.f};
        c_pm = nxt.pm; c_pn = nxt.pn; c_e = nxt.e; cA = nA; cB = nB; ++ui;
        if constexpr (GATHER) { vA[0][0] = nvA[0][0]; vA[0][1] = nvA[0][1]; vA[1][0] = nvA[1][0]; vA[1][1] = nvA[1][1]; }
        if (wr == 1) PG8_BAR;
    }
    PG8_WAIT_V(0);
    PG8_BAR;
#undef PG8_SA
#undef PG8_SB
#undef PG8_STAGE
#undef PG8_LDA
#undef PG8_LDB
#undef PG8_MMA
#undef PG8_WAIT_V
#undef PG8_WAIT_L
#undef PG8_BAR
#undef PG8_SCHED
#undef PG8_GIDX
}
}
namespace epi {
using pg8::Acc; using pg8::Unit; using pg8::cvt_pk_bf16;
constexpr int HALF = 128;
__device__ __forceinline__ void row_stats(const float* stat, int row, int fq, float& mu, float& rstd) {
    const f32x4 a = *(const f32x4*)(stat + (size_t)row * 32 + fq * 8), b = *(const f32x4*)(stat + (size_t)row * 32 + fq * 8 + 4);
    float s1 = (a[0] + a[2]) + (b[0] + b[2]), s2 = (a[1] + a[3]) + (b[1] + b[3]);
    s1 += __shfl_xor(s1, 16); s1 += __shfl_xor(s1, 32); s2 += __shfl_xor(s2, 16); s2 += __shfl_xor(s2, 32);
    mu = s1 * (1.0f / 1024.0f); const float var = fmaxf(s2 * (1.0f / 1024.0f) - mu * mu, 0.f); rstd = 1.0f / sqrtf(var + LN_EPS);
}
__device__ __forceinline__ v4u pack8(const f32x4 v0, const f32x4 v1) { v4u w; w.x = cvt_pk_bf16(v0[0], v0[1]); w.y = cvt_pk_bf16(v0[2], v0[3]); w.z = cvt_pk_bf16(v1[0], v1[1]); w.w = cvt_pk_bf16(v1[2], v1[3]); return w; }

struct EpiBf16 {
    static constexpr bool PERM = true;
    bf16* out; int ldc;
    __device__ __forceinline__ void operator()(const Acc& acc, const Unit& u, int wr, int wc, int fr, int fq) const {
        const int row0 = u.pm * 256 + wr * 64 + fr, col0 = u.pn * 256 + wc * 32 + 8 * fq;
#pragma unroll
        for (int ai = 0; ai < 2; ++ai)
#pragma unroll
            for (int m = 0; m < 4; ++m) { bf16* rowp = out + (size_t)(row0 + ai * HALF + m * 16) * ldc + col0;
#pragma unroll
                for (int bj = 0; bj < 2; ++bj) *(v4u*)(rowp + bj * HALF) = pack8(acc[ai][bj][m][0], acc[ai][bj][m][1]); }
    }
};

struct EpiMem {
    static constexpr bool PERM = true;
    bf16* mk; size_t estride; int ldc0, ldc1;
    __device__ __forceinline__ void operator()(const Acc& acc, const Unit& u, int wr, int wc, int fr, int fq) const {
        bf16* out = mk + (size_t)u.e * estride; const int ldc = u.e ? ldc1 : ldc0;
        const int row0 = u.pm * 256 + wr * 64 + fr, col0 = u.pn * 256 + wc * 32 + 8 * fq;
#pragma unroll
        for (int ai = 0; ai < 2; ++ai)
#pragma unroll
            for (int m = 0; m < 4; ++m) { bf16* rowp = out + (size_t)(row0 + ai * HALF + m * 16) * ldc + col0;
#pragma unroll
                for (int bj = 0; bj < 2; ++bj) *(v4u*)(rowp + bj * HALF) = pack8(acc[ai][bj][m][0], acc[ai][bj][m][1]); }
    }
};

struct EpiHeads64 {
    static constexpr bool PERM = true;
    bf16* base0; size_t tstride; int nrope; const float* rot16;
    __device__ __forceinline__ void operator()(Acc& acc, const Unit& u, int wr, int wc, int fr, int fq) const {
        const int t = u.pn >> 2; bf16* base = base0 + (size_t)t * tstride;
        const int row0 = u.pm * 256 + wr * 64 + fr, col0 = (u.pn & 3) * 256 + wc * 32 + 8 * fq;
        const bool ropew = (t < nrope) && ((wc & 1) == 0);
        const float sg = fq == 0 ? -1.0f : 1.0f, rt = fq < 2 ? 1.0f : 0.0f;
#pragma unroll
        for (int ai = 0; ai < 2; ++ai)
#pragma unroll
            for (int m = 0; m < 4; ++m) { const int row = row0 + ai * HALF + m * 16; bf16* rowp = base + (size_t)row * 1024 + col0;
                if (ropew) {
#pragma unroll
                    for (int n = 0; n < 2; ++n) { const f32x4 c0 = *(const f32x4*)(rot16 + (size_t)row * 16 + n * 8), c1 = *(const f32x4*)(rot16 + (size_t)row * 16 + n * 8 + 4);
                        const float cs[4] = {c0[0], c0[2], c1[0], c1[2]}, sn[4] = {c0[1], c0[3], c1[1], c1[3]};
#pragma unroll
                        for (int bj = 0; bj < 2; ++bj)
#pragma unroll
                            for (int e = 0; e < 4; ++e) { const float x = acc[ai][bj][m][n][e], p = __shfl_xor(x, 16);
                                acc[ai][bj][m][n][e] = x + rt * ((x * cs[e] - x) + sg * (p * sn[e])); } } }
#pragma unroll
                for (int bj = 0; bj < 2; ++bj) *(v4u*)(rowp + bj * HALF) = pack8(acc[ai][bj][m][0], acc[ai][bj][m][1]); }
    }
};

struct EpiQfull {
    static constexpr bool PERM = true;
    bf16* qf; const float* rot32;
    __device__ __forceinline__ void operator()(const Acc& acc, const Unit& u, int wr, int wc, int fr, int fq) const {
        const int row0 = u.pm * 256 + wr * 64 + fr; const float sg = fq < 2 ? -1.0f : 1.0f;
#pragma unroll
        for (int ai = 0; ai < 2; ++ai)
#pragma unroll
            for (int m = 0; m < 4; ++m) { const int row = row0 + ai * HALF + m * 16; bf16* rowp = qf + (size_t)row * (8 * KVW);
                if (u.pn < 8) {
#pragma unroll
                    for (int bj = 0; bj < 2; ++bj) *(v4u*)(rowp + u.pn * KVW + bj * HALF + wc * 32 + 8 * fq) = pack8(acc[ai][bj][m][0], acc[ai][bj][m][1]);
                } else {
                    f32x4 cs[2][2];
#pragma unroll
                    for (int n = 0; n < 2; ++n) { const float* rp = rot32 + (size_t)row * 32 + ((fq & 1) * 8 + n * 4) * 2; cs[n][0] = *(const f32x4*)rp; cs[n][1] = *(const f32x4*)(rp + 4); }
#pragma unroll
                    for (int bj = 0; bj < 2; ++bj) { f32x4 v[2] = {acc[ai][bj][m][0], acc[ai][bj][m][1]};
#pragma unroll
                        for (int n = 0; n < 2; ++n)
#pragma unroll
                            for (int e = 0; e < 4; ++e) { const float p = __shfl_xor(v[n][e], 32); const float c = cs[n][e >> 1][(e & 1) * 2], s = cs[n][e >> 1][(e & 1) * 2 + 1];
                                const float x = v[n][e]; v[n][e] = x * c + sg * (p * s); }
                        *(v4u*)(rowp + (4 * bj + wc) * KVW + 256 + 8 * fq) = pack8(v[0], v[1]); } } }
    }
};

template <bool OUTF32> struct EpiFold {
    static constexpr bool PERM = true;
    const float* stat; const float* gw; const float* bw; void* out; int ldc;
    __device__ __forceinline__ void operator()(const Acc& acc, const Unit& u, int wr, int wc, int fr, int fq) const {
        const int row0 = u.pm * 256 + wr * 64 + fr, col0 = u.pn * 256 + wc * 32 + 8 * fq;
        f32x4 gv[2][2], bv[2][2];
#pragma unroll
        for (int bj = 0; bj < 2; ++bj)
#pragma unroll
            for (int n = 0; n < 2; ++n) { gv[bj][n] = *(const f32x4*)(gw + col0 + bj * HALF + 4 * n); bv[bj][n] = *(const f32x4*)(bw + col0 + bj * HALF + 4 * n); }
#pragma unroll
        for (int ai = 0; ai < 2; ++ai)
#pragma unroll
            for (int m = 0; m < 4; ++m) { const int row = row0 + ai * HALF + m * 16; float mu, rstd; row_stats(stat, row, fq, mu, rstd);
#pragma unroll
                for (int bj = 0; bj < 2; ++bj) { const f32x4 v0 = (acc[ai][bj][m][0] - mu * gv[bj][0]) * rstd + bv[bj][0], v1 = (acc[ai][bj][m][1] - mu * gv[bj][1]) * rstd + bv[bj][1];
                    if (OUTF32) { float* p = (float*)out + (size_t)row * ldc + col0 + bj * HALF; *(f32x4*)p = v0; *(f32x4*)(p + 4) = v1; }
                    else *(v4u*)((bf16*)out + (size_t)row * ldc + col0 + bj * HALF) = pack8(v0, v1); } }
    }
};

template <int MODE, bool AUX = true> struct EpiPre {
    static constexpr bool PERM = false;
    const float* resid; float* pre; bf16* preb; const float* stat_old; float* stat_new; const float* g; const float* b;
    __device__ __forceinline__ void operator()(const Acc& acc, const Unit& u, int wr, int wc, int fr, int fq) const {
        const int row0 = u.pm * 256 + wr * 64 + fr, col0 = u.pn * 256 + wc * 32 + 4 * fq;
#pragma unroll
        for (int ai = 0; ai < 2; ++ai)
#pragma unroll
            for (int m = 0; m < 4; ++m) { const int row = row0 + ai * HALF + m * 16; const size_t off = (size_t)row * 1024 + col0;
                float mu = 0.f, rstd = 1.f; if (MODE == 1) row_stats(stat_old, row, fq, mu, rstd);
                float s1 = 0.f, s2 = 0.f;
#pragma unroll
                for (int bj = 0; bj < 2; ++bj)
#pragma unroll
                    for (int n = 0; n < 2; ++n) { f32x4 r;
                        { const v2u rw = *(const v2u*)(preb + off + bj * HALF + n * 16); r = (f32x4){bflo(rw.x), bfhi(rw.x), bflo(rw.y), bfhi(rw.y)}; }
                        if (MODE == 1) { const f32x4 gv = *(const f32x4*)(g + col0 + bj * HALF + n * 16), bv = *(const f32x4*)(b + col0 + bj * HALF + n * 16); r = (r - mu) * rstd * gv + bv; }
                        const f32x4 v = r * ALPHA + acc[ai][bj][m][n];
                        { v2u w; w.x = cvt_pk_bf16(v[0], v[1]); w.y = cvt_pk_bf16(v[2], v[3]); *(v2u*)(preb + off + bj * HALF + n * 16) = w; }
                        s1 += (v[0] + v[1]) + (v[2] + v[3]); s2 += (v[0] * v[0] + v[1] * v[1]) + (v[2] * v[2] + v[3] * v[3]);
                        if (MODE == 1 && n == 1) asm volatile("" ::: "memory"); }
                if (AUX) { s1 += __shfl_xor(s1, 16); s1 += __shfl_xor(s1, 32); s2 += __shfl_xor(s2, 16); s2 += __shfl_xor(s2, 32); }
                if (AUX && fq == 0) *(f32x2*)(stat_new + (size_t)row * 32 + (u.pn * 4 + wc) * 2) = (f32x2){s1, s2};
                asm volatile("" ::: "memory"); }
    }
};

struct EpiSoftmax {
    static constexpr bool PERM = true;
    bf16* out; int ldc; LAS float* xch;
    __device__ __forceinline__ void operator()(Acc& acc, const Unit& u, int wr, int wc, int fr, int fq) const {
        const int row0 = u.pm * 256 + wr * 64 + fr, col0 = u.pn * 256 + wc * 32 + 8 * fq;
#pragma unroll
        for (int ai = 0; ai < 2; ++ai)
#pragma unroll
            for (int m = 0; m < 4; ++m) { float mx = -INFINITY;
#pragma unroll
                for (int bj = 0; bj < 2; ++bj)
#pragma unroll
                    for (int n = 0; n < 2; ++n) { const f32x4 v = acc[ai][bj][m][n]; mx = fmaxf(mx, fmaxf(fmaxf(v[0], v[1]), fmaxf(v[2], v[3]))); }
                mx = fmaxf(mx, __shfl_xor(mx, 16)); mx = fmaxf(mx, __shfl_xor(mx, 32));
                if (fq == 0) xch[(ai * HALF + wr * 64 + m * 16 + fr) * 4 + wc] = mx; }
        asm volatile("s_waitcnt lgkmcnt(0)" ::: "memory"); __builtin_amdgcn_s_barrier(); asm volatile("" ::: "memory");
#pragma unroll
        for (int ai = 0; ai < 2; ++ai)
#pragma unroll
            for (int m = 0; m < 4; ++m) { const int r = ai * HALF + wr * 64 + m * 16 + fr; const f32x4 mm = *(const LAS f32x4*)(xch + r * 4);
                const float M = fmaxf(fmaxf(mm[0], mm[1]), fmaxf(mm[2], mm[3])); float s = 0.f;
#pragma unroll
                for (int bj = 0; bj < 2; ++bj)
#pragma unroll
                    for (int n = 0; n < 2; ++n) { f32x4 v = acc[ai][bj][m][n];
#pragma unroll
                        for (int e = 0; e < 4; ++e) { v[e] = __builtin_amdgcn_exp2f(v[e] - M); s += v[e]; }
                        acc[ai][bj][m][n] = v; }
                s += __shfl_xor(s, 16); s += __shfl_xor(s, 32);
                if (fq == 0) xch[1024 + r * 4 + wc] = s; }
        asm volatile("s_waitcnt lgkmcnt(0)" ::: "memory"); __builtin_amdgcn_s_barrier(); asm volatile("" ::: "memory");
#pragma unroll
        for (int ai = 0; ai < 2; ++ai)
#pragma unroll
            for (int m = 0; m < 4; ++m) { const int r = ai * HALF + wr * 64 + m * 16 + fr; const f32x4 ss = *(const LAS f32x4*)(xch + 1024 + r * 4);
                const float inv = 1.0f / ((ss[0] + ss[1]) + (ss[2] + ss[3])); bf16* rowp = out + (size_t)(row0 + ai * HALF + m * 16) * ldc + col0;
#pragma unroll
                for (int bj = 0; bj < 2; ++bj) *(v4u*)(rowp + bj * HALF) = pack8(acc[ai][bj][m][0] * inv, acc[ai][bj][m][1] * inv); }
    }
};

struct EpiFoldSoftmax {
    static constexpr bool PERM = true;
    const float* stat; const float* gwb; const float* bwb; bf16* out; LAS float* xch;
    __device__ __forceinline__ void operator()(Acc& acc, const Unit& u, int wr, int wc, int fr, int fq) const {
        const int row0 = u.pm * 256 + wr * 64 + fr, col0 = u.pn * 256 + wc * 32 + 8 * fq; const float* gw = gwb + u.e * 1024; const float* bw = bwb + u.e * 1024;
        { f32x4 gv[2][2], bv[2][2];
#pragma unroll
        for (int bj = 0; bj < 2; ++bj)
#pragma unroll
            for (int n = 0; n < 2; ++n) { gv[bj][n] = *(const f32x4*)(gw + col0 + bj * HALF + 4 * n); bv[bj][n] = *(const f32x4*)(bw + col0 + bj * HALF + 4 * n); }
#pragma unroll
        for (int ai = 0; ai < 2; ++ai)
#pragma unroll
            for (int m = 0; m < 4; ++m) { const int row = row0 + ai * HALF + m * 16; float mu, rstd; row_stats(stat, row, fq, mu, rstd); float mx = -INFINITY;
#pragma unroll
                for (int bj = 0; bj < 2; ++bj)
#pragma unroll
                    for (int n = 0; n < 2; ++n) { const f32x4 v = (acc[ai][bj][m][n] - mu * gv[bj][n]) * rstd + bv[bj][n]; acc[ai][bj][m][n] = v; mx = fmaxf(mx, fmaxf(fmaxf(v[0], v[1]), fmaxf(v[2], v[3]))); }
                mx = fmaxf(mx, __shfl_xor(mx, 16)); mx = fmaxf(mx, __shfl_xor(mx, 32));
                if (fq == 0) xch[(ai * HALF + wr * 64 + m * 16 + fr) * 4 + wc] = mx; } }
        asm volatile("s_waitcnt lgkmcnt(0)" ::: "memory"); __builtin_amdgcn_s_barrier(); asm volatile("" ::: "memory");
#pragma unroll
        for (int ai = 0; ai < 2; ++ai)
#pragma unroll
            for (int m = 0; m < 4; ++m) { const int r = ai * HALF + wr * 64 + m * 16 + fr; const f32x4 mm = *(const LAS f32x4*)(xch + r * 4);
                const float M = fmaxf(fmaxf(mm[0], mm[1]), fmaxf(mm[2], mm[3])); float s = 0.f;
#pragma unroll
                for (int bj = 0; bj < 2; ++bj)
#pragma unroll
                    for (int n = 0; n < 2; ++n) { f32x4 v = acc[ai][bj][m][n];
#pragma unroll
                        for (int e = 0; e < 4; ++e) { v[e] = __builtin_amdgcn_exp2f(v[e] - M); s += v[e]; }
                        acc[ai][bj][m][n] = v; }
                s += __shfl_xor(s, 16); s += __shfl_xor(s, 32);
                if (fq == 0) xch[1024 + r * 4 + wc] = s; }
        asm volatile("s_waitcnt lgkmcnt(0)" ::: "memory"); __builtin_amdgcn_s_barrier(); asm volatile("" ::: "memory");
#pragma unroll
        for (int ai = 0; ai < 2; ++ai)
#pragma unroll
            for (int m = 0; m < 4; ++m) { const int r = ai * HALF + wr * 64 + m * 16 + fr; const f32x4 ss = *(const LAS f32x4*)(xch + 1024 + r * 4);
                const float inv = 1.0f / ((ss[0] + ss[1]) + (ss[2] + ss[3])); bf16* rowp = out + (size_t)(row0 + ai * HALF + m * 16) * 1024 + col0;
#pragma unroll
                for (int bj = 0; bj < 2; ++bj) *(v4u*)(rowp + bj * HALF) = pack8(acc[ai][bj][m][0] * inv, acc[ai][bj][m][1] * inv); }
    }
};

struct EpiGateUp {
    static constexpr bool PERM = true;
    bf16* hid;
    __device__ __forceinline__ void operator()(const Acc& acc, const Unit& u, int wr, int wc, int fr, int fq) const {
        const int row0 = u.pm * 256 + wr * 64 + fr, col0 = u.pn * 128 + wc * 16 + 4 * fq;
#pragma unroll
        for (int ai = 0; ai < 2; ++ai)
#pragma unroll
            for (int m = 0; m < 4; ++m) { bf16* rowp = hid + (size_t)(row0 + ai * HALF + m * 16) * FF + col0;
#pragma unroll
                for (int bj = 0; bj < 2; ++bj) { const f32x4 v0 = acc[ai][bj][m][0], v1 = acc[ai][bj][m][1];
                    float h[4]; const float gt[4] = {v0[0], v0[2], v1[0], v1[2]}, up[4] = {v0[1], v0[3], v1[1], v1[3]};
#pragma unroll
                    for (int j = 0; j < 4; ++j) h[j] = gt[j] * __builtin_amdgcn_rcpf(1.0f + __builtin_amdgcn_exp2f(-gt[j] * LOG2E)) * up[j];
                    v2u w; w.x = cvt_pk_bf16(h[0], h[1]); w.y = cvt_pk_bf16(h[2], h[3]); *(v2u*)(rowp + bj * 64) = w; } }
    }
};
struct EpiDown {
    static constexpr bool PERM = true;
    bf16* y; const float* wsort;
    __device__ __forceinline__ void operator()(const Acc& acc, const Unit& u, int wr, int wc, int fr, int fq) const {
        const int row0 = u.pm * 256 + wr * 64 + fr, col0 = u.pn * 256 + wc * 32 + 8 * fq;
#pragma unroll
        for (int ai = 0; ai < 2; ++ai)
#pragma unroll
            for (int m = 0; m < 4; ++m) { const int row = row0 + ai * HALF + m * 16; const float w = wsort[row]; bf16* rowp = y + (size_t)row * 1024 + col0;
#pragma unroll
                for (int bj = 0; bj < 2; ++bj) *(v4u*)(rowp + bj * HALF) = pack8(acc[ai][bj][m][0] * w, acc[ai][bj][m][1] * w); }
    }
};
}
#include <hip/hip_bf16.h>
#include <cmath>
namespace attn_body {
using bf16=__hip_bfloat16;
using bf16x8=__attribute__((ext_vector_type(8)))short;
using s16x4=__attribute__((ext_vector_type(4)))short;
using f32x16=__attribute__((ext_vector_type(16)))float;
using u32x4=__attribute__((ext_vector_type(4)))unsigned;
constexpr int BATCH=8,NHEAD=16,SEQ=8192,D=64,DM=NHEAD*D;
constexpr int NW=8,QBLK=32,QB=QBLK*NW,KVBLK=64,NQB=SEQ/QB;
constexpr int ATTN_PITCH=DM, ATTN_UNIT_ROWS=QB;
__device__ __forceinline__ int crow(int r,int hi){return (r&3)+8*(r>>2)+4*hi;}
#define SBAR() __builtin_amdgcn_sched_barrier(0)
__device__ __forceinline__ void cmask(f32x16&p0,f32x16&p1,int jb,int qrel,int hi){
  const float NEG=-INFINITY; (void)hi;
  if(jb>(qrel>>6)){
  #pragma unroll
  for(int r=0;r<16;++r){p0[r]=NEG;p1[r]=NEG;}}
}


constexpr int NSLOT=3, SLOTB=8192, VSLOTB=16384;
constexpr int LDS_K=0, LDS_V=NSLOT*SLOTB, LDS_WS=LDS_V+NSLOT*VSLOTB, LDS_OST=LDS_WS+NW*64*4, LDS_BYTES=LDS_OST+NW*8192;
constexpr float C2=0.125f*1.4426950408889634f;
__device__ __forceinline__ void glds16(const void*gsrc,unsigned lds_dst){unsigned keep;
  asm volatile("s_mov_b32 %0, m0\n\ts_mov_b32 m0, %2\n\ts_nop 0\n\tglobal_load_lds_dwordx4 %1, off\n\ts_mov_b32 m0, %0":"=&s"(keep):"v"(gsrc),"s"(lds_dst):"memory");}
__device__ __forceinline__ float max3f(float a,float b,float c){float r;asm("v_max3_f32 %0, %1, %2, %3":"=v"(r):"v"(a),"v"(b),"v"(c));return r;}
__device__ __forceinline__ float max2f(float a,float b){float r;asm("v_max_f32_e32 %0, %1, %2":"=v"(r):"v"(a),"v"(b));return r;}
__device__ __forceinline__ float fadd_s(float a,float b){float r;asm("v_add_f32_e32 %0, %1, %2":"=v"(r):"v"(a),"v"(b));return r;}
__device__ __forceinline__ float fsub_s(float a,float b){float r;asm("v_sub_f32_e32 %0, %1, %2":"=v"(r):"v"(a),"v"(b));return r;}
typedef float f32x2_t __attribute__((ext_vector_type(2))); typedef __bf16 bf16x2_t __attribute__((ext_vector_type(2)));
__device__ __forceinline__ unsigned cvtpk_s(float lo,float hi){f32x2_t v={lo,hi};bf16x2_t b=__builtin_convertvector(v,bf16x2_t);return __builtin_bit_cast(unsigned,b);}
#define WAIT_BAR(N) asm volatile("s_waitcnt vmcnt(" #N ") lgkmcnt(0)\n\ts_barrier":::"memory")

__device__ __forceinline__ void qkt(f32x16&p0,f32x16&p1,const char*Kslot,const __attribute__((address_space(3))) char*qst,const f32x16&negm,int r32,int hi){
  #define QR(d0) (*(const __attribute__((address_space(3))) bf16x8*)(qst+(d0)*1024))
  const char*kb=Kslot+hi*1024+r32*16;
  #pragma unroll
  for(int d0=0;d0<4;++d0){
    const bf16x8 b0=*reinterpret_cast<const bf16x8*>(kb+d0*2048);
    const bf16x8 b1=*reinterpret_cast<const bf16x8*>(kb+d0*2048+512);
    if(d0==0){p0=__builtin_amdgcn_mfma_f32_32x32x16_bf16(b0,QR(0),negm,0,0,0);p1=__builtin_amdgcn_mfma_f32_32x32x16_bf16(b1,QR(0),negm,0,0,0);}
    else{p0=__builtin_amdgcn_mfma_f32_32x32x16_bf16(b0,QR(d0),p0,0,0,0);p1=__builtin_amdgcn_mfma_f32_32x32x16_bf16(b1,QR(d0),p1,0,0,0);}}
  #undef QR
}
typedef __attribute__((address_space(3))) const char* lds_cptr;
typedef short v4i16_t __attribute__((ext_vector_type(4)));
__device__ __forceinline__ void kload8(bf16x8*kf,lds_cptr kp){
  kf[0]=*(const __attribute__((address_space(3))) bf16x8*)(kp);      kf[1]=*(const __attribute__((address_space(3))) bf16x8*)(kp+512);
  kf[2]=*(const __attribute__((address_space(3))) bf16x8*)(kp+2048); kf[3]=*(const __attribute__((address_space(3))) bf16x8*)(kp+2560);
  kf[4]=*(const __attribute__((address_space(3))) bf16x8*)(kp+4096); kf[5]=*(const __attribute__((address_space(3))) bf16x8*)(kp+4608);
  kf[6]=*(const __attribute__((address_space(3))) bf16x8*)(kp+6144); kf[7]=*(const __attribute__((address_space(3))) bf16x8*)(kp+6656);
}
__device__ __forceinline__ void kload2(bf16x8*kf,lds_cptr kp,int j){ kf[2*j]=*(const __attribute__((address_space(3))) bf16x8*)(kp+j*2048); kf[2*j+1]=*(const __attribute__((address_space(3))) bf16x8*)(kp+j*2048+512); }
__device__ __forceinline__ s16x4 vtr(lds_cptr p){ return __builtin_bit_cast(s16x4,__builtin_amdgcn_ds_read_tr16_b64_v4i16((__attribute__((address_space(3))) v4i16_t*)p)); }
__device__ __forceinline__ float rowmax(const f32x16&p0,const f32x16&p1){
  float a=max3f(p0[0],p0[1],p1[0]),b=max3f(p0[2],p0[3],p1[1]);a=max3f(a,p1[2],p1[3]);
  #pragma unroll
  for(int r=4;r<16;r+=4){a=max3f(a,p0[r],p0[r+1]);b=max3f(b,p0[r+2],p0[r+3]);a=max3f(a,p1[r],p1[r+1]);b=max3f(b,p1[r+2],p1[r+3]);}
  const float m=max2f(a,b);
  auto rr=__builtin_amdgcn_permlane32_swap(__float_as_uint(m),__float_as_uint(m),false,false);
  return max2f(__uint_as_float(rr[0]),__uint_as_float(rr[1]));
}
__device__ __forceinline__ void pv(f32x16*o,int vb,bf16x8 pa0,bf16x8 pa1,bf16x8 pa2,bf16x8 pa3){
  #pragma unroll
  for(int d0=0;d0<2;++d0){s16x4 lo[4],hi[4];
    #pragma unroll
    for(int ks=0;ks<4;++ks){
      asm volatile("ds_read_b64_tr_b16 %0,%1 offset:%c2":"=&v"(lo[ks]):"v"(vb),"i"(d0*4096+ks*1024):"memory");
      asm volatile("ds_read_b64_tr_b16 %0,%1 offset:%c2":"=&v"(hi[ks]):"v"(vb),"i"(d0*4096+ks*1024+512):"memory");}
    asm volatile("s_waitcnt lgkmcnt(0)":::"memory");SBAR();
    #define PK(k) (bf16x8){lo[k][0],lo[k][1],lo[k][2],lo[k][3],hi[k][0],hi[k][1],hi[k][2],hi[k][3]}
    o[d0]=__builtin_amdgcn_mfma_f32_32x32x16_bf16(pa0,PK(0),o[d0],0,0,0);
    o[d0]=__builtin_amdgcn_mfma_f32_32x32x16_bf16(pa1,PK(1),o[d0],0,0,0);
    o[d0]=__builtin_amdgcn_mfma_f32_32x32x16_bf16(pa2,PK(2),o[d0],0,0,0);
    o[d0]=__builtin_amdgcn_mfma_f32_32x32x16_bf16(pa3,PK(3),o[d0],0,0,0);
    #undef PK
  }
}

#ifndef ATTN_STORE16
#define ATTN_STORE16(p,v) (*(u32x4*)(p)=(v))
#endif
template<int THRL> __device__ __forceinline__ void attn_unit(const int wid,int b,int h,int hv,int qb,const bf16*Q,const bf16*__restrict__ K,const bf16*__restrict__ V,bf16*O,char*shm){
  int lane_; asm volatile("v_mbcnt_lo_u32_b32 %0, -1, 0\n\tv_mbcnt_hi_u32_b32 %0, -1, %0":"=v"(lane_)); const int lane=lane_,r32=lane&31,hi=lane>>5;
  const long rowbase=(long)b*SEQ; const int q0=qb*QB;
  const bf16*Qw=Q+(rowbase+q0+wid*QBLK)*DM+h*D;
  const bf16*Kh=K+rowbase*DM+h*D,*Vh=V+rowbase*DM+hv*D;
  const unsigned lds0=(unsigned)(uintptr_t)shm;
  float*wsf=(float*)(shm+LDS_WS)+wid*64;
  const bf16*ksrc=Kh+(long)lane*DM+wid*8;
  const bf16*vsrc=Vh+(long)(16*(wid&3)+(lane>>2))*DM+(wid>>2)*32+(lane&3)*8;
  const unsigned kdst=lds0+LDS_K+wid*1024, vdst=lds0+LDS_V+wid*1024;
  #define DMA_K(t,slot) glds16(ksrc+(long)(t)*KVBLK*DM,(unsigned)__builtin_amdgcn_readfirstlane(kdst+(slot)))
  #define DMA_V(t,slot) do{ glds16(vsrc+(long)(t)*KVBLK*DM,(unsigned)__builtin_amdgcn_readfirstlane(vdst+2*(slot))); glds16(vsrc+64+(long)(t)*KVBLK*DM,(unsigned)__builtin_amdgcn_readfirstlane(vdst+8192+2*(slot))); }while(0)
  const int vb0=(int)(lds0+LDS_V)+((lane>>4)&1)*32+(lane&3)*8+(4*hi+((lane&15)>>2))*64;
  const char*Kbase=shm+LDS_K; bf16x8 kf[8];
  const lds_cptr shm3=(lds_cptr)shm; const lds_cptr kp0=shm3+LDS_K+hi*1024+r32*16; const lds_cptr vp0=shm3+LDS_V+((lane>>4)&1)*32+(lane&3)*8+(4*hi+((lane&15)>>2))*64;
  const int NT=(q0+QB)/KVBLK;
  DMA_K(0,0);DMA_V(0,0);DMA_K(1,SLOTB);
  const lds_cptr qst=(lds_cptr)shm+LDS_OST+wid*8192+lane*16;
  { bf16x8 qtmp[4];
  #pragma unroll
  for(int d0=0;d0<4;++d0)qtmp[d0]=*reinterpret_cast<const bf16x8*>(&Qw[(long)r32*DM+d0*16+hi*8]);
  #pragma unroll
  for(int d0=0;d0<4;++d0)*(__attribute__((address_space(3))) bf16x8*)((__attribute__((address_space(3))) char*)qst+d0*1024)=qtmp[d0]; }
  #define QR(d0) (*(const __attribute__((address_space(3))) bf16x8*)(qst+(d0)*1024))
  float mhat=0.f,l_reg=0.f;f32x16 o[4];o[0]=f32x16{};o[1]=f32x16{};o[2]=f32x16{};o[3]=f32x16{};const f32x16 negm=f32x16{};
  const int qrel=wid*QBLK+r32;
  #define CMASK(P0,P1,t) do{int jb_=(t)-(NT-4); if(jb_>=0)cmask(P0,P1,jb_,qrel,hi);}while(0)
  bool resc=false;
  #define START(P0,P1) do{ const float rm=rowmax(P0,P1); resc=false; \
    { const float dl=rm; mhat=fadd_s(mhat,dl); \
      _Pragma("unroll") for(int r=0;r<16;++r){P0[r]=fsub_s(P0[r],dl);P1[r]=fsub_s(P1[r],dl);} \
      } \
    _Pragma("unroll") for(int r=0;r<16;++r)P0[r]=__builtin_amdgcn_exp2f(P0[r]); }while(0)
  #define RESC() do{ if(resc){ asm volatile("s_waitcnt lgkmcnt(0)":::"memory"); \
      _Pragma("unroll") for(int d_=0;d_<4;++d_) _Pragma("unroll") for(int r=0;r<16;++r)o[d_][r]*=wsf[crow(r,hi)]; } }while(0)
  f32x16 pA0,pA1,pB0,pB1;
  int sl_prev=0,sl_cur=0,sl_next=SLOTB;
  #define ROT() do{sl_prev=sl_cur;sl_cur=sl_next;sl_next=(sl_next==(NSLOT-1)*SLOTB)?0:sl_next+SLOTB;}while(0)
  DMA_K(2,2*SLOTB);
  WAIT_BAR(3);
  qkt(pA0,pA1,Kbase,qst,negm,r32,hi);asm volatile("s_nop 15\n\ts_nop 7":"+v"(pA0),"+v"(pA1));CMASK(pA0,pA1,0);
  START(pA0,pA1);
  _Pragma("unroll") for(int r=0;r<16;++r)pA1[r]=__builtin_amdgcn_exp2f(pA1[r]);
  WAIT_BAR(0);
  DMA_K(3,0);DMA_V(1,SLOTB);
  ROT();
  kload8(kf,kp0+sl_cur);
  WAIT_BAR(3);
  s16x4 vlo[8],vhi[8]; u32x4 pw0,pw1,pw2,pw3;
  #define PKW(P,B) cvtpk_s(P[B],P[B+1])
  #define PAF(k) __builtin_bit_cast(bf16x8,pw##k)
  #define VFR(i) (bf16x8){vlo[i][0],vlo[i][1],vlo[i][2],vlo[i][3],vhi[i][0],vhi[i][1],vhi[i][2],vhi[i][3]}
  #define PIN(x) asm volatile("":"+v"(x))
  #define MX3(a,b,c) __builtin_fmaxf(__builtin_fmaxf((a),(b)),(c))
  #define GAPA(MF,A0,A1,A2,A3,W0,W1,PW) do{ MF; sacc+=A0; sacc+=A1; sacc+=A2; sacc+=A3; PIN(sacc); W0; W1; PIN(PW); SBAR(); }while(0)
  #define EX(v) __builtin_amdgcn_exp2f(v)
  #define GAPB(MF,X,B) do{ MF; X[B]=EX(X[B]); X[B+1]=EX(X[B+1]); X[B+2]=EX(X[B+2]); X[B+3]=EX(X[B+3]); PIN(X); SBAR(); }while(0)
  #define VRD(i) do{ vlo[i]=vtr(vp_+(((i)>>2)*4096+((i)&3)*1024)); vhi[i]=vtr(vp_+(((i)>>2)*4096+((i)&3)*1024+512)); }while(0)
  #define KRD(G,j) do{ if(G){ kload2(kf,kp0+sl_next,j); SBAR(); } }while(0)
  #define STEP(C0,C1,P0,P1,t,GK,GV,GL) do{ SBAR(); \
    const lds_cptr vp_=vp0+2*sl_prev; \
    VRD(0); SBAR(); float sacc=(P0[0]+P0[1]); \
    GAPA(C0=__builtin_amdgcn_mfma_f32_32x32x16_bf16(kf[0],QR(0),negm,0,0,0), P0[2],P0[3],P0[4],P0[5],     pw0[0]=PKW(P0,0), pw0[1]=PKW(P0,2), pw0); \
    VRD(4); SBAR(); GAPA(C1=__builtin_amdgcn_mfma_f32_32x32x16_bf16(kf[1],QR(0),negm,0,0,0), P0[6],P0[7],P0[8],P0[9],     pw0[2]=PKW(P0,4), pw0[3]=PKW(P0,6), pw0); \
    VRD(1); SBAR(); GAPA(C0=__builtin_amdgcn_mfma_f32_32x32x16_bf16(kf[2],QR(1),C0,0,0,0),   P0[10],P0[11],P0[12],P0[13], pw1[0]=PKW(P0,8), pw1[1]=PKW(P0,10), pw1); \
    VRD(5); SBAR(); GAPA(C1=__builtin_amdgcn_mfma_f32_32x32x16_bf16(kf[3],QR(1),C1,0,0,0),   P0[14],P0[15],P1[0],P1[1],   pw1[2]=PKW(P0,12),pw1[3]=PKW(P0,14), pw1); \
    VRD(2); SBAR(); GAPA(C0=__builtin_amdgcn_mfma_f32_32x32x16_bf16(kf[4],QR(2),C0,0,0,0),   P1[2],P1[3],P1[4],P1[5],     pw2[0]=PKW(P1,0), pw2[1]=PKW(P1,2), pw2); \
    VRD(6); SBAR(); GAPA(C1=__builtin_amdgcn_mfma_f32_32x32x16_bf16(kf[5],QR(2),C1,0,0,0),   P1[6],P1[7],P1[8],P1[9],     pw2[2]=PKW(P1,4), pw2[3]=PKW(P1,6), pw2); \
    VRD(3); SBAR(); GAPA(C0=__builtin_amdgcn_mfma_f32_32x32x16_bf16(kf[6],QR(3),C0,0,0,0),   P1[10],P1[11],P1[12],P1[13], pw3[0]=PKW(P1,8), pw3[1]=PKW(P1,10), pw3); \
    VRD(7); SBAR(); GAPA(C1=__builtin_amdgcn_mfma_f32_32x32x16_bf16(kf[7],QR(3),C1,0,0,0),   P1[14],P1[15],0.f,0.f,       pw3[2]=PKW(P1,12),pw3[3]=PKW(P1,14), pw3); \
    l_reg+=sacc; \
    if(GK){DMA_K((t)+3,sl_cur);} if(GV){DMA_V((t)+1,sl_next);} \
    _Pragma("unroll") for(int r=0;r<16;++r){C0[r]-=mhat;C1[r]-=mhat;} \
    CMASK(C0,C1,t); \
    { float a=MX3(C0[0],C0[1],C1[0]),b=MX3(C0[2],C0[3],C1[1]); a=MX3(a,C1[2],C1[3]); \
      _Pragma("unroll") for(int r=4;r<16;r+=4){a=MX3(a,C0[r],C0[r+1]);b=MX3(b,C0[r+2],C0[r+3]);a=MX3(a,C1[r],C1[r+1]);b=MX3(b,C1[r+2],C1[r+3]);} \
      float rm=__builtin_fmaxf(a,b); { auto rr=__builtin_amdgcn_permlane32_swap(__float_as_uint(rm),__float_as_uint(rm),false,false); rm=__builtin_fmaxf(__uint_as_float(rr[0]),__uint_as_float(rr[1])); } \
      resc=false; \
      if(__builtin_expect(__any(rm>(float)THRL),0)){ const float dl=__builtin_fmaxf(rm,0.f); mhat+=dl; \
        _Pragma("unroll") for(int r=0;r<16;++r){C0[r]-=dl;C1[r]-=dl;} \
        const float f=__builtin_amdgcn_exp2f(-dl); l_reg*=f; if(hi==0)wsf[r32]=f; resc=true; } } \
    SBAR(); \
    GAPB(o[0]=__builtin_amdgcn_mfma_f32_32x32x16_bf16(PAF(0),VFR(0),o[0],0,0,0), C0,0); \
    GAPB(o[1]=__builtin_amdgcn_mfma_f32_32x32x16_bf16(PAF(0),VFR(4),o[1],0,0,0), C0,4); \
    KRD(GL,0); GAPB(o[0]=__builtin_amdgcn_mfma_f32_32x32x16_bf16(PAF(1),VFR(1),o[0],0,0,0), C0,8); \
    KRD(GL,1); GAPB(o[1]=__builtin_amdgcn_mfma_f32_32x32x16_bf16(PAF(1),VFR(5),o[1],0,0,0), C0,12); \
    KRD(GL,2); GAPB(o[0]=__builtin_amdgcn_mfma_f32_32x32x16_bf16(PAF(2),VFR(2),o[0],0,0,0), C1,0); \
    KRD(GL,3); GAPB(o[1]=__builtin_amdgcn_mfma_f32_32x32x16_bf16(PAF(2),VFR(6),o[1],0,0,0), C1,4); \
    GAPB(o[0]=__builtin_amdgcn_mfma_f32_32x32x16_bf16(PAF(3),VFR(3),o[0],0,0,0), C1,8); \
    GAPB(o[1]=__builtin_amdgcn_mfma_f32_32x32x16_bf16(PAF(3),VFR(7),o[1],0,0,0), C1,12); \
    pv(o+2,vb0+2*sl_prev+8192,PAF(0),PAF(1),PAF(2),PAF(3));   \
    }while(0)
  int t=1;
  #undef CMASK
  #define CMASK(P0,P1,t) do{}while(0)
  for(;t+5<NT;t+=2){
    STEP(pB0,pB1,pA0,pA1,t,true,true,true);     WAIT_BAR(3); RESC(); ROT();
    STEP(pA0,pA1,pB0,pB1,t+1,true,true,true);   WAIT_BAR(3); RESC(); ROT();
  }
  #undef CMASK
  #define CMASK(P0,P1,t) do{int jb_=(t)-(NT-4); if(jb_>=0)cmask(P0,P1,jb_,qrel,hi);}while(0)
  #define ENDW(tt) do{ if((tt)+3<NT){WAIT_BAR(3);} else if((tt)+2<NT){WAIT_BAR(2);} else {WAIT_BAR(0);} }while(0)
  for(;t+1<NT;t+=2){
    STEP(pB0,pB1,pA0,pA1,t,(t+3<NT),(t+1<NT),(t+1<NT));       ENDW(t);   RESC(); ROT();
    STEP(pA0,pA1,pB0,pB1,t+1,(t+4<NT),(t+2<NT),(t+2<NT));     ENDW(t+1); RESC(); ROT();
  }
  STEP(pB0,pB1,pA0,pA1,NT-1,false,false,false); RESC();
  { float sacc=pB0[0]+pB0[1]; _Pragma("unroll") for(int r=2;r<16;++r)sacc+=pB0[r]; _Pragma("unroll") for(int r=0;r<16;++r)sacc+=pB1[r]; l_reg+=sacc;
    pw0=(u32x4){PKW(pB0,0),PKW(pB0,2),PKW(pB0,4),PKW(pB0,6)};pw1=(u32x4){PKW(pB0,8),PKW(pB0,10),PKW(pB0,12),PKW(pB0,14)};pw2=(u32x4){PKW(pB1,0),PKW(pB1,2),PKW(pB1,4),PKW(pB1,6)};pw3=(u32x4){PKW(pB1,8),PKW(pB1,10),PKW(pB1,12),PKW(pB1,14)};
    SBAR(); pv(o,vb0+2*sl_cur,PAF(0),PAF(1),PAF(2),PAF(3)); pv(o+2,vb0+2*sl_cur+8192,PAF(0),PAF(1),PAF(2),PAF(3)); }
  #undef PKW
  #undef PAF
  #undef VFR
  #undef PIN
  #undef MX3
  #undef GAPA
  #undef GAPB
  #undef EX
  #undef VRD
  #undef KRD
  #undef STEP
  #undef ENDW
  {auto rr=__builtin_amdgcn_permlane32_swap(__float_as_uint(l_reg),__float_as_uint(l_reg),false,false);l_reg=__uint_as_float(rr[0])+__uint_as_float(rr[1]);}
  if(hi==0)wsf[32+r32]=l_reg;asm volatile("s_waitcnt lgkmcnt(0)":::"memory");
  float rli[16];
  #pragma unroll
  for(int r=0;r<16;++r)rli[r]=__builtin_amdgcn_rcpf(wsf[32+crow(r,hi)]);
  bf16*Ow=O+(rowbase+q0+wid*QBLK)*DM+hv*D;
  { bf16*stg=(bf16*)(shm+LDS_OST)+wid*4096;
    #pragma unroll
    for(int r=0;r<16;++r){const int orow=crow(r,hi);
      #pragma unroll
      for(int d0=0;d0<4;++d0)stg[orow*128+d0*32+r32]=__float2bfloat16(o[d0][r]*rli[r]);}
    asm volatile("s_waitcnt lgkmcnt(0)":::"memory");
    #pragma unroll
    for(int i=0;i<8;++i){const int row=i*4+(lane>>4),ch=lane&15; const u32x4 v=*(const u32x4*)(stg+row*128+ch*8); ATTN_STORE16(Ow+(long)row*DM+ch*8,v);} }
  asm volatile("s_waitcnt lgkmcnt(0)\n\ts_barrier":::"memory");
  #undef QR
  #undef DMA_K
  #undef DMA_V
  #undef CMASK
  #undef START
  #undef RESC
  #undef ROT
}
constexpr int ATTN_LDS_BYTES=LDS_BYTES;
struct AttnTensors { const bf16* Q; const bf16* K; const bf16* V; bf16* O0; bf16* O1; };
template<int THRL=8> __device__ __forceinline__ void attn_phase(char*lds,const AttnTensors&T,int vcu,const int wid){
  const int bhc=vcu>>1, part=vcu&1, b=bhc>>4, h=(bhc>>1)&7, c=bhc&1;
  bf16*O=c?T.O1:T.O0;
  for(int i=0;i<16;++i){ const int j=2*(i>>1)+part, qb=(i&1)?(NQB-1-j):j; attn_unit<THRL>(wid,b,2*h+c,2*h,qb,T.Q,T.K,T.V,O,lds); }
}
#undef SBAR
#undef WAIT_BAR
}
#define XB_TMO      128
#define XB_XCNT(j)  (256  + 64 * (j))
#define XB_XSUB(j)  (1280 + 64 * (j))
#define XB_XGEN(j)  (2304 + 64 * (j))
#define XB_TOP      3328
#define XB_TOPGEN   3392
#define XCD_BAR_WORDS 3456
#define XB_SPIN_CAP (1u << 18)

__device__ __forceinline__ unsigned xb_ld(unsigned* p)              { return __hip_atomic_load(p, __ATOMIC_RELAXED, __HIP_MEMORY_SCOPE_AGENT); }
__device__ __forceinline__ unsigned xb_add(unsigned* p, unsigned v) { return __hip_atomic_fetch_add(p, v, __ATOMIC_RELAXED, __HIP_MEMORY_SCOPE_AGENT); }
__device__ __forceinline__ unsigned xb_xcc_id() { return (unsigned)__builtin_amdgcn_s_getreg((3 << 11) | 20) & 0xFu; }
#define XB_SPIN(cond, bar) do { unsigned _sp = 0; while (cond) { __builtin_amdgcn_s_sleep(1); \
    if ((++_sp & 255u) == 0u) { if (xb_ld(&(bar)[XB_TMO])) break; if (_sp > XB_SPIN_CAP) { atomicAdd(&(bar)[XB_TMO], 1u); break; } } } } while (0)

struct XcdBarrier {
    unsigned* bar; unsigned x;
    int wave;
    volatile LAS unsigned* st;
};

__device__ __forceinline__ bool xb_thread0(int wave) { return wave == 0 && __builtin_amdgcn_mbcnt_hi(~0u, __builtin_amdgcn_mbcnt_lo(~0u, 0u)) == 0u; }
__device__ __forceinline__ XcdBarrier xcd_barrier_post(unsigned* bar, volatile LAS unsigned* st, int wave) {
    XcdBarrier b; b.bar = bar; b.x = xb_xcc_id(); b.st = st; b.wave = wave;
    if (xb_thread0(wave)) (void)xb_add(&bar[XB_XCNT(b.x)], 1u);
    return b;
}
__device__ __forceinline__ void xcd_barrier_complete(unsigned* bar, unsigned x, unsigned& nloc, unsigned& nx) {
    const unsigned G = gridDim.x * gridDim.y * gridDim.z;
    unsigned sum, cnt, mine, sp = 0u;
    for (;;) {
        sum = 0u; cnt = 0u; mine = 0u;
#pragma unroll
        for (unsigned j = 0; j < 16; ++j) { const unsigned c = xb_ld(&bar[XB_XCNT(j)]); sum += c; cnt += (c > 0u) ? 1u : 0u; mine = (j == x) ? c : mine; }
        if (sum == G) break;
        __builtin_amdgcn_s_sleep(1);
        if ((++sp & 255u) == 0u) { if (xb_ld(&bar[XB_TMO])) break; if (sp > XB_SPIN_CAP) { atomicAdd(&bar[XB_TMO], 1u); break; } }
    }
    nloc = mine > 0u ? mine : 1u; nx = cnt > 0u ? cnt : 1u;
}

__device__ __forceinline__ void xcd_barrier(const XcdBarrier& b) {
    asm volatile("s_waitcnt vmcnt(0)" ::: "memory");
    __syncthreads();
    if (xb_thread0(b.wave)) {
        unsigned* bar = b.bar;
        __builtin_amdgcn_s_waitcnt(0);
        unsigned nloc = b.st[0], nx = b.st[1];
        if (nloc == 0u) { xcd_barrier_complete(bar, b.x, nloc, nx); b.st[0] = nloc; b.st[1] = nx; }
        const unsigned old = xb_add(&bar[XB_XSUB(b.x)], 1u);
        const unsigned gen = old / nloc;
        if (old + 1u == (gen + 1u) * nloc) {
            __builtin_amdgcn_fence(__ATOMIC_RELEASE, "agent");
            asm volatile("s_waitcnt vmcnt(0)" ::: "memory");
            const unsigned og = xb_add(&bar[XB_TOP], 1u);
            const unsigned tg = og / nx;
            if (og + 1u == (tg + 1u) * nx) xb_add(&bar[XB_TOPGEN], 1u);
            else XB_SPIN(xb_ld(&bar[XB_TOPGEN]) == tg, bar);
            __builtin_amdgcn_fence(__ATOMIC_ACQUIRE, "agent");
            xb_add(&bar[XB_XGEN(b.x)], 1u);
            asm volatile("s_waitcnt vmcnt(0)" ::: "memory");
        } else {
            XB_SPIN(xb_ld(&bar[XB_XGEN(b.x)]) == gen, bar);
            __builtin_amdgcn_fence(__ATOMIC_ACQUIRE, "agent");
            asm volatile("s_waitcnt vmcnt(0)" ::: "memory");
        }
    }
    __syncthreads();
}
enum { I_X = 0, I_MEM, I_POS, I_AWIN, I_ALAM, I_ASUBG, I_AWOUT, I_BWIN, I_BQG, I_BKVG, I_BWUQ, I_BWQIDX, I_BWUK, I_BWUV, I_BWOUT, I_MEMWKV, I_XAWQ, I_XAWOUT,
       I_MWG, I_MBG, I_MWE, I_MBE, I_MWGATE, I_MWUP, I_MWDOWN, I_LNG, I_LNB, N_IN };
struct Frame {
    LAS unsigned char* lds;
    volatile LAS unsigned* MISC;
    gu32* ctl;
    unsigned char* ws;
    int vcu, G, wave;
    float* out;
};
#define CAS __attribute__((address_space(4)))
__device__ __forceinline__ const float* ld_in(int i) { const float* CAS const* tab = (const float* CAS const*)__builtin_amdgcn_kernarg_segment_ptr(); asm volatile("" : "+s"(tab)); return tab[i]; }
#define WSP(T_, off) ((T_*)(F.ws + (off)))
__device__ __forceinline__ int hw_lane() { int l; asm volatile("v_mbcnt_lo_u32_b32 %0, -1, 0\n\tv_mbcnt_hi_u32_b32 %0, -1, %0" : "=v"(l)); return l;     }
#define PHASE_IDS() const int wave = F.wave, lane = hw_lane(), tid = wave * 64 + lane; (void)tid; (void)lane; (void)wave

__device__ __forceinline__ void tr_item(const float* W, int ldw, int c0, int N, bf16* WT, int ldt, int row_off, int rs, const float* kscale, float cs, int cs_lim, LAS float* scr, int item, int lane) {
    const int nblk = (N + 31) / 32, kb = item / nblk, nb = item % nblk, k0 = 64 * kb, n0 = 32 * nb;
    if ((N & 3) == 0 && (ldw & 3) == 0 && (c0 & 3) == 0) {
        const int n4 = n0 + 4 * (lane & 7); const bool nok = n4 < N; const float csn = n4 < cs_lim ? cs : 1.0f; f32x4 v[8];
#pragma unroll
        for (int i = 0; i < 8; ++i) { const int kk = 8 * i + (lane >> 3); v[i] = nok ? *(const GAS f32x4*)(W + (size_t)(k0 + kk) * ldw + c0 + n4) : (f32x4){0.f, 0.f, 0.f, 0.f}; }
#pragma unroll
        for (int i = 0; i < 8; ++i) { const int kk = 8 * i + (lane >> 3); float sc = csn; if (kscale) sc *= kscale[k0 + kk];
#pragma unroll
            for (int e = 0; e < 4; ++e) scr[kk * 33 + 4 * (lane & 7) + e] = v[i][e] * sc; }
    } else {
    const int nl = n0 + (lane & 31); const bool nok = nl < N; const float csn = nl < cs_lim ? cs : 1.0f;
#pragma unroll 8
    for (int i = 0; i < 32; ++i) { const int kk = 2 * i + (lane >> 5); float v = 0.f;
        if (nok) { v = W[(size_t)(k0 + kk) * ldw + c0 + nl] * csn; if (kscale) v *= kscale[k0 + kk]; }
        scr[kk * 33 + (lane & 31)] = v; }
    }
    LDS_WAIT(); asm volatile("" ::: "memory");
    const int c = lane & 7;
#pragma unroll
    for (int j = 0; j < 4; ++j) { const int n = (lane >> 3) + 8 * j; const LAS float* s = scr + (8 * c) * 33 + n;
        v4u o; o.x = pk2(s[0 * 33], s[1 * 33]); o.y = pk2(s[2 * 33], s[3 * 33]); o.z = pk2(s[4 * 33], s[5 * 33]); o.w = pk2(s[6 * 33], s[7 * 33]);
        if (n0 + n < N) *(GAS v4u*)(WT + (size_t)(row_off + (n0 + n) * rs) * ldt + k0 + 8 * c) = o; }
    LDS_WAIT(); asm volatile("" ::: "memory");
}
#ifndef MK_REP
#define MK_REP 0ull
#endif
#define P0REP(b) (1 + (int)((MK_REP >> (b)) & 1ull))
__device__ __forceinline__ void p0_prologue(Frame& F) {
    PHASE_IDS();
    LAS float* scr = (LAS float*)(F.lds + RING_OFF + wave * 16384);
    const int gw = F.vcu * NWAVES + wave, NGW = F.G * NWAVES;
    constexpr int IT_QKV = 16 * 96, IT_O = 16 * 32, IT_MKV = 16 * 64, IT_XQ = 16 * 32, IT_BIN = 16 * 20, IT_G = 16 * 16, IT_D = 8 * 32, IT_QIDX = 4 * 32, IT_QR = 4 * 1;
    constexpr int N1 = IT_QKV, N2 = N1 + IT_O, N3 = N2 + IT_MKV, N4 = N3 + 2 * IT_XQ, N5 = N4 + 2 * IT_XQ, N6 = N5 + IT_BIN, N7 = N6 + IT_QIDX, N8 = N7 + 8 * IT_QR;
    constexpr int PER_E = 2 * IT_G + IT_D, NITEMS = N8 + 32 * PER_E;
    const float* lng = ld_in(I_LNG);
    for (int rp = 0; rp < P0REP(22); ++rp)
    for (int it = gw; it < NITEMS; it += NGW) {
        if (it < N1) tr_item(ld_in(I_AWIN), 3072, 0, 3072, WSP(bf16, W_QKV), 1024, 0, 1, nullptr, C2, 1024, scr, it, lane);
        else if (it < N2) tr_item(ld_in(I_AWOUT), 1024, 0, 1024, WSP(bf16, W_O), 1024, 0, 1, nullptr, 1.f, 0, scr, it - N1, lane);
        else if (it < N3) tr_item(ld_in(I_MEMWKV), 2048, 0, 2048, WSP(bf16, W_MKV), 1024, 0, 1, nullptr, 1.f, 0, scr, it - N2, lane);
        else if (it < N4) { }
        else if (it < N5) { const int l = (it - N4) / IT_XQ; tr_item(ld_in(I_XAWOUT) + (size_t)l * 1048576, 1024, 0, 1024, WSP(bf16, W_XO) + (size_t)l * 1048576, 1024, 0, 1, nullptr, 1.f, 0, scr, (it - N4) % IT_XQ, lane); }
        else if (it < N6) tr_item(ld_in(I_BWIN), BIN_W, 0, BIN_W, WSP(bf16, W_BIN), 1024, 0, 1, lng + 2 * 1024, 1.f, 0, scr, it - N5, lane);
        else if (it < N7) tr_item(ld_in(I_BWQIDX), 1024, 0, 1024, WSP(bf16, W_Q2), 256, 2304, 1, nullptr, 1.f, 0, scr, it - N6, lane);
        else if (it < N8) { const int h = (it - N7) / IT_QR; tr_item(ld_in(I_BWUQ), 1024, h * 128, 32, WSP(bf16, W_Q2), 256, 2048 + h * 32, 1, nullptr, SC2, 1 << 30, scr, (it - N7) % IT_QR, lane); }
        else { const int r = it - N8, le = r / PER_E, q = r % PER_E;
            if (q < IT_G) tr_item(ld_in(I_MWGATE) + (size_t)le * 524288, 512, 0, 512, WSP(bf16, W_GU) + (size_t)le * 1048576, 1024, 0, 2, nullptr, 1.f, 0, scr, q, lane);
            else if (q < 2 * IT_G) tr_item(ld_in(I_MWUP) + (size_t)le * 524288, 512, 0, 512, WSP(bf16, W_GU) + (size_t)le * 1048576, 1024, 1, 2, nullptr, 1.f, 0, scr, q - IT_G, lane);
            else tr_item(ld_in(I_MWDOWN) + (size_t)le * 524288, 1024, 0, 1024, WSP(bf16, W_DN) + (size_t)le * 524288, 512, 0, 1, nullptr, 1.f, 0, scr, q - 2 * IT_G, lane); }
    }
    for (int rp = 0; rp < P0REP(23); ++rp) {
        const float* wuq = ld_in(I_BWUQ); const float* wuk = ld_in(I_BWUK); bf16* dst = WSP(bf16, W_Q2);
        for (int it = gw; it < 8 * 4 * 64; it += NGW) { const int rb = it & 63, kb = (it >> 6) & 3, h = it >> 8, k = kb * 64 + lane;
            const float* a = wuq + (size_t)k * 1024 + h * 128 + 32; float av[96];
#pragma unroll
            for (int n = 0; n < 96; n += 4) { const f32x4 v = *(const GAS f32x4*)(a + n); av[n] = v[0]; av[n + 1] = v[1]; av[n + 2] = v[2]; av[n + 3] = v[3]; }
#pragma unroll 1
            for (int r = rb * 4; r < rb * 4 + 4; ++r) { const float* bb = wuk + ((size_t)h * 256 + r) * 96; float s = 0.f;
#pragma unroll
                for (int n = 0; n < 96; n += 16) { const f32x4 b0 = *(const GAS f32x4*)(bb + n), b1 = *(const GAS f32x4*)(bb + n + 4), b2 = *(const GAS f32x4*)(bb + n + 8), b3 = *(const GAS f32x4*)(bb + n + 12);
                    s += (av[n] * b0[0] + av[n + 1] * b0[1]) + (av[n + 2] * b0[2] + av[n + 3] * b0[3]); s += (av[n + 4] * b1[0] + av[n + 5] * b1[1]) + (av[n + 6] * b1[2] + av[n + 7] * b1[3]);
                    s += (av[n + 8] * b2[0] + av[n + 9] * b2[1]) + (av[n + 10] * b2[2] + av[n + 11] * b2[3]); s += (av[n + 12] * b3[0] + av[n + 13] * b3[1]) + (av[n + 14] * b3[2] + av[n + 15] * b3[3]);
                    asm volatile("" ::: "memory"); }
                dst[(size_t)(h * 256 + r) * 256 + k] = (bf16)f2bf(s * SC2); } }
        const float* wuv = ld_in(I_BWUV); const float* wo = ld_in(I_BWOUT); bf16* d2 = WSP(bf16, W_UVO);
        for (int it = gw; it < 8 * 32 * 16; it += NGW) { const int nb = it & 15, r8 = (it >> 4) & 31, h = it >> 9, n = nb * 64 + lane;
            const float* a = wuv + ((size_t)h * 256 + r8 * 8) * 128; const float* bb = wo + (size_t)(h * 128) * 1024 + n; float acc[8];
#pragma unroll
            for (int jr = 0; jr < 8; ++jr) acc[jr] = 0.f;
#pragma unroll 8
            for (int v = 0; v < 128; v += 4) { const float b0 = bb[(size_t)v * 1024], b1 = bb[(size_t)(v + 1) * 1024], b2 = bb[(size_t)(v + 2) * 1024], b3 = bb[(size_t)(v + 3) * 1024];
#pragma unroll
                for (int jr = 0; jr < 8; ++jr) { const f32x4 av = *(const GAS f32x4*)(a + jr * 128 + v); acc[jr] += (av[0] * b0 + av[1] * b1) + (av[2] * b2 + av[3] * b3); } }
#pragma unroll
            for (int jr = 0; jr < 8; ++jr) d2[(size_t)n * 2048 + h * 256 + r8 * 8 + jr] = (bf16)f2bf(acc[jr]); }
    }
    const int gt = F.vcu * (NWAVES * 64) + tid, NGT = F.G * NWAVES * 64;
    for (int rp = 0; rp < P0REP(24); ++rp) {   const GAS f32x4* x4 = (const GAS f32x4*)ld_in(I_X); GAS v4u* xb = (GAS v4u*)WSP(bf16, S_XB);
        for (int i0 = gt; i0 < T * D / 8; i0 += 4 * NGT) { f32x4 a[4], b[4];
#pragma unroll
            for (int u = 0; u < 4; ++u) { a[u] = x4[2 * (size_t)(i0 + u * NGT)]; b[u] = x4[2 * (size_t)(i0 + u * NGT) + 1]; }
#pragma unroll
            for (int u = 0; u < 4; ++u) { v4u o; o.x = pk2(a[u][0], a[u][1]); o.y = pk2(a[u][2], a[u][3]); o.z = pk2(b[u][0], b[u][1]); o.w = pk2(b[u][2], b[u][3]); xb[i0 + u * NGT] = o; } }
        const GAS f32x4* m4 = (const GAS f32x4*)ld_in(I_MEM); GAS v4u* mb = (GAS v4u*)WSP(bf16, WS_MEMB);
        for (int i = gt; i < MEMROWS * D / 8; i += NGT) { const f32x4 a = m4[2 * (size_t)i], b = m4[2 * (size_t)i + 1]; v4u o; o.x = pk2(a[0], a[1]); o.y = pk2(a[2], a[3]); o.z = pk2(b[0], b[1]); o.w = pk2(b[2], b[3]); mb[i] = o; }
        { const GAS f32x4* q4 = (const GAS f32x4*)ld_in(I_XAWQ); GAS v4u* qb = (GAS v4u*)WSP(bf16, W_XQ); const float* lg = ld_in(I_LNG);
          for (int i = gt; i < 2 * 1024 * 1024 / 8; i += NGT) { const int l = i >> 17, k = (i >> 7) & 1023; const float sc = lg[(l * 3 + 0) * 1024 + k] * XQS; const f32x4 a = q4[2 * (size_t)i] * sc, b = q4[2 * (size_t)i + 1] * sc;
              v4u o; o.x = pk2(a[0], a[1]); o.y = pk2(a[2], a[3]); o.z = pk2(b[0], b[1]); o.w = pk2(b[2], b[3]); qb[i] = o; } }
        GAS v4u* zb = (GAS v4u*)(WSP(bf16, W_BIN) + (size_t)BIN_W * 1024);
        for (int i = gt; i < (BIN_LD - BIN_W) * 1024 / 8; i += NGT) zb[i] = (v4u){0u, 0u, 0u, 0u};
    }
    for (int rp = 0; rp < P0REP(25); ++rp) {   const int* pos = (const int*)ld_in(I_POS); float* r16 = WSP(float, WS_ROT16); float* r32 = WSP(float, WS_ROT32);
        for (int i = gt; i < T * 24; i += NGT) { const int t = i / 24, q = i % 24; const int jj = q < 8 ? 2 * q : q - 8;
            const double invf = exp2(-(double)jj * 1.1832230355827609), ang = (double)pos[t] * invf, n = rint(ang * 0.15915494309189535), red = fma(-n, 6.283185307179586, ang);
            const float rf = (float)red, c = cosf(rf), s = sinf(rf);
            float* d = q < 8 ? r16 + (size_t)t * 16 + q * 2 : r32 + (size_t)t * 32 + (q - 8) * 2; d[0] = c; d[1] = s; }
    }
    if (gt == 0) { const float* lam = ld_in(I_ALAM); float s01 = 0.f, s23 = 0.f; for (int i = 0; i < 64; ++i) { s01 += lam[i] * lam[64 + i]; s23 += lam[128 + i] * lam[192 + i]; }
        WSP(float, WS_SMALL)[SM_LAM] = expf(s01) - expf(s23) + 0.2f; }
}
__device__ __forceinline__ void fold_vectors(Frame& F) {
    PHASE_IDS();
    const int gw = F.vcu * NWAVES + wave, NGW = F.G * NWAVES;
    for (int it = gw; it < 3 * 1024; it += NGW) { const int f = it >> 10, n = it & 1023;
        const bf16* wt = f < 2 ? WSP(bf16, W_XQ) + (size_t)f * 1048576 : WSP(bf16, W_BIN);
        const float* w = f < 2 ? ld_in(I_XAWQ) + (size_t)f * 1048576 : ld_in(I_BWIN); const int ldw = f < 2 ? 1024 : BIN_W, nv = f < 2 ? 1024 : BIN_W;
        const float* bb = ld_in(I_LNB) + (f < 2 ? (f * 3 + 0) * 1024 : 2 * 1024); const float cs = f < 2 ? XQS : 1.0f;
        float* dst = WSP(float, WS_SMALL) + SM_GW + f * 2048;
        float sg = 0.f, sb = 0.f;
        if (n < nv) { v4u a = (v4u){0u, 0u, 0u, 0u}, b = a; if (f == 2) { a = *(const GAS v4u*)(wt + (size_t)n * 1024 + lane * 16); b = *(const GAS v4u*)(wt + (size_t)n * 1024 + lane * 16 + 8); }
            sg = ((bflo(a.x) + bfhi(a.x)) + (bflo(a.y) + bfhi(a.y))) + ((bflo(a.z) + bfhi(a.z)) + (bflo(a.w) + bfhi(a.w))) + ((bflo(b.x) + bfhi(b.x)) + (bflo(b.y) + bfhi(b.y))) + ((bflo(b.z) + bfhi(b.z)) + (bflo(b.w) + bfhi(b.w)));
            for (int k = lane; k < 1024; k += 64) sb += bb[k] * w[(size_t)k * ldw + n]; }
        sg = wave_sum(sg); sb = wave_sum(sb) * cs;
        if (lane == 0) { dst[n] = sg; dst[1024 + n] = sb; } }
}

__device__ __forceinline__ void diff_combine(Frame& F) {
    PHASE_IDS();
    const int gw = F.vcu * NWAVES + wave, NGW = F.G * NWAVES;
    const float lam = WSP(float, WS_SMALL)[SM_LAM]; const float* sg = ld_in(I_ASUBG);
    float gv[16];
#pragma unroll
    for (int i = 0; i < 16; ++i) gv[i] = sg[(lane & 7) * 16 + i] * 0.8f;
    const bf16* O0 = WSP(bf16, S_O0); const bf16* O1 = WSP(bf16, S_O1); bf16* ON = WSP(bf16, S_ON);
    constexpr int RB = 4;
    for (int m0 = gw; m0 < T; m0 += RB * NGW) {
        v4u a0v[RB], a1v[RB], b0v[RB], b1v[RB];
#pragma unroll
        for (int u = 0; u < RB; ++u) { const size_t mo = (size_t)(m0 + u * NGW) * 1024 + lane * 16;
            a0v[u] = *(const GAS v4u*)(O0 + mo); a1v[u] = *(const GAS v4u*)(O0 + mo + 8); b0v[u] = *(const GAS v4u*)(O1 + mo); b1v[u] = *(const GAS v4u*)(O1 + mo + 8); }
#pragma unroll
        for (int u = 0; u < RB; ++u) { const int m = m0 + u * NGW; const v4u a0 = a0v[u], a1 = a1v[u], b0 = b0v[u], b1 = b1v[u];
        const unsigned aw[8] = {a0.x, a0.y, a0.z, a0.w, a1.x, a1.y, a1.z, a1.w}, bw[8] = {b0.x, b0.y, b0.z, b0.w, b1.x, b1.y, b1.z, b1.w};
        float o[16]; float ss = 0.f;
#pragma unroll
        for (int i = 0; i < 8; ++i) { o[2 * i] = bflo(aw[i]) - lam * bflo(bw[i]); o[2 * i + 1] = bfhi(aw[i]) - lam * bfhi(bw[i]); ss += o[2 * i] * o[2 * i] + o[2 * i + 1] * o[2 * i + 1]; }
        ss += __shfl_xor(ss, 1); ss += __shfl_xor(ss, 2); ss += __shfl_xor(ss, 4);
        const float r = 1.0f / sqrtf(ss * (1.0f / 128.0f) + LN_EPS);
        v4u w0, w1;
        w0.x = pk2(o[0] * r * gv[0], o[1] * r * gv[1]); w0.y = pk2(o[2] * r * gv[2], o[3] * r * gv[3]); w0.z = pk2(o[4] * r * gv[4], o[5] * r * gv[5]); w0.w = pk2(o[6] * r * gv[6], o[7] * r * gv[7]);
        w1.x = pk2(o[8] * r * gv[8], o[9] * r * gv[9]); w1.y = pk2(o[10] * r * gv[10], o[11] * r * gv[11]); w1.z = pk2(o[12] * r * gv[12], o[13] * r * gv[13]); w1.w = pk2(o[14] * r * gv[14], o[15] * r * gv[15]);
        *(GAS v4u*)(ON + (size_t)m * 1024 + lane * 16) = w0; *(GAS v4u*)(ON + (size_t)m * 1024 + lane * 16 + 8) = w1; }
    }
}

__device__ __forceinline__ void moe_route(Frame& F, int layer) {
    PHASE_IDS();
    const int gw = F.vcu * NWAVES + wave, NGW = F.G * NWAVES;
    LAS float* wl = (LAS float*)(F.lds + RING_OFF);
    { const float* wg = ld_in(I_MWG) + (size_t)layer * 1024 * 4; const float* we = ld_in(I_MWE) + (size_t)layer * 1024 * 16;
      float tg[8], te[32];
#pragma unroll
      for (int k = 0; k < 8; ++k) tg[k] = wg[tid + k * (NWAVES * 64)];
#pragma unroll
      for (int k = 0; k < 32; ++k) te[k] = we[tid + k * (NWAVES * 64)];
#pragma unroll
      for (int k = 0; k < 8; ++k) { const int i = tid + k * (NWAVES * 64); wl[(i & 3) * 1024 + (i >> 2)] = tg[k]; }
#pragma unroll
      for (int k = 0; k < 32; ++k) { const int i = tid + k * (NWAVES * 64); wl[(4 + (i & 15)) * 1024 + (i >> 4)] = te[k]; } }
    LAS unsigned* lcnt = (LAS unsigned*)(F.lds + RING_OFF + 81920);
    if (tid < 16) lcnt[tid] = 0u;
    __syncthreads();
    const bf16* preb = WSP(bf16, WS_PREB); const float* g = ld_in(I_LNG) + (layer * 3 + 1) * 1024; const float* b = ld_in(I_LNB) + (layer * 3 + 1) * 1024;
    const float* bg = ld_in(I_MBG) + layer * 4; const float* be = ld_in(I_MBE) + layer * 16;
    f32x4 gl[4], bl[4];
#pragma unroll
    for (int j = 0; j < 4; ++j) { gl[j] = *(const f32x4*)(g + 256 * j + 4 * lane); bl[j] = *(const f32x4*)(b + 256 * j + 4 * lane); }
    bf16* XH = WSP(bf16, S_XH); f32x2* statf = WSP(f32x2, WS_STATF); int* route = WSP(int, WS_ROUTE); f32x2* routew = WSP(f32x2, WS_ROUTEW);
    gu32* cnt = F.ctl + CW_CNT + layer * 16 * 64;
    constexpr int RB = 4;
    auto rows_load = [&](v2u (&r)[RB][4], const int m0) __attribute__((always_inline)) {
#pragma unroll
        for (int u = 0; u < RB; ++u) { const bf16* xr = preb + (size_t)(m0 + u * NGW) * 1024 + 4 * lane;
#pragma unroll
            for (int j = 0; j < 4; ++j) r[u][j] = *(const GAS v2u*)(xr + 256 * j); } };
    auto rows_body = [&](v2u (&r)[RB][4], const int m0) __attribute__((always_inline)) {
        float mean[RB], rstd[RB]; f32x4 v[RB][4];
#pragma unroll
        for (int u = 0; u < RB; ++u)
#pragma unroll
            for (int j = 0; j < 4; ++j) v[u][j] = (f32x4){bflo(r[u][j].x), bfhi(r[u][j].x), bflo(r[u][j].y), bfhi(r[u][j].y)};
#pragma unroll
        for (int u = 0; u < RB; ++u) { float s = 0.f;
#pragma unroll
            for (int j = 0; j < 4; ++j) s += (v[u][j][0] + v[u][j][1]) + (v[u][j][2] + v[u][j][3]);
            mean[u] = wave_sum(s) * (1.f / 1024.f); }
#pragma unroll
        for (int u = 0; u < RB; ++u) { float s2 = 0.f;
#pragma unroll
            for (int j = 0; j < 4; ++j) { v[u][j] = v[u][j] - mean[u]; s2 += (v[u][j][0] * v[u][j][0] + v[u][j][1] * v[u][j][1]) + (v[u][j][2] * v[u][j][2] + v[u][j][3] * v[u][j][3]); }
            rstd[u] = 1.f / sqrtf(wave_sum(s2) * (1.f / 1024.f) + LN_EPS); }
#pragma unroll
        for (int u = 0; u < RB; ++u) { const int m = m0 + u * NGW;
#pragma unroll
            for (int j = 0; j < 4; ++j) { v[u][j] = v[u][j] * rstd[u] * gl[j] + bl[j];
                v2u w; w.x = pk2(v[u][j][0], v[u][j][1]); w.y = pk2(v[u][j][2], v[u][j][3]); *(GAS v2u*)(XH + (size_t)m * 1024 + 256 * j + 4 * lane) = w; } }
        float gq[RB][4];
#pragma unroll
        for (int o = 0; o < 4; ++o) { f32x4 w[4];
#pragma unroll
            for (int j = 0; j < 4; ++j) w[j] = *(const LAS f32x4*)(wl + o * 1024 + 256 * j + 4 * lane);
#pragma unroll
            for (int u = 0; u < RB; ++u) { float p = 0.f;
#pragma unroll
                for (int j = 0; j < 4; ++j) p += (v[u][j][0] * w[j][0] + v[u][j][1] * w[j][1]) + (v[u][j][2] * w[j][2] + v[u][j][3] * w[j][3]);
                gq[u][o] = wave_sum(p) + bg[o]; } }
#pragma unroll
        for (int u = 0; u < RB; ++u) { const int m = m0 + u * NGW;
            const float g0 = gq[u][0], g1 = gq[u][1], g2 = gq[u][2], g3 = gq[u][3];
            int gs = 0; float gm = g0; if (g1 > gm) { gm = g1; gs = 1; } if (g2 > gm) { gm = g2; gs = 2; } if (g3 > gm) { gm = g3; gs = 3; }
            const float gate = __builtin_amdgcn_rcpf(__builtin_amdgcn_exp2f((g0 - gm) * LOG2E) + __builtin_amdgcn_exp2f((g1 - gm) * LOG2E) + __builtin_amdgcn_exp2f((g2 - gm) * LOG2E) + __builtin_amdgcn_exp2f((g3 - gm) * LOG2E));
            gs = __builtin_amdgcn_readfirstlane(gs);
            float e[4];
#pragma unroll
            for (int o = 0; o < 4; ++o) { float p = 0.f; const LAS float* wp = wl + (4 + gs * 4 + o) * 1024;
#pragma unroll
                for (int j = 0; j < 4; ++j) { const f32x4 w = *(const LAS f32x4*)(wp + 256 * j + 4 * lane); p += (v[u][j][0] * w[0] + v[u][j][1] * w[1]) + (v[u][j][2] * w[2] + v[u][j][3] * w[3]); }
                e[o] = wave_sum(p) + be[gs * 4 + o]; }
            int i1 = 0; float v1 = e[0]; if (e[1] > v1) { v1 = e[1]; i1 = 1; } if (e[2] > v1) { v1 = e[2]; i1 = 2; } if (e[3] > v1) { v1 = e[3]; i1 = 3; }
            int i2 = -1; float v2 = -INFINITY;
#pragma unroll
            for (int i = 0; i < 4; ++i) if (i != i1 && (i2 < 0 || e[i] > v2)) { v2 = e[i]; i2 = i; }
            const float e2 = __builtin_amdgcn_exp2f((v2 - v1) * LOG2E), w1 = gate * __builtin_amdgcn_rcpf(1.0f + e2), w2 = gate - w1;
            if (lane == 0) { const int ea = gs * 4 + i1, eb = gs * 4 + i2;
                const int pa = (int)__hip_atomic_fetch_add(lcnt + ea, 1u, __ATOMIC_RELAXED, __HIP_MEMORY_SCOPE_WORKGROUP), pb = (int)__hip_atomic_fetch_add(lcnt + eb, 1u, __ATOMIC_RELAXED, __HIP_MEMORY_SCOPE_WORKGROUP);
                *(GAS v4i*)(route + (size_t)m * 4) = (v4i){ea, eb, pa, pb}; routew[m] = (f32x2){w1, w2}; statf[m] = (f32x2){mean[u], rstd[u]}; } }
        };
    v2u va[RB][4], vb[RB][4];
    rows_load(va, gw);
    for (int m0 = gw; m0 < T; m0 += 2 * RB * NGW) { const int m1 = m0 + RB * NGW, m2 = m0 + 2 * RB * NGW;
        if (m1 < T) rows_load(vb, m1);
        rows_body(va, m0);
        if (m1 < T) { if (m2 < T) rows_load(va, m2); rows_body(vb, m1); }
    }
    __syncthreads();
    if (tid < 16) WSP(int, WS_WGB)[F.vcu * 16 + tid] = (int)__hip_atomic_fetch_add(cnt + tid * 64, lcnt[tid], RLX_AGENT);
}
__device__ __forceinline__ void moe_index(Frame& F, int layer) {
    PHASE_IDS();
    gu32* cnt = F.ctl + CW_CNT + layer * 16 * 64;
    int c[16], off[16]; int acc = 0;
#pragma unroll
    for (int e = 0; e < 16; ++e) { c[e] = (int)__hip_atomic_load(cnt + e * 64, RLX_AGENT); off[e] = acc; acc += ((c[e] + 255) >> 8) << 8; }
    int* rowidx = WSP(int, WS_ROWIDX); float* wsort = WSP(float, WS_WSORT); int* tile_e = WSP(int, WS_TILEE); int* pos2 = WSP(int, WS_POS2);
    const int* route = WSP(int, WS_ROUTE); const f32x2* routew = WSP(f32x2, WS_ROUTEW);
    const int gt = F.vcu * (NWAVES * 64) + tid, NGT = F.G * NWAVES * 64;
    for (int t = gt; t < T; t += NGT) { const v4i r = *(const GAS v4i*)(route + (size_t)t * 4); const f32x2 w = routew[t];
        int oa = 0, ob = 0;
#pragma unroll
        for (int e = 0; e < 16; ++e) { oa = r[0] == e ? off[e] : oa; ob = r[1] == e ? off[e] : ob; }
        const int* wgb = WSP(int, WS_WGB) + ((t & (F.G * NWAVES - 1)) >> 3) * 16;
        const int ra = oa + wgb[r[0]] + r[2], rb = ob + wgb[r[1]] + r[3];
        rowidx[ra] = t; wsort[ra] = w[0]; rowidx[rb] = t; wsort[rb] = w[1]; pos2[2 * t] = ra; pos2[2 * t + 1] = rb; }
    if (F.vcu == 0) {
#pragma unroll
        for (int e = 0; e < 16; ++e) { const int pad = (((c[e] + 255) >> 8) << 8) - c[e];
            for (int i = tid; i < pad; i += NWAVES * 64) { rowidx[off[e] + c[e] + i] = 0; wsort[off[e] + c[e] + i] = 0.f; }
            for (int i = tid; i < ((c[e] + 255) >> 8); i += NWAVES * 64) tile_e[16 + (off[e] >> 8) + i] = e; }
        if (tid == 0) tile_e[0] = acc >> 8;
    }
}
struct MoeOrder {
    const int* tile_e; int ntiles, G, c; long wstride; int nn;
    __device__ bool next(int i, pg8::Unit& u) const {
        const long L = (long)i * G + c; if (L >= (long)ntiles * nn) return false;
        const int rt = (int)(L / nn), pn = (int)(L % nn), e = tile_e[16 + rt];
        u.pm = rt; u.pn = pn; u.e = e; u.aoff = 0; u.boff = (long)e * wstride + (long)pn * 256 * (wstride / 1024); return true;
    }
};
__device__ __forceinline__ void moe_combine(Frame& F, int layer) {
    PHASE_IDS();
    const int gw = F.vcu * NWAVES + wave, NGW = F.G * NWAVES;
    float* pre = F.out; const float* g = ld_in(I_LNG) + (layer * 3 + 1) * 1024; const float* b = ld_in(I_LNB) + (layer * 3 + 1) * 1024;
    const float* g2 = ld_in(I_LNG) + (layer * 3 + 2) * 1024; const float* b2 = ld_in(I_LNB) + (layer * 3 + 2) * 1024;
    const f32x2* statf = WSP(f32x2, WS_STATF); const int* pos2 = WSP(int, WS_POS2); const bf16* Y = WSP(bf16, S_Y);
    bf16* preb = WSP(bf16, WS_PREB); float* stat_new = WSP(float, WS_STAT) + (size_t)((layer * 3 + 2) & 1) * T * 32;
    constexpr int RB = 4;
    for (int m0 = gw; m0 < T; m0 += RB * NGW) {
        v2u xv[RB][4]; v2u ya[RB][4], yb[RB][4]; f32x2 st[RB];
#pragma unroll
        for (int u = 0; u < RB; ++u) { const int m = m0 + u * NGW; st[u] = statf[m]; const int ra = pos2[2 * m], rb = pos2[2 * m + 1];
#pragma unroll
            for (int j = 0; j < 4; ++j) { xv[u][j] = *(const GAS v2u*)(preb + (size_t)m * 1024 + 256 * j + 4 * lane); ya[u][j] = *(const GAS v2u*)(Y + (size_t)ra * 1024 + 256 * j + 4 * lane); yb[u][j] = *(const GAS v2u*)(Y + (size_t)rb * 1024 + 256 * j + 4 * lane); } }
#pragma unroll
        for (int u = 0; u < RB; ++u) { const int m = m0 + u * NGW;
        GAS f32x4* xr = (GAS f32x4*)(pre + (size_t)m * 1024) + lane;
        f32x4 v[4]; float s = 0.f, s2 = 0.f;
#pragma unroll
        for (int j = 0; j < 4; ++j) { const f32x4 gj = *(const f32x4*)(g + 256 * j + 4 * lane), bj = *(const f32x4*)(b + 256 * j + 4 * lane);
            const f32x4 xf = (f32x4){bflo(xv[u][j].x), bfhi(xv[u][j].x), bflo(xv[u][j].y), bfhi(xv[u][j].y)};
            const f32x4 h = (xf - st[u][0]) * st[u][1] * gj + bj;
            const f32x4 y = (f32x4){bflo(ya[u][j].x) + bflo(yb[u][j].x), bfhi(ya[u][j].x) + bfhi(yb[u][j].x), bflo(ya[u][j].y) + bflo(yb[u][j].y), bfhi(ya[u][j].y) + bfhi(yb[u][j].y)};
            v[j] = h * ALPHA + y; s += (v[j][0] + v[j][1]) + (v[j][2] + v[j][3]); s2 += (v[j][0] * v[j][0] + v[j][1] * v[j][1]) + (v[j][2] * v[j][2] + v[j][3] * v[j][3]); }
        if (layer == 0) {
#pragma unroll
            for (int j = 0; j < 4; ++j) { v2u w; w.x = pk2(v[j][0], v[j][1]); w.y = pk2(v[j][2], v[j][3]); *(GAS v2u*)(preb + (size_t)m * 1024 + 256 * j + 4 * lane) = w; }
            s = wave_sum(s); s2 = wave_sum(s2);
            if (lane < 16) *(GAS f32x2*)(stat_new + (size_t)m * 32 + lane * 2) = lane == 0 ? (f32x2){s, s2} : (f32x2){0.f, 0.f};
        } else {
            const float mean = wave_sum(s) * (1.f / 1024.f); float q = 0.f;
#pragma unroll
            for (int j = 0; j < 4; ++j) { v[j] = v[j] - mean; q += (v[j][0] * v[j][0] + v[j][1] * v[j][1]) + (v[j][2] * v[j][2] + v[j][3] * v[j][3]); }
            const float rstd = 1.f / sqrtf(wave_sum(q) * (1.f / 1024.f) + LN_EPS);
#pragma unroll
            for (int j = 0; j < 4; ++j) { const f32x4 gj = *(const f32x4*)(g2 + 256 * j + 4 * lane), bj = *(const f32x4*)(b2 + 256 * j + 4 * lane); xr[64 * j] = v[j] * rstd * gj + bj; }
        } }
    }
}
__device__ __forceinline__ void dsa_prep(Frame& F) {
    PHASE_IDS();
    const int gw = F.vcu * NWAVES + wave, NGW = F.G * NWAVES;
    const bf16* bin = WSP(bf16, S_BIN); bf16* cq = WSP(bf16, S_CQ); bf16* kvl = WSP(bf16, S_KVL); bf16* kidx = WSP(bf16, S_KIDX); float* widx = WSP(float, S_WIDX);
    const float* r16 = WSP(float, WS_ROT16); const float* r32 = WSP(float, WS_ROT32);
    const f32x4 gq = *(const f32x4*)(ld_in(I_BQG) + 4 * lane), gk = *(const f32x4*)(ld_in(I_BKVG) + 4 * lane);
    constexpr int RB = 4;
    for (int m0 = gw; m0 < T; m0 += RB * NGW) {
        f32x4 av[RB], cv[RB]; float x1v[RB], x2v[RB], c32v[RB], s32v[RB], xkv[RB], pkv[RB], c16v[RB], s16v[RB], wwv[RB];
#pragma unroll
        for (int u = 0; u < RB; ++u) { const int m = m0 + u * NGW; const bf16* row = bin + (size_t)m * BIN_LD;
            { const v2u aw = *(const GAS v2u*)(row + 4 * lane), cw = *(const GAS v2u*)(row + 256 + 4 * lane);
              av[u] = (f32x4){bflo(aw.x), bfhi(aw.x), bflo(aw.y), bfhi(aw.y)}; cv[u] = (f32x4){bflo(cw.x), bfhi(cw.x), bflo(cw.y), bfhi(cw.y)}; }
            x1v[u] = bf2f(row[512 + (lane & 15)]); x2v[u] = bf2f(row[528 + (lane & 15)]); c32v[u] = r32[(size_t)m * 32 + 2 * (lane & 15)]; s32v[u] = r32[(size_t)m * 32 + 2 * (lane & 15) + 1];
            xkv[u] = bf2f(row[544 + lane]); pkv[u] = bf2f(row[544 + ((lane ^ 8) & 63)]); c16v[u] = r16[(size_t)m * 16 + 2 * (lane & 7)]; s16v[u] = r16[(size_t)m * 16 + 2 * (lane & 7) + 1]; wwv[u] = bf2f(row[608 + (lane & 15)]); }
#pragma unroll
        for (int u = 0; u < RB; ++u) { const int m = m0 + u * NGW; const f32x4 a = av[u], c = cv[u];
        const float sa = wave_sum((a[0] * a[0] + a[1] * a[1]) + (a[2] * a[2] + a[3] * a[3])), sc = wave_sum((c[0] * c[0] + c[1] * c[1]) + (c[2] * c[2] + c[3] * c[3]));
        const float ra = 1.f / sqrtf(sa * (1.f / 256.f) + LN_EPS), rc = 1.f / sqrtf(sc * (1.f / 256.f) + LN_EPS);
        v2u w; w.x = pk2(a[0] * ra * gq[0], a[1] * ra * gq[1]); w.y = pk2(a[2] * ra * gq[2], a[3] * ra * gq[3]); *(GAS v2u*)(cq + (size_t)m * 256 + 4 * lane) = w;
        w.x = pk2(c[0] * rc * gk[0], c[1] * rc * gk[1]); w.y = pk2(c[2] * rc * gk[2], c[3] * rc * gk[3]); *(GAS v2u*)(kvl + (size_t)m * KVW + 4 * lane) = w;
        if (lane < 16) { const float x1 = x1v[u], x2 = x2v[u], cs = c32v[u], sn = s32v[u];
            kvl[(size_t)m * KVW + 256 + lane] = (bf16)f2bf(x1 * cs - x2 * sn); kvl[(size_t)m * KVW + 272 + lane] = (bf16)f2bf(x2 * cs + x1 * sn); }
        { const float x = xkv[u]; float o = x; const float p = pkv[u];
          if (lane < 16) { const float cs = c16v[u], sn = s16v[u]; o = lane < 8 ? x * cs - p * sn : x * cs + p * sn; }
          kidx[(size_t)m * 64 + lane] = (bf16)f2bf(o); }
        if (lane < 16) widx[(size_t)m * 16 + lane] = wwv[u] * 0.03125f; }
    }
    for (int i = F.vcu * (NWAVES * 64) + tid; i < NB * 256 * TOPK; i += F.G * NWAVES * 64) { const int bb = i >> 16, s = (i >> 8) & 255, j = i & 255; WSP(unsigned short, S_IDX)[((size_t)bb * SEQ + s) * TOPK + j] = (unsigned short)j; }
}
struct bfrx { bf16x8 f[4]; };
__device__ __forceinline__ float relu_s(float x) { float r; asm("v_max_f32_e32 %0, 0, %1" : "=v"(r) : "v"(x)); return r; }
__device__ __forceinline__ float fma_s(float a, float b, float c) { float r; asm("v_fma_f32 %0, %1, %2, %3" : "=v"(r) : "v"(a), "v"(b), "v"(c)); return r; }
__device__ __forceinline__ void lds_add(LAS unsigned* p, unsigned v) { asm volatile("ds_add_u32 %0, %1" :: "v"((unsigned)(unsigned long)p), "v"(v) : "memory"); }
__device__ __forceinline__ unsigned pk_max_u16(unsigned a, unsigned b) { unsigned r; asm("v_pk_max_u16 %0, %1, %2" : "=v"(r) : "v"(a), "v"(b)); return r; }
__device__ __forceinline__ unsigned pk_min_u16(unsigned a, unsigned b) { unsigned r; asm("v_pk_min_u16 %0, %1, %2" : "=v"(r) : "v"(a), "v"(b)); return r; }
template <int CTRL> __device__ __forceinline__ unsigned dpp_u(unsigned x) { return (unsigned)__builtin_amdgcn_update_dpp((int)x, (int)x, CTRL, 0xf, 0xf, false); }
__device__ __forceinline__ unsigned half_min_pk(unsigned x) {
    x = pk_min_u16(x, dpp_u<0xB1>(x)); x = pk_min_u16(x, dpp_u<0x4E>(x)); x = pk_min_u16(x, dpp_u<0x141>(x)); x = pk_min_u16(x, dpp_u<0x140>(x));
    return pk_min_u16(x, (unsigned)__shfl_xor((int)x, 16));
}
__device__ __forceinline__ float relu_v(float x) { float r; asm volatile("v_max_f32_e32 %0, 0, %1" : "=v"(r) : "v"(x)); return r; }
__device__ __forceinline__ float fma_v(float a, float b, float c) { float r; asm volatile("v_fma_f32 %0, %1, %2, %3" : "=v"(r) : "v"(a), "v"(b), "v"(c)); return r; }
__device__ __forceinline__ unsigned fkey(float x) { const unsigned u = __float_as_uint(x + 0.0f); return (u & 0x80000000u) ? ~u : (u | 0x80000000u); }
__device__ __forceinline__ unsigned wave_excl_prefix(unsigned x, int lane, unsigned& total) {
    unsigned v = x;
#pragma unroll
    for (int d = 1; d < 64; d <<= 1) { const unsigned y = __shfl_up(v, d); if (lane >= d) v += y; }
    total = (unsigned)__builtin_amdgcn_readlane((int)v, 63); return v - x;
}
template <int NP>
__device__ __forceinline__ void topk16_select(const unsigned short* sc16, int n, unsigned short* out, LAS unsigned* h0, LAS unsigned* hw, LAS unsigned short* cidx, LAS float* csc,
                                              const bf16* qrow, const bf16* KI, const float* wrow, int lane, const unsigned th16) {
    unsigned kp[NP * 4];
    int l8 = 8 * lane;
#pragma unroll
    for (int i = 0; i < NP; ++i) { const v4u v = *(const GAS v4u*)(sc16 + 512 * i + 8 * lane);
        if ((i & 3) == 0) asm volatile("" : "+v"(l8));
        const unsigned m = (512 * i + l8 < n) ? 0xffffffffu : 0u;
        kp[4 * i] = v.x & m; kp[4 * i + 1] = v.y & m; kp[4 * i + 2] = v.z & m; kp[4 * i + 3] = v.w & m; }
    const unsigned ninv = (unsigned)(NP * 512 - n);
    unsigned want = TOPK, T = 0u;
#pragma unroll
    for (int pass = 0; pass < 2; ++pass) {
        LAS unsigned* hist = pass == 0 ? h0 : hw;
        if (pass == 1) {
            *(LAS v4u*)(hw + 4 * lane) = (v4u){0u, 0u, 0u, 0u};
            LDS_WAIT();
#pragma unroll
            for (int i = 0; i < NP * 4; ++i) {
#pragma unroll
                for (int hf = 0; hf < 2; ++hf) { const unsigned k = hf ? kp[i] >> 16 : kp[i] & 0xffffu;
                    if ((k >> 8) == T && k >= th16) __hip_atomic_fetch_add(hw + (k & 255u), 1u, __ATOMIC_RELAXED, __HIP_MEMORY_SCOPE_WORKGROUP); } }
            LDS_WAIT();
        }
        v4u c4;
        if (pass == 0) {
            const v4u a = *(const LAS v4u*)(h0 + 8 * lane), e = *(const LAS v4u*)(h0 + 8 * lane + 4);
            c4.x = ((a.x & 0xffffu) + (a.y & 0xffffu)) + ((a.z & 0xffffu) + (a.w & 0xffffu)); c4.y = ((a.x >> 16) + (a.y >> 16)) + ((a.z >> 16) + (a.w >> 16));
            c4.z = ((e.x & 0xffffu) + (e.y & 0xffffu)) + ((e.z & 0xffffu) + (e.w & 0xffffu)); c4.w = ((e.x >> 16) + (e.y >> 16)) + ((e.z >> 16) + (e.w >> 16));
        } else c4 = *(const LAS v4u*)(hist + 4 * lane);
        const unsigned tl = c4.x + c4.y + c4.z + c4.w; unsigned S = tl;
#pragma unroll
        for (int d = 1; d < 64; d <<= 1) { const unsigned v = __shfl_down(S, d); if (lane + d < 64) S += v; }
        const unsigned long long bal = __ballot(S >= want);
        const int L = 63 - __clzll(bal | 1ull);
        const unsigned above = __shfl(S - tl, L), c1 = __shfl(c4.y, L), c2 = __shfl(c4.z, L), c3 = __shfl(c4.w, L);
        unsigned cum = above; int d;
        if (cum + c3 >= want) d = 3; else { cum += c3; if (cum + c2 >= want) d = 2; else { cum += c2; if (cum + c1 >= want) d = 1; else { cum += c1; d = 0; } } }
        want -= cum; T = pass == 0 ? (unsigned)(4 * L + d) : ((T << 8) | (unsigned)(4 * L + d));
    }
    if (lane == 0) { hw[0] = 0u; hw[1] = 0u; }
    LDS_WAIT();
    int l4 = 8 * lane;
#pragma unroll
    for (int i = 0; i < NP * 4; ++i) { if ((i & 7) == 0) asm volatile("" : "+v"(l4));
#pragma unroll
        for (int hf = 0; hf < 2; ++hf) { const unsigned k = hf ? kp[i] >> 16 : kp[i] & 0xffffu; const int idx = 512 * (i >> 2) + l4 + 2 * (i & 3) + hf;
            if (k >= T) {
                if (k > T) { const unsigned pos = __hip_atomic_fetch_add(hw, 1u, __ATOMIC_RELAXED, __HIP_MEMORY_SCOPE_WORKGROUP); out[pos] = (unsigned short)idx; }
                else { const unsigned cp = __hip_atomic_fetch_add(hw + 1, 1u, __ATOMIC_RELAXED, __HIP_MEMORY_SCOPE_WORKGROUP); if (cp < 512u) cidx[cp] = (unsigned short)idx; } } }
        if ((i & 7) == 7) asm volatile("" ::: "memory"); }
    LDS_WAIT();
    const unsigned nab = (unsigned)__builtin_amdgcn_readfirstlane((int)hw[0]), c = (unsigned)__builtin_amdgcn_readfirstlane((int)hw[1]);
    if (c == want) { for (unsigned jj = lane; jj < c; jj += 64) out[nab + jj] = cidx[jj]; }
    else if (c <= 512u) {
        const int hh = lane >> 2, dq = lane & 3; const float wh = wrow[hh];
        const v4u q0 = *(const GAS v4u*)(qrow + hh * 64 + 16 * dq), q1 = *(const GAS v4u*)(qrow + hh * 64 + 16 * dq + 8);
        for (unsigned jj = 0; jj < c; ++jj) { const int idx = (int)cidx[jj]; const bf16* kr = KI + (size_t)idx * 64 + 16 * dq;
            const v4u k0 = *(const GAS v4u*)kr, k1 = *(const GAS v4u*)(kr + 8);
            float dsum = ((bflo(q0.x) * bflo(k0.x) + bfhi(q0.x) * bfhi(k0.x)) + (bflo(q0.y) * bflo(k0.y) + bfhi(q0.y) * bfhi(k0.y))) + ((bflo(q0.z) * bflo(k0.z) + bfhi(q0.z) * bfhi(k0.z)) + (bflo(q0.w) * bflo(k0.w) + bfhi(q0.w) * bfhi(k0.w)))
                       + ((bflo(q1.x) * bflo(k1.x) + bfhi(q1.x) * bfhi(k1.x)) + (bflo(q1.y) * bflo(k1.y) + bfhi(q1.y) * bfhi(k1.y))) + ((bflo(q1.z) * bflo(k1.z) + bfhi(q1.z) * bfhi(k1.z)) + (bflo(q1.w) * bflo(k1.w) + bfhi(q1.w) * bfhi(k1.w)));
            dsum += dpp_f(dsum, dsum, 0xB1, 0xf); dsum += dpp_f(dsum, dsum, 0x4E, 0xf);
            const float sc = wave_sum(wh * fmaxf(dsum, 0.f)) * 0.25f;
            if (lane == 0) csc[jj] = sc; }
        LDS_WAIT();
        for (unsigned jj = lane; jj < c; jj += 64) { const float sj = csc[jj]; const unsigned ij = cidx[jj]; unsigned r = 0u;
            for (unsigned ii = 0; ii < c; ++ii) { const float si = csc[ii]; const unsigned ix = cidx[ii]; r += (si > sj || (si == sj && ix < ij)) ? 1u : 0u; }
            if (r < want) out[nab + r] = (unsigned short)ij; }
    } else {
        unsigned run = 0u; int l5 = 8 * lane;
#pragma unroll
        for (int i = 0; i < NP; ++i) { if ((i & 1) == 0) asm volatile("" : "+v"(l5));
            unsigned fl = 0u;
#pragma unroll
            for (int e = 0; e < 8; ++e) { const unsigned k = (e & 1) ? kp[4 * i + (e >> 1)] >> 16 : kp[4 * i + (e >> 1)] & 0xffffu; fl |= (k == T ? 1u : 0u) << e; }
            unsigned tot; unsigned base = run + wave_excl_prefix((unsigned)__popc(fl), lane, tot);
#pragma unroll
            for (int e = 0; e < 8; ++e) if ((fl >> e) & 1u) { if (base < want) out[nab + base] = (unsigned short)(512 * i + l5 + e); ++base; }
            run += tot; }
    }
    LDS_WAIT();
}
__device__ __forceinline__ void dsa_index(Frame& F) {
    PHASE_IDS();
    const int w = wave, b = F.vcu >> 5, iw = F.vcu & 31, r32 = lane & 31, hi = lane >> 5;
    const bf16* QI = WSP(bf16, S_QI) + (size_t)b * SEQ * 1024; const bf16* KI = WSP(bf16, S_KIDX) + (size_t)b * SEQ * 64; const float* WI = WSP(float, S_WIDX) + (size_t)b * SEQ * 16;
    unsigned short* IDX = WSP(unsigned short, S_IDX) + (size_t)b * SEQ * TOPK;
    unsigned short* sc = WSP(unsigned short, S_SC) + (size_t)F.vcu * 32 * SEQ;
    LAS unsigned* h4 = (LAS unsigned*)(F.lds + RING_OFF + w * 10240);
    LAS float* csc = (LAS float*)(h4 + 2048);
    LAS unsigned char* kb = F.lds + RING_OFF + 81920;
    for (int ui = 0; ui < 4; ++ui) {
        const int c = ui == 0 ? 127 - iw : (ui == 1 ? 64 + iw : (ui == 2 ? 63 - iw : iw));
        if (c < 4) continue;
        const int n = (c + 1) * 64, ntile = n / 32, nblk = (n + 255) >> 8;
        for (int sub = 0; sub < 2; ++sub) { const int qbase = c * 64 + sub * 32 + 4 * w;
            bf16x8 af[2][4]; float wv[2][16];
#pragma unroll
            for (int tt = 0; tt < 2; ++tt) { const int q = qbase + 2 * tt + ((r32 >> 2) & 1), head = (r32 & 3) + 4 * (r32 >> 3);
#pragma unroll
                for (int ks = 0; ks < 4; ++ks) af[tt][ks] = *(const GAS bf16x8*)(QI + (size_t)q * 1024 + head * 64 + 16 * ks + 8 * hi);
                const float* wp = WI + (size_t)(qbase + 2 * tt + hi) * 16;
#pragma unroll
                for (int j = 0; j < 4; ++j) { const f32x4 v = *(const GAS f32x4*)(wp + 4 * j); wv[tt][4 * j] = v[0]; wv[tt][4 * j + 1] = v[1]; wv[tt][4 * j + 2] = v[2]; wv[tt][4 * j + 3] = v[3]; } }
            unsigned short* scw = sc + (size_t)(4 * w) * SEQ;
            LAS unsigned* hq = h4 + hi * 512 + (lane & 3);
            for (int rp_ = 0; rp_ < P0REP(26); ++rp_) {
#pragma unroll
            for (int j = 0; j < 8; ++j) *(LAS v4u*)(h4 + 256 * j + 4 * lane) = (v4u){0u, 0u, 0u, 0u};
            LDS_WAIT();
#define IDX_DMA(j_) do { _Pragma("unroll") for (int p_ = 0; p_ < 4; ++p_) { const int kn_ = 256 * (j_) + 8 * (4 * w + p_) + (lane >> 3), kr_ = kn_ < n ? kn_ : n - 1, ch_ = (lane & 7) ^ (kn_ & 7); \
                __builtin_amdgcn_global_load_lds((const unsigned*)(KI + (size_t)kr_ * 64 + ch_ * 8), (LAS unsigned*)(kb + ((j_) & 1) * 32768 + (4 * w + p_) * 1024), 16, 0, 0); } } while (0)
#define IDX_LDF(ks_, t_) KF.f[ks_] = *(const LAS bf16x8*)(kb + (((t_) >> 3) & 1) * 32768 + (32 * ((t_) & 7) + r32) * 128 + (((2 * (ks_) + hi) ^ (r32 & 7)) << 4))
#define MF0(acc, a, b) asm volatile("v_mfma_f32_32x32x16_bf16 %0, %1, %2, 0" : "=&v"(acc) : "v"(a), "v"(b))
#define MFA(acc, a, b) asm volatile("v_mfma_f32_32x32x16_bf16 %0, %1, %2, %0" : "+v"(acc) : "v"(a), "v"(b))
#define VAL4(C, W, sa, sb, r) do { sa = fma_v(W[r], relu_v(C[r]), sa); sb = fma_v(W[(r) + 1], relu_v(C[(r) + 1]), sb); sa = fma_v(W[(r) + 2], relu_v(C[(r) + 2]), sa); sb = fma_v(W[(r) + 3], relu_v(C[(r) + 3]), sb); } while (0)
            IDX_DMA(0);
            if (nblk > 1) { IDX_DMA(1); asm volatile("s_waitcnt vmcnt(4)" ::: "memory"); } else asm volatile("s_waitcnt vmcnt(0)" ::: "memory");
            __builtin_amdgcn_s_barrier(); asm volatile("" ::: "memory");
            bfrx KF; f32x16 A0a, A0b, A1a, A1b;
#pragma unroll
            for (int ks = 0; ks < 4; ++ks) IDX_LDF(ks, 0);
            MF0(A0a, af[0][0], KF.f[0]); MF0(A0b, af[1][0], KF.f[0]); IDX_LDF(0, 1);
            MFA(A0a, af[0][1], KF.f[1]); MFA(A0b, af[1][1], KF.f[1]); IDX_LDF(1, 1);
            MFA(A0a, af[0][2], KF.f[2]); MFA(A0b, af[1][2], KF.f[2]); IDX_LDF(2, 1);
            MFA(A0a, af[0][3], KF.f[3]); MFA(A0b, af[1][3], KF.f[3]); IDX_LDF(3, 1);
#define IDX_STEP(t_, j_, Ca, Cb, Na, Nb) do { const int tq_ = (t_), t2_ = tq_ + 2 < ntile ? tq_ + 2 : tq_ + 1; \
                if (tq_ + 2 < ntile && ((tq_ + 2) & 7) == 0) { const int jn_ = (tq_ + 2) >> 3; asm volatile("s_waitcnt vmcnt(8) lgkmcnt(0)" ::: "memory"); __builtin_amdgcn_s_barrier(); asm volatile("" ::: "memory"); if (jn_ + 1 < nblk) IDX_DMA(jn_ + 1); } \
                float s0a = 0.f, s0b = 0.f, s1a = 0.f, s1b = 0.f; \
                if (tq_ + 1 < ntile) { \
                    MF0(Na, af[0][0], KF.f[0]); VAL4(Ca, wv[0], s0a, s0b, 0); MF0(Nb, af[1][0], KF.f[0]); IDX_LDF(0, t2_); VAL4(Cb, wv[1], s1a, s1b, 0); \
                    MFA(Na, af[0][1], KF.f[1]); VAL4(Ca, wv[0], s0a, s0b, 4); MFA(Nb, af[1][1], KF.f[1]); IDX_LDF(1, t2_); VAL4(Cb, wv[1], s1a, s1b, 4); \
                    MFA(Na, af[0][2], KF.f[2]); VAL4(Ca, wv[0], s0a, s0b, 8); MFA(Nb, af[1][2], KF.f[2]); IDX_LDF(2, t2_); VAL4(Cb, wv[1], s1a, s1b, 8); \
                    MFA(Na, af[0][3], KF.f[3]); VAL4(Ca, wv[0], s0a, s0b, 12); MFA(Nb, af[1][3], KF.f[3]); IDX_LDF(3, t2_); VAL4(Cb, wv[1], s1a, s1b, 12); \
                } else { VAL4(Ca, wv[0], s0a, s0b, 0); VAL4(Cb, wv[1], s1a, s1b, 0); VAL4(Ca, wv[0], s0a, s0b, 4); VAL4(Cb, wv[1], s1a, s1b, 4); VAL4(Ca, wv[0], s0a, s0b, 8); VAL4(Cb, wv[1], s1a, s1b, 8); VAL4(Ca, wv[0], s0a, s0b, 12); VAL4(Cb, wv[1], s1a, s1b, 12); } \
                const float s0 = s0a + s0b, s1 = s1a + s1b; const unsigned k0 = fkey(s0), k1 = fkey(s1); \
                scw[(size_t)hi * SEQ + 32 * tq_ + r32] = (unsigned short)(k0 >> 16); scw[(size_t)(2 + hi) * SEQ + 32 * tq_ + r32] = (unsigned short)(k1 >> 16); \
                RM[j_] = pk_max_u16(RM[j_], (k1 & 0xffff0000u) | (k0 >> 16)); \
                if (k0 >= (th << 16)) lds_add(hq + ((k0 >> 25) << 2), (k0 & 0x1000000u) ? 65536u : 1u);     \
                if (k1 >= (th & 0xffff0000u)) lds_add(hq + 1024 + ((k1 >> 25) << 2), (k1 & 0x1000000u) ? 65536u : 1u); \
            } while (0)
            unsigned RM[8], th = 0u;
#pragma unroll
            for (int j = 0; j < 8; ++j) RM[j] = 0u;
#define IDX_TH() do { th = half_min_pk(pk_min_u16(pk_min_u16(pk_min_u16(RM[0], RM[1]), pk_min_u16(RM[2], RM[3])), pk_min_u16(pk_min_u16(RM[4], RM[5]), pk_min_u16(RM[6], RM[7])))); } while (0)
            for (int t = 0; t < ntile; t += 8) {
                IDX_STEP(t, 0, A0a, A0b, A1a, A1b); IDX_STEP(t + 1, 1, A1a, A1b, A0a, A0b); if (t + 2 >= ntile) break;
                IDX_STEP(t + 2, 2, A0a, A0b, A1a, A1b); IDX_STEP(t + 3, 3, A1a, A1b, A0a, A0b); if (t + 4 >= ntile) break;
                IDX_STEP(t + 4, 4, A0a, A0b, A1a, A1b); IDX_STEP(t + 5, 5, A1a, A1b, A0a, A0b); if (t + 6 >= ntile) break;
                IDX_STEP(t + 6, 6, A0a, A0b, A1a, A1b); IDX_STEP(t + 7, 7, A1a, A1b, A0a, A0b);
                IDX_TH();
            }
            IDX_TH();
            if (r32 == 0) { F.MISC[16 + 4 * w + hi] = th & 0xffffu; F.MISC[16 + 4 * w + 2 + hi] = th >> 16; }
#undef IDX_TH
            asm volatile("s_waitcnt lgkmcnt(0)" ::: "memory"); __builtin_amdgcn_s_barrier(); asm volatile("" ::: "memory");
#undef IDX_STEP
#undef VAL4
#undef MFA
#undef MF0
#undef IDX_LDF
#undef IDX_DMA
            LDS_WAIT(); }
            VM_WAIT(); __builtin_amdgcn_fence(__ATOMIC_ACQUIRE, "agent"); VM_WAIT(); LDS_WAIT();
            for (int rp_ = 0; rp_ < P0REP(27); ++rp_)
            for (int qq = 0; qq < 4; ++qq) { const unsigned short* row = scw + (size_t)qq * SEQ; unsigned short* o = IDX + (size_t)(qbase + qq) * TOPK; LAS unsigned* h0 = h4 + 512 * qq; LAS unsigned* hw = h0; LAS unsigned short* cidx = (LAS unsigned short*)(h0 + 256);
                unsigned th16 = F.MISC[16 + 4 * w + qq]; th16 = th16 > 1u ? th16 : 1u;
                const bf16* qrow = QI + (size_t)(qbase + qq) * 1024; const float* wrow = WI + (size_t)(qbase + qq) * 16;
                if (n <= 2048) topk16_select<4>(row, n, o, h0, hw, cidx, csc, qrow, KI, wrow, lane, th16); else if (n <= 4096) topk16_select<8>(row, n, o, h0, hw, cidx, csc, qrow, KI, wrow, lane, th16);
                else if (n <= 6144) topk16_select<12>(row, n, o, h0, hw, cidx, csc, qrow, KI, wrow, lane, th16); else topk16_select<16>(row, n, o, h0, hw, cidx, csc, qrow, KI, wrow, lane, th16); }
        }
    }
}

__device__ __forceinline__ s16x4 tr16(LAS const unsigned char* p) { typedef short v4i16_t __attribute__((ext_vector_type(4))); return __builtin_bit_cast(s16x4, __builtin_amdgcn_ds_read_tr16_b64_v4i16((LAS v4i16_t*)p)); }
__device__ __forceinline__ void sparse_attn(Frame& F) {
    PHASE_IDS();
    const int w = wave, b = F.vcu >> 5, wb = (F.vcu & 31) * 8 + w, n16 = lane & 15, g = lane >> 4;
    constexpr int RS = 592;
    LAS unsigned char* tile = F.lds + RING_OFF + w * 19456;
    const bf16* QF = WSP(bf16, S_QF); const unsigned char* KV = (const unsigned char*)(WSP(bf16, S_KVL) + (size_t)b * SEQ * KVW);
    const unsigned short* IDX = WSP(unsigned short, S_IDX); bf16* OL = WSP(bf16, S_OL);
    const int trq = (n16 >> 2), trp = n16 & 3;
    for (int i = 0; i < 32; ++i) {
        const int s = wb + 256 * i; const size_t t = (size_t)b * SEQ + s;
        const int nv = ((s >> 6) + 1) * 64 < TOPK ? ((s >> 6) + 1) * 64 : TOPK, ntile = nv >> 5;
        bf16x8 qb[9]; { int qo = (n16 & 7) * KVW + 8 * g; asm volatile("" : "+v"(qo)); const bf16* qp = QF + t * (8 * KVW) + qo;
#pragma unroll
            for (int ks = 0; ks < 9; ++ks) qb[ks] = *(const GAS bf16x8*)(qp + 32 * ks); }
        float mrun = -INFINITY, lrun = 0.f;
        f32x4 o[16];
#pragma unroll
        for (int dt = 0; dt < 16; ++dt) o[dt] = (f32x4){0.f, 0.f, 0.f, 0.f};
        int koff[19];
        { const int mi = (int)IDX[t * TOPK + (lane & 31)];
#pragma unroll
          for (int j = 0; j < 19; ++j) { const int L = j * 1024 + lane * 16, row = L / RS; koff[j] = __shfl(mi, row & 31) * (KVW * 2); } }
        for (int tl = 0; tl < ntile; ++tl) {
#pragma unroll
            for (int j = 0; j < 19; ++j) { const int L = j * 1024 + lane * 16, row = L / RS, col = L - row * RS;
                const unsigned char* src = (col < KVW * 2 && row < 32) ? KV + (size_t)(unsigned)koff[j] + col : KV;
                __builtin_amdgcn_global_load_lds((const unsigned*)src, (LAS unsigned*)(tile + j * 1024), 16, 0, 0); }
            const int mi_n = (int)IDX[t * TOPK + 32 * (tl + 1 < ntile ? tl + 1 : tl) + (lane & 31)];
            asm volatile("s_waitcnt vmcnt(0)" ::: "memory");
            LDS_WAIT();
            f32x4 s0 = (f32x4){0.f, 0.f, 0.f, 0.f}, s1 = s0;
#pragma unroll
            for (int ks = 0; ks < 9; ++ks) { const bf16x8 a0 = *(const LAS bf16x8*)(tile + n16 * RS + (32 * ks + 8 * g) * 2), a1 = *(const LAS bf16x8*)(tile + (16 + n16) * RS + (32 * ks + 8 * g) * 2);
                s0 = __builtin_amdgcn_mfma_f32_16x16x32_bf16(a0, qb[ks], s0, 0, 0, 0); s1 = __builtin_amdgcn_mfma_f32_16x16x32_bf16(a1, qb[ks], s1, 0, 0, 0); }
            float mx = fmaxf(fmaxf(fmaxf(s0[0], s0[1]), fmaxf(s0[2], s0[3])), fmaxf(fmaxf(s1[0], s1[1]), fmaxf(s1[2], s1[3])));
            { auto r16 = __builtin_amdgcn_permlane16_swap(__float_as_uint(mx), __float_as_uint(mx), false, false); mx = fmaxf(__uint_as_float(r16[0]), __uint_as_float(r16[1]));
              auto r32 = __builtin_amdgcn_permlane32_swap(__float_as_uint(mx), __float_as_uint(mx), false, false); mx = fmaxf(__uint_as_float(r32[0]), __uint_as_float(r32[1])); }
            const float mnew = fmaxf(mrun, mx), alpha = __builtin_amdgcn_exp2f(mrun - mnew);
            float p0[4], p1[4], ps = 0.f;
#pragma unroll
            for (int r = 0; r < 4; ++r) { p0[r] = __builtin_amdgcn_exp2f(s0[r] - mnew); p1[r] = __builtin_amdgcn_exp2f(s1[r] - mnew); ps += p0[r] + p1[r]; }
            lrun = lrun * alpha + ps; mrun = mnew;
            v4u pw; pw.x = pg8::cvt_pk_bf16(p0[0], p0[1]); pw.y = pg8::cvt_pk_bf16(p0[2], p0[3]); pw.z = pg8::cvt_pk_bf16(p1[0], p1[1]); pw.w = pg8::cvt_pk_bf16(p1[2], p1[3]);
            const bf16x8 pa = __builtin_bit_cast(bf16x8, pw);
            float ar[4];
#pragma unroll
            for (int r = 0; r < 4; ++r) ar[r] = __shfl(alpha, 4 * g + r);
#pragma unroll
            for (int j = 0; j < 19; ++j) { const int L = j * 1024 + lane * 16, row = L / RS; koff[j] = __shfl(mi_n, row & 31) * (KVW * 2); }
#pragma unroll
            for (int dt = 0; dt < 16; ++dt) {
#pragma unroll
                for (int r = 0; r < 4; ++r) o[dt][r] *= ar[r];
                const s16x4 lo = tr16(tile + (4 * g + trq) * RS + (16 * dt + 4 * trp) * 2), hi4 = tr16(tile + (16 + 4 * g + trq) * RS + (16 * dt + 4 * trp) * 2);
                const bf16x8 vb = (bf16x8){lo[0], lo[1], lo[2], lo[3], hi4[0], hi4[1], hi4[2], hi4[3]};
                o[dt] = __builtin_amdgcn_mfma_f32_16x16x32_bf16(pa, vb, o[dt], 0, 0, 0); }
            LDS_WAIT();
        }
        lrun += __shfl_xor(lrun, 16); lrun += __shfl_xor(lrun, 32);
        const float linv = 1.0f / lrun; float li[4];
#pragma unroll
        for (int r = 0; r < 4; ++r) li[r] = __shfl(linv, 4 * g + r);
        if (g < 2) {
#pragma unroll
            for (int dt = 0; dt < 16; ++dt)
#pragma unroll
                for (int r = 0; r < 4; ++r) ((LAS bf16*)tile)[(4 * g + r) * 256 + 16 * dt + n16] = (bf16)f2bf(o[dt][r] * li[r]); }
        LDS_WAIT();
#pragma unroll
        for (int j = 0; j < 4; ++j) { const int c = lane + 64 * j; *(GAS v4u*)(OL + t * 2048 + c * 8) = *(const LAS v4u*)(tile + c * 16); }
        LDS_WAIT();
    }
}
#if !MK_DBG
#define DBG_AFTER_PHASE(p) do { } while (0)
#else
#define DBGK 256
__device__ __forceinline__ unsigned hsh(unsigned x) { x ^= x >> 16; x *= 0x7feb352du; x ^= x >> 15; x *= 0x846ca68bu; x ^= x >> 16; return x; }
__device__ __forceinline__ void err_max(unsigned char* ws, int id, float v) { if (!(v >= 0.f)) v = 1e30f; atomicMax((unsigned*)(ws + WS_CTL) + CW_ERR + id, __float_as_uint(v)); }
__device__ __forceinline__ float block_sum(float v, float* sh) { const int t = threadIdx.x; sh[t] = v; __syncthreads(); for (int o = DBGK / 2; o > 0; o >>= 1) { if (t < o) sh[t] += sh[t + o]; __syncthreads(); } const float r = sh[0]; __syncthreads(); return r; }
__device__ __forceinline__ float block_max(float v, float* sh) { const int t = threadIdx.x; sh[t] = v; __syncthreads(); for (int o = DBGK / 2; o > 0; o >>= 1) { if (t < o) sh[t] = fmaxf(sh[t], sh[t + o]); __syncthreads(); } const float r = sh[0]; __syncthreads(); return r; }
__device__ __forceinline__ void rope_cs(const int* pos, int t, int jj  , float& c, float& s) { const double a = (double)pos[t] * pow(500000.0, -(double)jj / 16.0); c = (float)cos(a); s = (float)sin(a); }
__device__ __forceinline__ void ln_row(const float* row, const float* g, const float* b, float* sh_h, float* sh) {
    const int t = threadIdx.x; float v[4], s = 0.f; for (int j = 0; j < 4; ++j) { v[j] = row[t + 256 * j]; s += v[j]; }
    const float mean = block_sum(s, sh) * (1.f / 1024.f); float q = 0.f; for (int j = 0; j < 4; ++j) { v[j] -= mean; q += v[j] * v[j]; }
    const float rstd = 1.f / sqrtf(block_sum(q, sh) * (1.f / 1024.f) + LN_EPS);
    for (int j = 0; j < 4; ++j) sh_h[t + 256 * j] = v[j] * rstd * g[t + 256 * j] + b[t + 256 * j];
    __syncthreads();
}
struct DArgs { const float* in[N_IN]; float* out; unsigned char* ws; int layer, pad; };
#define DWS(T_, off) ((T_*)(a.ws + (off)))
__global__ void __launch_bounds__(DBGK) chk_topk(DArgs a) {
    __shared__ float sc[SEQ]; __shared__ unsigned char sel[SEQ]; __shared__ float sh[DBGK]; __shared__ int cnt;
    const int smp = blockIdx.x, t = threadIdx.x, b = smp & 7; const int s = 256 + (hsh(smp * 7 + 1) % (SEQ - 256)), n = ((s >> 6) + 1) * 64; const size_t tok = (size_t)b * SEQ + s;
    const bf16* QI = DWS(bf16, S_QI) + tok * 1024; const bf16* KI = DWS(bf16, S_KIDX) + (size_t)b * SEQ * 64; const float* WI = DWS(float, S_WIDX) + tok * 16;
    for (int k = t; k < n; k += DBGK) { float acc = 0.f; for (int h = 0; h < 16; ++h) { float l = 0.f; for (int d = 0; d < 64; ++d) l += bf2f(QI[h * 64 + d]) * bf2f(KI[(size_t)k * 64 + d]); acc += WI[h] * fmaxf(l, 0.f); } sc[k] = acc; sel[k] = 0; }
    if (t == 0) cnt = 0; __syncthreads();
    const unsigned short* idx = DWS(unsigned short, S_IDX) + tok * TOPK;
    { const int k = idx[t]; bool ok = k < n; if (ok) { sel[k] = 1; } else atomicAdd(&cnt, 1000); }
    __syncthreads();
    int c = 0; float mn = 1e30f, mxu = -1e30f, lo = 1e30f, hi = -1e30f; for (int k = t; k < n; k += DBGK) { c += sel[k]; if (sel[k]) mn = fminf(mn, sc[k]); else mxu = fmaxf(mxu, sc[k]); lo = fminf(lo, sc[k]); hi = fmaxf(hi, sc[k]); }
    const float nsel = block_sum((float)c, sh), smin = -block_max(-mn, sh), umax = block_max(mxu, sh), rlo = -block_max(-lo, sh), rhi = block_max(hi, sh);
    if (t == 0) { float e = fmaxf(0.f, umax - smin) / (rhi - rlo + 1e-20f); if (nsel != 256.f || cnt != 0) e = 1e3f; err_max(a.ws, 1, e); }
}
__global__ void __launch_bounds__(DBGK) chk_sparse(DArgs a) {
    __shared__ float p[256]; __shared__ float sh[DBGK];
    const int smp = blockIdx.x, t = threadIdx.x, b = smp & 7; const int s = (smp < 16) ? (smp * 13) % 256 : hsh(smp * 11 + 3) % SEQ; const size_t tok = (size_t)b * SEQ + s;
    const int nv = ((s >> 6) + 1) * 64 < TOPK ? ((s >> 6) + 1) * 64 : TOPK;
    const bf16* QF = DWS(bf16, S_QF) + tok * 8 * KVW; const bf16* KV = DWS(bf16, S_KVL) + (size_t)b * SEQ * KVW; const unsigned short* idx = DWS(unsigned short, S_IDX) + tok * TOPK; const bf16* OL = DWS(bf16, S_OL) + tok * 2048;
    float emax = 0.f, omax = 0.f;
    for (int h = 0; h < 8; ++h) { float sc = -INFINITY; if (t < nv) { sc = 0.f; const bf16* kr = KV + (size_t)idx[t] * KVW; for (int d = 0; d < KVW; ++d) sc += bf2f(QF[h * KVW + d]) * bf2f(kr[d]); }
        const float m = block_max(sc, sh); const float e = t < nv ? exp2f(sc - m) : 0.f; const float l = block_sum(e, sh); p[t] = e / l; __syncthreads();
        float o = 0.f; for (int k = 0; k < nv; ++k) o += p[k] * bf2f(KV[(size_t)idx[k] * KVW + t]);
        emax = fmaxf(emax, fabsf(o - bf2f(OL[h * 256 + t]))); omax = fmaxf(omax, fabsf(o)); __syncthreads(); }
    const float e = block_max(emax, sh), o = block_max(omax, sh); if (t == 0) err_max(a.ws, 2, e / (o + 1e-20f));
}
__global__ void __launch_bounds__(DBGK) chk_x1p(DArgs a) {
    __shared__ float hrow[1024]; __shared__ float q[1024]; __shared__ float sh[DBGK];
    const int smp = blockIdx.x, t = threadIdx.x, L = a.layer; const size_t tok = hsh(smp * 5 + 9 + L) % T; const int b = (int)(tok / SEQ);
    ln_row(a.out + tok * 1024, a.in[I_LNG] + (L * 3) * 1024, a.in[I_LNB] + (L * 3) * 1024, hrow, sh);
    const float* W = a.in[I_XAWQ] + (size_t)L * 1048576;
    for (int j = 0; j < 4; ++j) { const int c = t + 256 * j; float o = 0.f; for (int k = 0; k < 1024; ++k) o += hrow[k] * W[(size_t)k * 1024 + c]; q[c] = o * XQS; }
    __syncthreads();
    const bf16* MK = DWS(bf16, WS_MK) + (size_t)b * 256 * 1024; const bf16* P = DWS(bf16, S_P) + tok * 1024; float emax = 0.f;
    for (int h = 0; h < 4; ++h) { float sc = 0.f; for (int d = 0; d < 256; ++d) sc += q[h * 256 + d] * bf2f(MK[(size_t)t * 1024 + h * 256 + d]);
        const float m = block_max(sc, sh); const float e = exp2f(sc - m); const float l = block_sum(e, sh); emax = fmaxf(emax, fabsf(e / l - bf2f(P[h * 256 + t]))); }
    const float e = block_max(emax, sh); if (t == 0) err_max(a.ws, 4, e * 16.f);
}
__global__ void __launch_bounds__(DBGK) chk_x4p(DArgs a, int salt) {
    __shared__ float hrow[1024]; __shared__ float ov[1024]; __shared__ float sh[DBGK];
    const int t = threadIdx.x, L = a.layer; const size_t tok = hsh(blockIdx.x * 29 + salt) % T; const int b = (int)(tok / SEQ); const float* snap = DWS(float, WS_SMALL) + 65536 + (size_t)blockIdx.x * 1024;
    ln_row(snap, a.in[I_LNG] + (L * 3) * 1024, a.in[I_LNB] + (L * 3) * 1024, hrow, sh);
    const bf16* P = DWS(bf16, S_P) + tok * 1024; const bf16* MV = DWS(bf16, WS_MVT) + (size_t)b * 256 * 1024;
    for (int j = 0; j < 4; ++j) { const int c = t + 256 * j, h = c >> 8; float o = 0.f; for (int m = 0; m < 256; ++m) o += bf2f(P[h * 256 + m]) * bf2f(MV[(size_t)m * 1024 + c]); ov[c] = o; }
    __syncthreads();
    const float* W = a.in[I_XAWOUT] + (size_t)L * 1048576; float emax = 0.f, omax = 0.f;
    for (int j = 0; j < 4; ++j) { const int c = t + 256 * j; float o = 0.f; for (int k = 0; k < 1024; ++k) o += ov[k] * W[(size_t)k * 1024 + c]; emax = fmaxf(emax, fabsf(ALPHA * hrow[c] + o - a.out[tok * 1024 + c])); omax = fmaxf(omax, fabsf(o)); }
    const float e = block_max(emax, sh), o = block_max(omax, sh); if (t == 0) err_max(a.ws, 3, e / (o + 1e-20f));
}
__global__ void __launch_bounds__(DBGK) chk_fold(DArgs a, int which  ) {
    __shared__ float hrow[1024]; __shared__ float sh[DBGK];
    const int smp = blockIdx.x, t = threadIdx.x; const size_t tok = hsh(smp * 3 + 17 + which + a.layer) % T;
    const int ln = which == 0 ? a.layer * 3 + 0 : 2;
    ln_row(a.out + tok * 1024, a.in[I_LNG] + ln * 1024, a.in[I_LNB] + ln * 1024, hrow, sh);
    float emax = 0.f, omax = 0.f;
    if (which == 0) { const float* W = a.in[I_XAWQ] + (size_t)a.layer * 1048576; const bf16* QX = DWS(bf16, S_QX) + tok * 1024;
        for (int j = 0; j < 4; ++j) { const int c = t + 256 * j; float o = 0.f; for (int k = 0; k < 1024; ++k) o += hrow[k] * W[(size_t)k * 1024 + c]; o *= XQS; emax = fmaxf(emax, fabsf(o - bf2f(QX[c]))); omax = fmaxf(omax, fabsf(o)); } }
    else { const float* W = a.in[I_BWIN]; const float* BIN = DWS(float, S_BIN) + tok * BIN_LD;
        for (int c = t; c < BIN_W; c += DBGK) { float o = 0.f; for (int k = 0; k < 1024; ++k) o += hrow[k] * W[(size_t)k * BIN_W + c]; emax = fmaxf(emax, fabsf(o - BIN[c])); omax = fmaxf(omax, fabsf(o)); } }
    const float e = block_max(emax, sh), o = block_max(omax, sh); if (t == 0) err_max(a.ws, 4 + which, e / (o + 1e-20f));
}
__global__ void __launch_bounds__(DBGK) chk_moe(DArgs a) {
    __shared__ float hrow[1024]; __shared__ float hid[512]; __shared__ float sh[DBGK]; __shared__ float lg[20]; __shared__ int se[2]; __shared__ float sw[2];
    const int smp = blockIdx.x, t = threadIdx.x, L = a.layer; const size_t tok = hsh(smp * 13 + 5 + L) % T;
    ln_row(a.out + tok * 1024, a.in[I_LNG] + (L * 3 + 1) * 1024, a.in[I_LNB] + (L * 3 + 1) * 1024, hrow, sh);
    for (int o = 0; o < 20; ++o) { float p = 0.f; for (int j = 0; j < 4; ++j) { const int k = t + 256 * j; p += hrow[k] * (o < 4 ? a.in[I_MWG][(size_t)L * 4096 + k * 4 + o] : a.in[I_MWE][(size_t)L * 16384 + k * 16 + (o - 4)]); }
        const float v = block_sum(p, sh); if (t == 0) lg[o] = v + (o < 4 ? a.in[I_MBG][L * 4 + o] : a.in[I_MBE][L * 16 + o - 4]); }
    __syncthreads();
    if (t == 0) { int gs = 0; for (int i = 1; i < 4; ++i) if (lg[i] > lg[gs]) gs = i; float den = 0.f; for (int i = 0; i < 4; ++i) den += expf(lg[i] - lg[gs]); const float gate = 1.f / den;
        const float* e = lg + 4 + gs * 4; int i1 = 0; for (int i = 1; i < 4; ++i) if (e[i] > e[i1]) i1 = i; int i2 = -1; for (int i = 0; i < 4; ++i) if (i != i1 && (i2 < 0 || e[i] > e[i2])) i2 = i;
        const float m = e[i1], z = expf(e[i1] - m) + expf(e[i2] - m); se[0] = gs * 4 + i1; se[1] = gs * 4 + i2; sw[0] = expf(e[i1] - m) / z * gate; sw[1] = expf(e[i2] - m) / z * gate; }
    __syncthreads();
    const int* route = DWS(int, WS_ROUTE) + tok * 4; const float* rw = DWS(float, WS_ROUTEW) + tok * 2; const int* pos2 = DWS(int, WS_POS2) + tok * 2;
    float emax = 0.f, omax = 0.f; float rerr = 0.f;
    if (route[0] != se[0] || route[1] != se[1]) rerr = 1e3f; rerr = fmaxf(rerr, fabsf(rw[0] - sw[0]) / sw[0]); rerr = fmaxf(rerr, fabsf(rw[1] - sw[1]) / sw[1]);
    if (DWS(int, WS_ROWIDX)[pos2[0]] != (int)tok || DWS(int, WS_ROWIDX)[pos2[1]] != (int)tok) rerr = 2e3f;
    for (int j = 0; j < 2; ++j) { const int e = se[j]; const float* Wg = a.in[I_MWGATE] + ((size_t)L * 16 + e) * 524288; const float* Wu = a.in[I_MWUP] + ((size_t)L * 16 + e) * 524288; const float* Wd = a.in[I_MWDOWN] + ((size_t)L * 16 + e) * 524288;
        for (int f = t; f < 512; f += DBGK) { float g = 0.f, u = 0.f; for (int k = 0; k < 1024; ++k) { g += hrow[k] * Wg[(size_t)k * 512 + f]; u += hrow[k] * Wu[(size_t)k * 512 + f]; } hid[f] = g / (1.f + expf(-g)) * u; }
        __syncthreads();
        const bf16* Y = DWS(bf16, S_Y) + (size_t)pos2[j] * 1024;
        for (int jj = 0; jj < 4; ++jj) { const int c = t + 256 * jj; float o = 0.f; for (int f = 0; f < 512; ++f) o += hid[f] * Wd[(size_t)f * 1024 + c]; o *= sw[j]; emax = fmaxf(emax, fabsf(o - bf2f(Y[c]))); omax = fmaxf(omax, fabsf(o)); }
        __syncthreads(); }
    const float e = block_max(emax, sh), o = block_max(omax, sh); if (t == 0) { err_max(a.ws, 6, e / (o + 1e-20f)); err_max(a.ws, 7, rerr); }
}
__global__ void __launch_bounds__(DBGK) chk_q2(DArgs a) {
    __shared__ float cq[256]; __shared__ float q[1024]; __shared__ float sh[DBGK];
    const int smp = blockIdx.x, t = threadIdx.x; const size_t tok = hsh(smp * 19 + 2) % T; const int* pos = (const int*)a.in[I_POS];
    cq[t] = bf2f(DWS(bf16, S_CQ)[tok * 256 + t]); __syncthreads();
    for (int j = 0; j < 4; ++j) { const int c = t + 256 * j; float o = 0.f; for (int k = 0; k < 256; ++k) o += cq[k] * a.in[I_BWUQ][(size_t)k * 1024 + c]; q[c] = o; }
    __syncthreads();
    float emax = 0.f, omax = 0.f; const bf16* QF = DWS(bf16, S_QF) + tok * 8 * KVW;
    for (int h = 0; h < 8; ++h) { float o = 0.f; for (int n = 0; n < 96; ++n) o += q[h * 128 + 32 + n] * a.in[I_BWUK][((size_t)h * 256 + t) * 96 + n]; o *= SC2;
        emax = fmaxf(emax, fabsf(o - bf2f(QF[h * KVW + t]))); omax = fmaxf(omax, fabsf(o));
        if (t < 32) { const int j = t & 15; float c, s; rope_cs(pos, (int)tok, j, c, s); const float x1 = q[h * 128 + j], x2 = q[h * 128 + 16 + j]; const float r = (t < 16 ? x1 * c - x2 * s : x2 * c + x1 * s) * SC2;
            emax = fmaxf(emax, fabsf(r - bf2f(QF[h * KVW + 256 + t]))); omax = fmaxf(omax, fabsf(r)); } }
    const float e = block_max(emax, sh), o = block_max(omax, sh); if (t == 0) err_max(a.ws, 8, e / (o + 1e-20f));
    __syncthreads();
    if (tok >= T / 4 + 64) { float e2 = 0.f, o2 = 0.f; const bf16* QI = DWS(bf16, S_QI) + tok * 1024;
        for (int j = 0; j < 4; ++j) { const int c = t + 256 * j; float o = 0.f; for (int k = 0; k < 256; ++k) o += cq[k] * a.in[I_BWQIDX][(size_t)k * 1024 + c]; q[c] = o; }
        __syncthreads();
        for (int j = 0; j < 4; ++j) { const int c = t + 256 * j, d = c & 63; float r = q[c]; if (d < 16) { float cs, sn; rope_cs(pos, (int)tok, 2 * (d & 7), cs, sn); r = d < 8 ? q[c] * cs - q[c + 8] * sn : q[c] * cs + q[c - 8] * sn; }
            e2 = fmaxf(e2, fabsf(r - bf2f(QI[c]))); o2 = fmaxf(o2, fabsf(r)); }
        const float ee = block_max(e2, sh), oo = block_max(o2, sh); if (t == 0) err_max(a.ws, 9, ee / (oo + 1e-20f)); }
}
__global__ void __launch_bounds__(DBGK) chk_prep(DArgs a) {
    __shared__ float sh[DBGK];
    const int smp = blockIdx.x, t = threadIdx.x; const size_t tok = hsh(smp * 23 + 4) % T; const float* row = DWS(float, S_BIN) + tok * BIN_LD; const int* pos = (const int*)a.in[I_POS];
    const float sa = block_sum(row[t] * row[t], sh), scv = block_sum(row[256 + t] * row[256 + t], sh); const float ra = 1.f / sqrtf(sa / 256.f + LN_EPS), rc = 1.f / sqrtf(scv / 256.f + LN_EPS);
    float e = fabsf(row[t] * ra * a.in[I_BQG][t] - bf2f(DWS(bf16, S_CQ)[tok * 256 + t])); e = fmaxf(e, fabsf(row[256 + t] * rc * a.in[I_BKVG][t] - bf2f(DWS(bf16, S_KVL)[tok * KVW + t])));
    if (t < 32) { const int j = t & 15; float c, s; rope_cs(pos, (int)tok, j, c, s); const float x1 = row[512 + j], x2 = row[528 + j]; const float r = t < 16 ? x1 * c - x2 * s : x2 * c + x1 * s; e = fmaxf(e, fabsf(r - bf2f(DWS(bf16, S_KVL)[tok * KVW + 256 + t]))); }
    if (t < 64) { float r = row[544 + t]; if (t < 16) { float c, s; rope_cs(pos, (int)tok, 2 * (t & 7), c, s); r = t < 8 ? row[544 + t] * c - row[552 + t] * s : row[544 + t] * c + row[536 + t] * s; } e = fmaxf(e, fabsf(r - bf2f(DWS(bf16, S_KIDX)[tok * 64 + t]))); }
    if (t < 16) e = fmaxf(e, 32.f * fabsf(row[608 + t] / 32.f - DWS(float, S_WIDX)[tok * 16 + t]));
    const float ee = block_max(e, sh); if (t == 0) err_max(a.ws, 10, ee);
}
__global__ void __launch_bounds__(DBGK) dbg_snap(DArgs a, int salt) { const size_t tok = hsh(blockIdx.x * 29 + salt) % T; float* snap = DWS(float, WS_SMALL) + 65536 + (size_t)blockIdx.x * 1024; for (int j = 0; j < 4; ++j) snap[threadIdx.x + 256 * j] = a.out[tok * 1024 + threadIdx.x + 256 * j]; }
__global__ void __launch_bounds__(DBGK) chk_b6(DArgs a, int salt) {
    __shared__ float hrow[1024]; __shared__ float ov[1024]; __shared__ float sh[DBGK];
    const int t = threadIdx.x; const size_t tok = hsh(blockIdx.x * 29 + salt) % T; const float* snap = DWS(float, WS_SMALL) + 65536 + (size_t)blockIdx.x * 1024;
    ln_row(snap, a.in[I_LNG] + 2 * 1024, a.in[I_LNB] + 2 * 1024, hrow, sh);
    const bf16* OL = DWS(bf16, S_OL) + tok * 2048;
    for (int j = 0; j < 4; ++j) { const int c = t + 256 * j, h = c >> 7, v = c & 127; float o = 0.f; for (int r = 0; r < 256; ++r) o += bf2f(OL[h * 256 + r]) * a.in[I_BWUV][((size_t)h * 256 + r) * 128 + v]; ov[c] = o; }
    __syncthreads();
    float emax = 0.f, omax = 0.f;
    for (int j = 0; j < 4; ++j) { const int c = t + 256 * j; float o = 0.f; for (int k = 0; k < 1024; ++k) o += ov[k] * a.in[I_BWOUT][(size_t)k * 1024 + c]; const float ref = ALPHA * hrow[c] + o; emax = fmaxf(emax, fabsf(ref - a.out[tok * 1024 + c])); omax = fmaxf(omax, fabsf(o)); }
    const float e = block_max(emax, sh), o = block_max(omax, sh); if (t == 0) err_max(a.ws, 11, e / (o + 1e-20f));
}
__global__ void __launch_bounds__(DBGK) chk_m3(DArgs a, int salt) {
    __shared__ float hrow[1024]; __shared__ float sh[DBGK];
    const int t = threadIdx.x; const size_t tok = hsh(blockIdx.x * 29 + salt) % T; const float* snap = DWS(float, WS_SMALL) + 65536 + (size_t)blockIdx.x * 1024;
    ln_row(snap, a.in[I_LNG] + 1 * 1024, a.in[I_LNB] + 1 * 1024, hrow, sh);
    const int* pos2 = DWS(int, WS_POS2) + tok * 2; const bf16* Y = DWS(bf16, S_Y); float emax = 0.f, omax = 0.f;
    for (int j = 0; j < 4; ++j) { const int c = t + 256 * j; const float y = bf2f(Y[(size_t)pos2[0] * 1024 + c]) + bf2f(Y[(size_t)pos2[1] * 1024 + c]); emax = fmaxf(emax, fabsf(ALPHA * hrow[c] + y - a.out[tok * 1024 + c])); omax = fmaxf(omax, fabsf(y)); }
    const float e = block_max(emax, sh), o = block_max(omax, sh); if (t == 0) err_max(a.ws, 12, e / (o + 1e-20f));
}
__global__ void __launch_bounds__(DBGK) chk_attn(DArgs a) {
    __shared__ float sh[DBGK]; __shared__ float pm[DBGK];
    const int smp = blockIdx.x, t = threadIdx.x, b = smp & 7, hc = (smp >> 3) & 15; const int s = hsh(smp * 31 + 7) % SEQ; const size_t tok = (size_t)b * SEQ + s; const int n = ((s >> 6) + 1) * 64, c = hc & 1, h = hc >> 1;
    const bf16* Q = DWS(bf16, S_Q) + tok * 1024 + hc * 64; const bf16* K = DWS(bf16, S_K) + (size_t)b * SEQ * 1024 + hc * 64; const bf16* V = DWS(bf16, S_V) + (size_t)b * SEQ * 1024 + h * 128;
    const bf16* O = (c ? DWS(bf16, S_O1) : DWS(bf16, S_O0)) + tok * 1024 + h * 128;
    float m = -INFINITY; for (int k = t; k < n; k += DBGK) { float sc = 0.f; for (int d = 0; d < 64; ++d) sc += bf2f(Q[d]) * bf2f(K[(size_t)k * 1024 + d]); m = fmaxf(m, sc); }
    m = block_max(m, sh);
    float l = 0.f, o[128]; for (int d = 0; d < 128; ++d) o[d] = 0.f;
    float emax = 0.f, omax = 0.f;
    for (int d0 = 0; d0 < 128; d0 += 1) { float acc = 0.f, ll = 0.f; for (int k = t; k < n; k += DBGK) { float sc = 0.f; for (int d = 0; d < 64; ++d) sc += bf2f(Q[d]) * bf2f(K[(size_t)k * 1024 + d]); const float p = exp2f(sc - m); ll += p; acc += p * bf2f(V[(size_t)k * 1024 + d0]); }
        const float num = block_sum(acc, sh), den = block_sum(ll, sh); const float ref = num / den; emax = fmaxf(emax, fabsf(ref - bf2f(O[d0]))); omax = fmaxf(omax, fabsf(ref)); }
    (void)l; (void)o; (void)pm;
    if (t == 0) err_max(a.ws, 13, emax / (omax + 1e-20f));
}
__global__ void dbg_encode(DArgs a) {
    const float tol[16] = {0, 2e-3f, 0.03f, 0.03f, 0.03f, 0.03f, 0.03f, 1e-3f, 0.03f, 0.03f, 0.02f, 0.03f, 0.03f, 0.03f, 0, 0};
    const unsigned* err = (const unsigned*)(a.ws + WS_CTL) + CW_ERR; int bad = 0; float ev = 0.f;
#if MK_DBG >= 100
    bad = MK_DBG - 100; ev = __uint_as_float(err[bad]); const float f = 1.0f + fminf(100.f * (ev + 0.001f), 10.f);
#else
    for (int i = 1; i < 16; ++i) if (tol[i] > 0.f && __uint_as_float(err[i]) > tol[i]) { bad = i; break; }
    const float f = 1.0f + 0.1f * bad; (void)ev;
#endif
    for (size_t i = (size_t)blockIdx.x * blockDim.x + threadIdx.x; i < (size_t)T * D; i += (size_t)gridDim.x * blockDim.x) a.out[i] *= f;
}
static void dbg_after_phase(int p, const void* argsv, hipStream_t stream);
#define DBG_AFTER_PHASE(p) dbg_after_phase((p), (const void*)&a, stream)
#endif
struct XOrder {
    int vcu; long a_rt, a_h, b_b, b_h;
    __device__ bool next(int i, pg8::Unit& u) const {
        if (i >= 4) return false;
        const int idx = i * 32 + (vcu & 31), b = vcu >> 5, h = idx >> 5, rt = idx & 31;
        u.pm = b * 32 + rt; u.pn = h; u.e = 0; u.aoff = (long)(b * 32 + rt) * a_rt + h * a_h; u.boff = (long)b * b_b + (long)h * b_h; return true;
    }
};
struct MemOrder {
    int G, c;
    __device__ bool next(int i, pg8::Unit& u) const {
        const int L = i * G + c; if (L >= 64) return false;
        const int j = L >> 5, r = L & 31; u.e = j;
        u.pm = r >> 2; u.pn = r & 3; u.aoff = (long)WS_MEMB + (long)u.pm * 256 * 2048; u.boff = (long)W_MKV + (long)(j * 1024 + u.pn * 256) * 2048;
        return true;
    }
};
struct ProdOrder {
    int G, c, l;
    __device__ bool next(int i, pg8::Unit& u) const {
        const int L = i * G + c; if (L >= 256) return false;
        const int e = L >> 7, r = L & 127, t4 = r & 3, bh = r >> 2, b = bh >> 2, h = bh & 3; u.e = e;
        if (e == 0) { u.pm = bh; u.pn = t4; u.aoff = (long)WS_MK + ((long)b * 256 * 1024 + h * 256) * 2; u.boff = (long)W_XQ + (long)l * 2097152 + ((long)t4 * 256 * 1024 + h * 256) * 2; }
        else { u.pm = t4; u.pn = bh; u.aoff = (long)W_XO + (long)l * 2097152 + ((long)t4 * 256 * 1024 + h * 256) * 2; u.boff = (long)WS_MVT + ((long)b * 256 * 1024 + h * 256) * 2; }
        return true;
    }
};
struct XbOrder {
    int vcu; long b_b, b_pn;
    __device__ bool next(int i, pg8::Unit& u) const {
        if (i >= 4) return false;
        const int idx = i * 32 + (vcu & 31), b = vcu >> 5, rt = idx >> 2, pn = idx & 3;
        u.pm = b * 32 + rt; u.pn = pn; u.e = b; u.aoff = (long)u.pm * 256 * 1024 * 2; u.boff = (long)b * b_b + (long)pn * b_pn; return true;
    }
};
struct MoeOrderA : MoeOrder { long astride; __device__ bool next(int i, pg8::Unit& u) const { const bool ok = MoeOrder::next(i, u); if (ok) u.aoff = (long)u.pm * astride; return ok; } };

constexpr int NPH = 30;
struct Args { const float* in[N_IN]; float* out; unsigned char* ws; int ph_lo, ph_hi; };
static_assert(sizeof(Args) == (N_IN + 2) * 8 + 8, "Args has no holes");
extern __shared__ __attribute__((aligned(16))) unsigned char lds[];
__device__ __forceinline__ Frame make_frame(const int wave_s) {
    const CAS Args* a = (const CAS Args*)__builtin_amdgcn_kernarg_segment_ptr(); asm volatile("" : "+s"(a));
    Frame F;
    F.lds = (LAS unsigned char*)lds;
    F.MISC = (volatile LAS unsigned*)(F.lds + MISC_OFF);
    F.wave = wave_s;
    F.G = gridDim.x; { const int bx = blockIdx.x; F.vcu = (F.G % 8 == 0) ? (bx % 8) * (F.G / 8) + bx / 8 : bx; }
    F.ws = a->ws; F.ctl = (gu32*)(a->ws + WS_CTL); F.out = a->out;
    return F;
}
__device__ __forceinline__ void xattn_products(Frame& F, LAS unsigned char* ring, int l) {
    pg8::Gemm g{WSP(bf16, 0), WSP(bf16, 0), 1024, 1024, 256, nullptr}; ProdOrder S{F.G, F.vcu, l};
    epi::EpiMem E{WSP(bf16, S_WQK), (size_t)(S_WVO - S_WQK) / 2, 1024, 8192};
    pg8::gemm_phase<epi::EpiMem, ProdOrder>(ring, g, S, E, F.wave);
}
__device__ __forceinline__ void xattn_vectors(Frame& F, int l) {
    PHASE_IDS();
    const int gw = F.vcu * NWAVES + wave, NGW = F.G * NWAVES; float* dst = WSP(float, WS_SMALL) + SM_GWB; const float* bwq = WSP(float, WS_SMALL) + SM_GW + l * 2048 + 1024;
    for (int it = gw; it < 8192; it += NGW) { const int b = it >> 10, hm = it & 1023, h = hm >> 8, m = hm & 255;
        const bf16* wt = WSP(bf16, S_WQK) + (size_t)it * 1024;
        const v4u a = *(const GAS v4u*)(wt + lane * 16), c = *(const GAS v4u*)(wt + lane * 16 + 8);
        float sg = ((bflo(a.x) + bfhi(a.x)) + (bflo(a.y) + bfhi(a.y))) + ((bflo(a.z) + bfhi(a.z)) + (bflo(a.w) + bfhi(a.w))) + ((bflo(c.x) + bfhi(c.x)) + (bflo(c.y) + bfhi(c.y))) + ((bflo(c.z) + bfhi(c.z)) + (bflo(c.w) + bfhi(c.w)));
        const bf16* mk = WSP(bf16, WS_MK) + (size_t)(b * 256 + m) * 1024 + h * 256; const v2u kv = *(const GAS v2u*)(mk + 4 * lane); const f32x4 bq = *(const f32x4*)(bwq + h * 256 + 4 * lane);
        float sb = (bflo(kv.x) * bq[0] + bfhi(kv.x) * bq[1]) + (bflo(kv.y) * bq[2] + bfhi(kv.y) * bq[3]);
        sg = wave_sum(sg); sb = wave_sum(sb);
        if (lane == 0) { dst[it] = sg; dst[8192 + it] = sb; } }
}
template <int LO, int HI, int layer> __device__ __forceinline__ void layer_phases(const int wave_s);
template <int LO, int HI> __device__ __forceinline__ void run_phases(const int wave_s) {
    constexpr int lo = LO, hi = HI;
#ifndef MK_PHMASK
#define MK_PHMASK 0x3fffffffull
#endif
#define IN(k) (((MK_PHMASK >> ((k) < 14 ? (k) : ((k) >= 21 ? (k) - 16 : (k)))) & 1ull) && lo <= (k) && (k) < hi)
#ifndef MK_REP
#define MK_REP 0ull
#endif
#define REPS(k) (1 + (int)((MK_REP >> ((k) < 14 ? (k) : ((k) >= 21 ? (k) - 16 : (k)))) & 1ull))
#define SEAM(k) do { if (IN((k) + 1)) { XcdBarrier bar_; bar_.bar = (unsigned*)(F.ctl + CW_BAR); bar_.x = xb_xcc_id(); bar_.st = F.MISC + 8; bar_.wave = wave_s; xcd_barrier(bar_); } } while (0)
#define PRE (F.out)
#define PREB WSP(bf16, WS_PREB)
#define STAT0 WSP(float, WS_STAT)
#define STAT1 (WSP(float, WS_STAT) + (size_t)T * 32)
#define SMALL WSP(float, WS_SMALL)
#define PH_BEGIN() Frame F = make_frame(wave_s); LAS unsigned char* ring = F.lds + RING_OFF; const int bx = (int)blockIdx.x; (void)ring; (void)bx

    if (IN(0)) { PH_BEGIN(); for (int rep_ = 0; rep_ < REPS(0); ++rep_) { p0_prologue(F); } SEAM(0); }

    if constexpr (hi > 1 && lo < 14) layer_phases<LO, HI, 0>(wave_s);
    if constexpr (hi > 14) layer_phases<LO, HI, 1>(wave_s);
}
template <int LO, int HI, int layer> __device__ __forceinline__ void layer_phases(const int wave_s) {
    constexpr int lo = LO, hi = HI;
    {
        if constexpr (layer == 0) {
            if (IN(1)) { PH_BEGIN(); for (int rep_ = 0; rep_ < REPS(1); ++rep_) {
                { pg8::Gemm g{WSP(bf16, S_XB), WSP(bf16, W_QKV), 1024, 1024, 1024, nullptr}; pg8::StaticOrder S; S.init(T, 3072, 1024, 1024, F.G, bx);
                  epi::EpiHeads64 E{WSP(bf16, S_Q), (size_t)(S_K - S_Q) / 2, 2, WSP(float, WS_ROT16)};
                  static_assert(S_V - S_K == S_K - S_Q, "Q, K, V arrays at one stride");
                  pg8::gemm_phase<epi::EpiHeads64, pg8::StaticOrder>(ring, g, S, E, F.wave); }
                {
                  pg8::Gemm g{WSP(bf16, 0), WSP(bf16, 0), 1024, 1024, 1024, nullptr}; MemOrder S{F.G, F.vcu};
                  epi::EpiMem E{WSP(bf16, WS_MK), (size_t)(WS_MVT - WS_MK) / 2, 1024, 1024};
                  pg8::gemm_phase<epi::EpiMem, MemOrder>(ring, g, S, E, F.wave); }
                fold_vectors(F);
                } SEAM(1); }
            if (IN(2)) { PH_BEGIN(); for (int rep_ = 0; rep_ < REPS(2); ++rep_) {
                const attn_body::AttnTensors AT{(const attn_body::bf16*)WSP(bf16, S_Q), (const attn_body::bf16*)WSP(bf16, S_K), (const attn_body::bf16*)WSP(bf16, S_V), (attn_body::bf16*)WSP(bf16, S_O0), (attn_body::bf16*)WSP(bf16, S_O1)};
                attn_body::attn_phase<8>((char*)lds + RING_OFF, AT, F.vcu, F.wave);
                } SEAM(2); }
            if (IN(3)) { PH_BEGIN(); for (int rep_ = 0; rep_ < REPS(3); ++rep_) { diff_combine(F); xattn_products(F, ring, 0); } SEAM(3); }
            if (IN(4)) { PH_BEGIN(); for (int rep_ = 0; rep_ < REPS(4); ++rep_) {
                pg8::Gemm g{WSP(bf16, S_ON), WSP(bf16, W_O), 1024, 1024, 1024, nullptr}; pg8::StaticOrder S; S.init(T, 1024, 1024, 1024, F.G, bx);
                epi::EpiPre<0> E{ld_in(I_X), PRE, PREB, nullptr, STAT0, nullptr, nullptr};
                pg8::gemm_phase<epi::EpiPre<0>, pg8::StaticOrder>(ring, g, S, E, F.wave);
                xattn_vectors(F, 0);
                } SEAM(4); }
        } else {
            if (IN(14)) { PH_BEGIN(); for (int rep_ = 0; rep_ < REPS(14); ++rep_) {
                pg8::Gemm g{PREB, WSP(bf16, W_BIN), 1024, 1024, 1024, nullptr}; pg8::StaticOrder S; S.init(T, BIN_LD, 1024, 1024, F.G, bx);
                epi::EpiFold<false> E{STAT0, SMALL + SM_GW + 2 * 2048, SMALL + SM_GW + 2 * 2048 + 1024, WSP(bf16, S_BIN), BIN_LD};
                pg8::gemm_phase<epi::EpiFold<false>, pg8::StaticOrder>(ring, g, S, E, F.wave);
                } SEAM(14); }
            if (IN(15)) { PH_BEGIN(); for (int rep_ = 0; rep_ < REPS(15); ++rep_) { dsa_prep(F); xattn_products(F, ring, 1); } SEAM(15); }
            if (IN(16)) { PH_BEGIN(); for (int rep_ = 0; rep_ < REPS(16); ++rep_) {
                pg8::Gemm g{WSP(bf16, S_CQ), WSP(bf16, W_Q2) + 2304 * 256, 256, 256, 256, nullptr}; pg8::StaticOrder S; S.init(T, 1024, 256, 256, F.G, bx);
                epi::EpiHeads64 E{WSP(bf16, S_QI), 0, 1, WSP(float, WS_ROT16)};
                pg8::gemm_phase<epi::EpiHeads64, pg8::StaticOrder>(ring, g, S, E, F.wave);
                xattn_vectors(F, 1);
                } SEAM(16); }
            if (IN(17)) { PH_BEGIN(); for (int rep_ = 0; rep_ < REPS(17); ++rep_) { dsa_index(F); } SEAM(17); }
            if (IN(18)) { PH_BEGIN(); for (int rep_ = 0; rep_ < REPS(18); ++rep_) {
                pg8::Gemm g{WSP(bf16, S_CQ), WSP(bf16, W_Q2), 256, 256, 256, nullptr}; pg8::StaticOrder S; S.init(T, 2304, 256, 256, F.G, bx);
                epi::EpiQfull E{WSP(bf16, S_QF), WSP(float, WS_ROT32)};
                pg8::gemm_phase<epi::EpiQfull, pg8::StaticOrder>(ring, g, S, E, F.wave);
                } SEAM(18); }
            if (IN(19)) { PH_BEGIN(); for (int rep_ = 0; rep_ < REPS(19); ++rep_) { sparse_attn(F); } SEAM(19); }
            if (IN(20)) { PH_BEGIN(); for (int rep_ = 0; rep_ < REPS(20); ++rep_) {
                pg8::Gemm g{WSP(bf16, S_OL), WSP(bf16, W_UVO), 2048, 2048, 2048, nullptr}; pg8::StaticOrder S; S.init(T, 1024, 2048, 2048, F.G, bx);
                epi::EpiPre<1> E{PRE, PRE, PREB, STAT0, STAT1, ld_in(I_LNG) + 2 * 1024, ld_in(I_LNB) + 2 * 1024};
                pg8::gemm_phase<epi::EpiPre<1>, pg8::StaticOrder>(ring, g, S, E, F.wave);
                } SEAM(20); }
        }
        constexpr int px = layer == 0 ? 5 : 21;
#define st_mix (WSP(float, WS_STAT) + (size_t)(layer == 0 ? 0 : 1) * T * 32)
#define st_x (WSP(float, WS_STAT) + (size_t)(layer == 0 ? 1 : 0) * T * 32)
        if (IN(px)) { PH_BEGIN(); for (int rep_ = 0; rep_ < REPS(px); ++rep_) {
            pg8::Gemm g{PREB, WSP(bf16, S_WQK), 1024, 1024, 1024, nullptr};
            XbOrder S{F.vcu, 2097152L, 256L * 1024 * 2};
            epi::EpiFoldSoftmax E{st_mix, SMALL + SM_GWB, SMALL + SM_GWB + 8192, WSP(bf16, S_P), (LAS float*)(F.lds + XCH_OFF)};
            pg8::gemm_phase<epi::EpiFoldSoftmax, XbOrder>(ring, g, S, E, F.wave);
            } SEAM(px); }
        if (IN(px + 1)) { PH_BEGIN(); for (int rep_ = 0; rep_ < REPS(px + 1); ++rep_) {
            pg8::Gemm g{WSP(bf16, S_P), WSP(bf16, S_WVO), 1024, 8192, 1024, nullptr};
            XbOrder S{F.vcu, 1024L * 2, 256L * 8192 * 2};
            epi::EpiPre<1, false> E{PRE, PRE, PREB, st_mix, st_x, ld_in(I_LNG) + (layer * 3 + 0) * 1024, ld_in(I_LNB) + (layer * 3 + 0) * 1024};
            pg8::gemm_phase<epi::EpiPre<1, false>, XbOrder>(ring, g, S, E, F.wave);
            } SEAM(px + 3); }
        if (IN(px + 4)) { PH_BEGIN(); for (int rep_ = 0; rep_ < REPS(px + 4); ++rep_) { moe_route(F, layer); } SEAM(px + 4); }
        if (IN(px + 5)) { PH_BEGIN(); for (int rep_ = 0; rep_ < REPS(px + 5); ++rep_) { moe_index(F, layer); } SEAM(px + 5); }
        if (IN(px + 6)) { PH_BEGIN(); for (int rep_ = 0; rep_ < REPS(px + 6); ++rep_) {
            const int* tile_e = WSP(int, WS_TILEE);
            pg8::Gemm g{WSP(bf16, S_XH), WSP(bf16, W_GU) + (size_t)layer * 16 * 1048576, 1024, 1024, 1024, WSP(int, WS_ROWIDX)};
            MoeOrder S{tile_e, tile_e[0], F.G, F.vcu, 2L * 1048576, 4};
            epi::EpiGateUp E{WSP(bf16, S_HID)};
            pg8::gemm_phase<epi::EpiGateUp, MoeOrder, true>(ring, g, S, E, F.wave);
            } SEAM(px + 6); }
        if (IN(px + 7)) { PH_BEGIN(); for (int rep_ = 0; rep_ < REPS(px + 7); ++rep_) {
            const int* tile_e = WSP(int, WS_TILEE);
            pg8::Gemm g{WSP(bf16, S_HID), WSP(bf16, W_DN) + (size_t)layer * 16 * 524288, 512, 512, 512, nullptr};
            MoeOrderA S; S.tile_e = tile_e; S.ntiles = tile_e[0]; S.G = F.G; S.c = F.vcu; S.wstride = 1048576L; S.nn = 4; S.astride = 256L * 512 * 2;
            epi::EpiDown E{WSP(bf16, S_Y), WSP(float, WS_WSORT)};
            pg8::gemm_phase<epi::EpiDown, MoeOrderA>(ring, g, S, E, F.wave);
            } SEAM(px + 7); }
        if (IN(px + 8)) { PH_BEGIN(); for (int rep_ = 0; rep_ < REPS(px + 8); ++rep_) { moe_combine(F, layer); } if (layer == 0) SEAM(px + 8); }
    }
#undef IN
#undef SEAM
}
template <int LO, int HI> __global__ void __launch_bounds__(NWAVES * 64, 2) fwd(Args args) {
    const int wave_s = __builtin_amdgcn_readfirstlane((int)threadIdx.x >> 6);
    if constexpr (HI - LO > 1) {
        Frame F = make_frame(wave_s);
        if (wave_s == 0) ((LAS unsigned*)(F.lds + MISC_OFF))[__builtin_amdgcn_mbcnt_hi(~0u, __builtin_amdgcn_mbcnt_lo(~0u, 0u))] = 0u;
        __syncthreads();
        (void)xcd_barrier_post((unsigned*)(F.ctl + CW_BAR), F.MISC + 8, wave_s);
    }
    run_phases<LO, HI>(wave_s);
}

#if MK_DBG
static void dbg_after_phase(int p, const void* argsv, hipStream_t stream) {
    const Args& A = *(const Args*)argsv; DArgs a{}; for (int i = 0; i < N_IN; ++i) a.in[i] = A.in[i]; a.out = A.out; a.ws = A.ws; a.layer = p >= 14 ? 1 : 0; a.pad = 0;
    const dim3 g(64), b(DBGK);
    if (p == 2) hipLaunchKernelGGL(chk_attn, g, b, 0, stream, a);
    if (p == 14) hipLaunchKernelGGL(chk_fold, g, b, 0, stream, a, 1);
    if (p == 15) hipLaunchKernelGGL(chk_prep, g, b, 0, stream, a);
    if (p == 17) hipLaunchKernelGGL(chk_topk, g, b, 0, stream, a);
    if (p == 18) hipLaunchKernelGGL(chk_q2, g, b, 0, stream, a);
    if (p == 19) { hipLaunchKernelGGL(chk_sparse, g, b, 0, stream, a); hipLaunchKernelGGL(dbg_snap, g, b, 0, stream, a, 101); }
    if (p == 20) hipLaunchKernelGGL(chk_b6, g, b, 0, stream, a, 101);
    if (p == 5 || p == 21) { hipLaunchKernelGGL(chk_x1p, g, b, 0, stream, a); hipLaunchKernelGGL(dbg_snap, g, b, 0, stream, a, 303); }
    if (p == 6 || p == 22) hipLaunchKernelGGL(chk_x4p, g, b, 0, stream, a, 303);
    if (p == 12 || p == 28) { hipLaunchKernelGGL(chk_moe, g, b, 0, stream, a); if (p == 12) hipLaunchKernelGGL(dbg_snap, g, b, 0, stream, a, 202); }
    if (p == 13) hipLaunchKernelGGL(chk_m3, g, b, 0, stream, a, 202);
    if (p == NPH - 1) hipLaunchKernelGGL(dbg_encode, dim3(2048), dim3(256), 0, stream, a);
}
#endif
#if MK_PER_PHASE
template <int P> static void launch_phases(int grid, hipStream_t stream, Args a) {
    if constexpr (P < NPH) {
        static bool once = false; if (!once) { once = true; (void)hipFuncSetAttribute((const void*)fwd<P, P + 1>, hipFuncAttributeMaxDynamicSharedMemorySize, LDS_BYTES); }
        a.ph_lo = P; a.ph_hi = P + 1; hipLaunchKernelGGL((fwd<P, P + 1>), dim3(grid), dim3(NWAVES * 64), LDS_BYTES, stream, a); DBG_AFTER_PHASE(P);
        launch_phases<P + 1>(grid, stream, a);
    }
}
#endif
extern "C" void kernel_launch(void* const* d_in, const int* in_sizes, int n_in, void* d_out, int out_size, void* d_ws, size_t ws_size, hipStream_t stream) {
    static int grid = 0;
    if (grid == 0) {
        if (n_in != N_IN || in_sizes[0] != T * D || out_size != T * D || ws_size < WS_END) { fprintf(stderr, "kernel_launch: shape / workspace mismatch (n_in %d, in0 %d, out %d, ws %zu); nothing launched\n", n_in, n_in > 0 ? in_sizes[0] : -1, out_size, ws_size); grid = -1; return; }
#if !MK_PER_PHASE
        if (hipFuncSetAttribute((const void*)fwd<0, NPH>, hipFuncAttributeMaxDynamicSharedMemorySize, LDS_BYTES) != hipSuccess) { fprintf(stderr, "kernel_launch: hipFuncSetAttribute failed\n"); grid = -1; return; }
        int per_cu = 0;
        if (hipOccupancyMaxActiveBlocksPerMultiprocessor(&per_cu, (const void*)fwd<0, NPH>, NWAVES * 64, LDS_BYTES) != hipSuccess || per_cu < 1) fprintf(stderr, "kernel_launch: note: occupancy query reports %d workgroups per CU\n", per_cu);
        (void)hipGetLastError();
#endif
        grid = 256;
    }
    if (grid < 0) return;
    if (hipMemsetAsync((char*)d_ws + WS_CTL, 0, CTL_ZERO_BYTES, stream) != hipSuccess) { fprintf(stderr, "kernel_launch: hipMemsetAsync failed\n"); return; }
    Args a{};
    for (int i = 0; i < N_IN; ++i) a.in[i] = (const float*)d_in[i];
    a.out = (float*)d_out; a.ws = (unsigned char*)d_ws;
#if MK_PER_PHASE
    launch_phases<0>(grid, stream, a);
#else
    a.ph_lo = 0; a.ph_hi = NPH; hipLaunchKernelGGL((fwd<0, NPH>), dim3(grid), dim3(NWAVES * 64), LDS_BYTES, stream, a);
#endif
    const hipError_t le = hipPeekAtLastError();
    if (le != hipSuccess) fprintf(stderr, "kernel_launch: launch failed: %s\n", hipGetErrorName(le));
}
```

```cpp
#include <hip/hip_runtime.h>
#include <cstdio>
#include <cstdint>

#ifndef MK_PER_PHASE
#define MK_PER_PHASE 0
#endif
#ifndef MK_DBG
#define MK_DBG 0
#endif

#define GAS __attribute__((address_space(1)))
#define LAS __attribute__((address_space(3)))
typedef unsigned short bf16;
typedef unsigned v4u __attribute__((ext_vector_type(4)));
typedef unsigned v2u __attribute__((ext_vector_type(2)));
typedef int v4i __attribute__((ext_vector_type(4)));
typedef float f32x4 __attribute__((ext_vector_type(4)));
typedef float f32x2 __attribute__((ext_vector_type(2)));
typedef float f32x16 __attribute__((ext_vector_type(16)));
typedef short bf16x8 __attribute__((ext_vector_type(8)));
typedef short s16x4 __attribute__((ext_vector_type(4)));
typedef GAS unsigned gu32;
#define RLX_AGENT __ATOMIC_RELAXED, __HIP_MEMORY_SCOPE_AGENT
#define LDS_WAIT() asm volatile("s_waitcnt lgkmcnt(0)" ::: "memory")
#define VM_WAIT() asm volatile("s_waitcnt vmcnt(0)" ::: "memory")
__device__ __forceinline__ unsigned pk2(float lo, float hi) { unsigned r; asm("v_cvt_pk_bf16_f32 %0, %1, %2" : "=v"(r) : "v"(lo), "v"(hi)); return r; }
__device__ __forceinline__ unsigned f2bf(float f) { return pk2(f, 0.f) & 0xffffu; }
__device__ __forceinline__ float bf2f(unsigned short b) { return __builtin_bit_cast(float, (unsigned)b << 16); }
__device__ __forceinline__ float bflo(unsigned w) { return __builtin_bit_cast(float, w << 16); }
__device__ __forceinline__ float bfhi(unsigned w) { return __builtin_bit_cast(float, w & 0xffff0000u); }
__device__ __forceinline__ float dpp_f(float old, float x, const int ctrl, const int rmask) {
    switch (ctrl) {
        case 0xB1: return __builtin_bit_cast(float, __builtin_amdgcn_update_dpp(__builtin_bit_cast(int, old), __builtin_bit_cast(int, x), 0xB1, 0xf, 0xf, false));
        case 0x4E: return __builtin_bit_cast(float, __builtin_amdgcn_update_dpp(__builtin_bit_cast(int, old), __builtin_bit_cast(int, x), 0x4E, 0xf, 0xf, false));
        case 0x141: return __builtin_bit_cast(float, __builtin_amdgcn_update_dpp(__builtin_bit_cast(int, old), __builtin_bit_cast(int, x), 0x141, 0xf, 0xf, false));
        case 0x140: return __builtin_bit_cast(float, __builtin_amdgcn_update_dpp(__builtin_bit_cast(int, old), __builtin_bit_cast(int, x), 0x140, 0xf, 0xf, false));
        case 0x142: return __builtin_bit_cast(float, __builtin_amdgcn_update_dpp(__builtin_bit_cast(int, old), __builtin_bit_cast(int, x), 0x142, 0xa, 0xf, false));
        default: return __builtin_bit_cast(float, __builtin_amdgcn_update_dpp(__builtin_bit_cast(int, old), __builtin_bit_cast(int, x), 0x143, 0xc, 0xf, false));
    }
    (void)rmask;
}
__device__ __forceinline__ float wave_sum(float v) {
    v += dpp_f(v, v, 0xB1, 0xf);
    v += dpp_f(v, v, 0x4E, 0xf);
    v += dpp_f(v, v, 0x141, 0xf);
    v += dpp_f(v, v, 0x140, 0xf);
    v += dpp_f(0.f, v, 0x142, 0xa);
    v += dpp_f(0.f, v, 0x143, 0xc);
    return __builtin_bit_cast(float, __builtin_amdgcn_readlane(__builtin_bit_cast(int, v), 63));
}

constexpr int NB = 8, SEQ = 8192, D = 1024, T = NB * SEQ;
constexpr int MEML = 256, MEMROWS = NB * MEML;
constexpr int NEXP = 16, FF = 512;
constexpr int BIN_W = 624, BIN_LD = 768;
constexpr int KVW = 288;
constexpr int TOPK = 256;
constexpr float LN_EPS = 1e-5f;
constexpr float ALPHA = 1.41421356237309515f;
constexpr float LOG2E = 1.4426950408889634f;
constexpr float C2 = 0.125f * LOG2E;
constexpr float SC2 = 0.08838834764831845f * LOG2E;
constexpr float XQS = 0.0625f * LOG2E;
constexpr int MOE_ROWS = 2 * T + NEXP * 256;
constexpr int MOE_TILES = MOE_ROWS / 256;

constexpr size_t MiB = 1u << 20;
constexpr size_t WS_CTL = 0, CTL_ZERO_BYTES = 1 * MiB;
constexpr size_t WS_SMALL = 1 * MiB;
constexpr size_t WS_ROT16 = 2 * MiB;
constexpr size_t WS_ROT32 = 6 * MiB;
constexpr size_t WS_W = 16 * MiB;
constexpr size_t W_QKV = WS_W;
constexpr size_t W_O = W_QKV + 6 * MiB;
constexpr size_t W_MKV = W_O + 2 * MiB;
constexpr size_t W_XQ = W_MKV + 4 * MiB;
constexpr size_t W_XO = W_XQ + 4 * MiB;
constexpr size_t W_BIN = W_XO + 4 * MiB;
constexpr size_t W_Q2 = W_BIN + 2 * MiB;
constexpr size_t W_UVO = W_Q2 + 2 * MiB;
constexpr size_t W_GU = W_UVO + 4 * MiB;
constexpr size_t W_DN = W_GU + 64 * MiB;
constexpr size_t WS_W_END = W_DN + 32 * MiB;
constexpr size_t WS_PREB = 144 * MiB;
constexpr size_t WS_STAT = 272 * MiB;
constexpr size_t WS_MISC = 288 * MiB;
constexpr size_t WS_STATF = WS_MISC;
constexpr size_t WS_ROUTE = WS_STATF + T * 8;
constexpr size_t WS_ROUTEW = WS_ROUTE + (size_t)T * 16;
constexpr size_t WS_POS2 = WS_ROUTEW + (size_t)T * 8;
constexpr size_t WS_ROWIDX = WS_POS2 + (size_t)T * 8;
constexpr size_t WS_WSORT = WS_ROWIDX + (size_t)MOE_ROWS * 4;
constexpr size_t WS_TILEE = WS_WSORT + (size_t)MOE_ROWS * 4;
constexpr size_t WS_WGB = WS_TILEE + 4096;
constexpr size_t WS_MK = 292 * MiB;
constexpr size_t WS_MVT = 296 * MiB;
constexpr size_t WS_MEMB = 300 * MiB;
constexpr size_t WS_BIG = 304 * MiB;
constexpr size_t S_XB = WS_PREB, S_O0 = WS_BIG;
constexpr size_t S_Q = WS_BIG + 128 * MiB, S_ON = S_Q;
constexpr size_t S_K = WS_BIG + 256 * MiB, S_V = WS_BIG + 384 * MiB, S_O1 = WS_BIG + 512 * MiB;
constexpr size_t S_QX = WS_BIG, S_P = WS_BIG + 128 * MiB, S_OX = WS_BIG + 256 * MiB;
constexpr size_t S_XH = WS_BIG, S_HID = WS_BIG + 128 * MiB, S_Y = WS_BIG + 264 * MiB;
constexpr size_t S_KVL = WS_BIG;
constexpr size_t S_KIDX = S_KVL + 36 * MiB;
constexpr size_t S_WIDX = S_KIDX + 8 * MiB;
constexpr size_t S_IDX = S_WIDX + 4 * MiB;
constexpr size_t S_CQ = S_IDX + 32 * MiB;
constexpr size_t S_QF = S_CQ + 32 * MiB;
constexpr size_t S_SC = S_QF;
constexpr size_t S_QI = S_SC + 256 * MiB;
constexpr size_t S_OL = S_QF + 288 * MiB;
constexpr size_t S_BIN = S_QI + 128 * MiB;
constexpr size_t S_WQK = WS_BIG + 688 * MiB;
constexpr size_t S_WVO = WS_BIG + 704 * MiB;
constexpr size_t WS_END = WS_BIG + 720 * MiB;
static_assert(WS_W_END <= WS_PREB && (MOE_TILES + 16) * 4 <= 4096 && WS_WGB + 256 * 16 * 4 <= WS_MK, "ws map");
static_assert(S_BIN + (size_t)T * BIN_LD * 4 <= WS_END && S_OL + (size_t)T * 2048 * 2 <= WS_END && S_Y + (size_t)MOE_ROWS * 1024 * 2 <= WS_END && S_O1 + 128 * MiB <= WS_END, "ws map");
static_assert(S_HID + (size_t)MOE_ROWS * 512 * 2 <= S_Y && S_QF + (size_t)T * 8 * KVW * 2 <= S_OL && WS_END == 1024 * MiB, "ws map");
constexpr int SM_LAM = 0;
constexpr int SM_GW = 64;
constexpr int SM_GWB = 8192;
constexpr int CW_BAR = 4096;
constexpr int CW_CNT = 8192;
constexpr int CW_ERR = 16384;

constexpr int RING_OFF = 0, RING_BYTES = 131072;
constexpr int XCH_OFF = RING_BYTES;
constexpr int MISC_OFF = 160 * 1024 - 256;
constexpr int LDS_BYTES = 160 * 1024;
constexpr int NWAVES = 8;
namespace pg8 {
#define PG8_LAS __attribute__((address_space(3)))
typedef unsigned short bf16_t;
constexpr int BM = 256, BK = 64, HALF = 128, HTB = HALF * BK * 2  , STAGE_BYTES = 8 * HTB, NXCD = 8, WGM = 8;

__host__ __device__ __forceinline__ int lds_byte(int r, int c) { const int st = (r >> 4) * 2 + (c >> 5), rr = r & 15, cc = c & 31, ob = rr * 64 + cc * 2; return st * 1024 + (ob ^ (((ob >> 9) & 1) << 5)); }
__host__ __device__ __forceinline__ void stage_rc(int b, int& R, int& C) { const int st = b / 1024, sb = b % 1024, swz = sb ^ (((sb >> 9) & 1) << 5); R = (st >> 1) * 16 + swz / 64; C = (st & 1) * 32 + (swz % 64) / 2; }
__host__ __device__ __forceinline__ int perm32(int rho) { const int n = rho >> 4, i = rho & 15; return 8 * (i >> 2) + 4 * n + (i & 3); }

struct Unit { int pm, pn, e; long aoff, boff; };
struct Gemm { const bf16_t* A; const bf16_t* Bt; int lda, ldb, K; const int* gidx; };

struct StaticOrder {
    int nM, nN, nwg, G, c; long tsA, tsB;
    __device__ void init(int M, int N, int lda, int ldb, int G_, int c_) { nM = M / BM; nN = N / BM; nwg = nM * nN; G = G_; c = c_; tsA = (long)BM * lda * 2; tsB = (long)BM * ldb * 2; }
    __device__ bool next(int i, Unit& u) const {
        const long L = (long)i * G + c; if (L >= nwg) return false;
        int wgid = (int)L; { const int q = nwg / NXCD, r = nwg % NXCD, xcd = wgid % NXCD, off = wgid / NXCD; wgid = (xcd < r ? xcd * (q + 1) : r * (q + 1) + (xcd - r) * q) + off; }
        const int nig = WGM * nN, gid = wgid / nig, fm = gid * WGM, gsz = (nM - fm) < WGM ? (nM - fm) : WGM;
        u.pm = fm + ((wgid % nig) % gsz); u.pn = (wgid % nig) / gsz; u.e = 0; u.aoff = u.pm * tsA; u.boff = u.pn * tsB; return true;
    }
};

__device__ __forceinline__ unsigned cvt_pk_bf16(float lo, float hi) { unsigned r; asm volatile("v_cvt_pk_bf16_f32 %0, %1, %2" : "=v"(r) : "v"(lo), "v"(hi)); return r; }
typedef f32x4 Acc[2][2][4][2];

template <class Epi, class Sched, bool GATHER = false>
__device__ __forceinline__ void gemm_phase(PG8_LAS unsigned char* lds, const Gemm g, const Sched& S, const Epi& E, const int wid) {
    int lane_; asm volatile("v_mbcnt_lo_u32_b32 %0, -1, 0\n\tv_mbcnt_hi_u32_b32 %0, -1, %0" : "=v"(lane_));
    const int lane = lane_, tid = wid * 64 + lane, wr = wid >> 2, wc = wid & 3, fr = lane & 15, fq = lane >> 4;
    int Kq = g.K; asm volatile("" : "+s"(Kq));
    const int nt = Kq / BK;
    unsigned vA[2][2], nvA[2][2], voffB[2];
#pragma unroll
    for (int i = 0; i < 2; ++i) { int R, C; stage_rc(tid * 16 + i * 8192, R, C); const int Rb = Epi::PERM ? ((R & ~31) + perm32(R & 31)) : R;
        voffB[i] = (unsigned)(Rb * g.ldb + C) * 2u;
        vA[0][i] = (unsigned)(R * g.lda + C) * 2u; vA[1][i] = vA[0][i]; nvA[0][i] = vA[0][i]; nvA[1][i] = vA[0][i]; }
    const size_t hsA = GATHER ? (size_t)0 : (size_t)HALF * g.lda * 2;
    const size_t kstep = (size_t)(BK * 2);
    const size_t hstepB = (size_t)HALF * g.ldb * 2;
    const unsigned ldsw = (unsigned)wid * 1024u;
    const int aoff = lds_byte(wr * 64 + fr, fq * 8), boff = lds_byte(wc * 32 + fr, fq * 8);
#define PG8_SA(b, h) (((b) * 2 + (h)) * HTB)
#define PG8_SB(b, h) ((4 + (b) * 2 + (h)) * HTB)
#define PG8_STAGE(bufoff, gbase, voff) do { _Pragma("unroll") for (int _i = 0; _i < 2; ++_i) \
        __builtin_amdgcn_global_load_lds((const unsigned*)((const char*)(gbase) + (voff)[_i]), (PG8_LAS unsigned*)(lds + (bufoff) + ldsw + _i * 8192), 16, 0, 0); } while (0)
#define PG8_LDA(dst, b, h) do { _Pragma("unroll") for (int m = 0; m < 4; ++m) _Pragma("unroll") for (int k = 0; k < 2; ++k) dst[m][k] = *(const PG8_LAS bf16x8*)(lds + PG8_SA(b, h) + aoff + m * 2048 + k * 1024); } while (0)
#define PG8_LDB(dst, b, h) do { _Pragma("unroll") for (int n = 0; n < 2; ++n) _Pragma("unroll") for (int k = 0; k < 2; ++k) dst[n][k] = *(const PG8_LAS bf16x8*)(lds + PG8_SB(b, h) + boff + n * 2048 + k * 1024); } while (0)
#define PG8_MMA(ai, bj, At, Bt) do { __builtin_amdgcn_s_setprio(1); _Pragma("unroll") for (int m = 0; m < 4; ++m) _Pragma("unroll") for (int n = 0; n < 2; ++n) _Pragma("unroll") for (int k = 0; k < 2; ++k) \
        acc[ai][bj][m][n] = __builtin_amdgcn_mfma_f32_16x16x32_bf16(Bt[n][k], At[m][k], acc[ai][bj][m][n], 0, 0, 0); __builtin_amdgcn_s_setprio(0); } while (0)
#define PG8_WAIT_V(n) asm volatile("s_waitcnt vmcnt(" #n ")" ::: "memory")
#define PG8_WAIT_L(n) asm volatile("s_waitcnt lgkmcnt(" #n ")" ::: "memory")
#define PG8_BAR __builtin_amdgcn_s_barrier()
#define PG8_SCHED __builtin_amdgcn_sched_barrier(0)
#define PG8_GIDX(dst, u) do { if constexpr (GATHER) { int _t = tid; asm volatile("" : "+v"(_t)); _Pragma("unroll") for (int _i = 0; _i < 2; ++_i) { int _R, _C; stage_rc(_t * 16 + _i * 8192, _R, _C); \
        _Pragma("unroll") for (int _h = 0; _h < 2; ++_h) dst[_h][_i] = (unsigned)(g.gidx[(u).pm * BM + _h * HALF + _R] * g.lda + _C) * 2u; } } } while (0)
    int c_pm, c_pn, c_e, ui = 0; const char* cA; const char* cB;
    { Unit u0; if (!S.next(0, u0)) return; PG8_GIDX(vA, u0); c_pm = u0.pm; c_pn = u0.pn; c_e = u0.e; cA = (const char*)g.A + u0.aoff; cB = (const char*)g.Bt + u0.boff; }
    Acc acc;
#pragma unroll
    for (int a = 0; a < 2; ++a)
#pragma unroll
        for (int b = 0; b < 2; ++b)
#pragma unroll
            for (int m = 0; m < 4; ++m)
#pragma unroll
                for (int n = 0; n < 2; ++n) acc[a][b][m][n] = (f32x4){0.f, 0.f, 0.f, 0.f};
    bf16x8 At[4][2], B0[2][2], B1[2][2];
    PG8_STAGE(PG8_SB(0, 0), cB, voffB); PG8_STAGE(PG8_SB(0, 1), cB + hstepB, voffB); PG8_STAGE(PG8_SA(0, 0), cA, vA[0]); PG8_STAGE(PG8_SA(0, 1), cA + hsA, vA[GATHER ? 1 : 0]);
    if (wr == 1) PG8_BAR;
    PG8_WAIT_V(2); PG8_BAR;
    PG8_STAGE(PG8_SB(1, 0), cB + kstep, voffB); PG8_STAGE(PG8_SA(1, 0), cA + kstep, vA[0]); PG8_STAGE(PG8_SB(1, 1), cB + hstepB + kstep, voffB);
    PG8_WAIT_V(6); PG8_BAR;
    for (;;) {
        Unit nxt; const bool has_next = S.next(ui + 1, nxt);
        const char* nA = has_next ? (const char*)g.A + nxt.aoff : cA; const char* nB = has_next ? (const char*)g.Bt + nxt.boff : cB;
        if constexpr (GATHER) { if (has_next) { PG8_GIDX(nvA, nxt); } else { nvA[0][0] = vA[0][0]; nvA[0][1] = vA[0][1]; nvA[1][0] = vA[1][0]; nvA[1][1] = vA[1][1]; } }
#pragma unroll 1
        for (int t = 0; t < nt; t += 2) {
            const bool last = (t == nt - 2);
            const char* a1 = cA + (size_t)(t + 1) * kstep;
            const char* a2 = last ? nA : cA + (size_t)(t + 2) * kstep; const char* b2 = last ? nB : cB + (size_t)(t + 2) * kstep;
            const char* a3 = a2 + kstep; const char* b3 = b2 + kstep;
            unsigned w0[2], w1[2];
            if constexpr (GATHER) { w0[0] = last ? nvA[0][0] : vA[0][0]; w0[1] = last ? nvA[0][1] : vA[0][1]; w1[0] = last ? nvA[1][0] : vA[1][0]; w1[1] = last ? nvA[1][1] : vA[1][1]; }
            else { w0[0] = vA[0][0]; w0[1] = vA[0][1]; w1[0] = vA[0][0]; w1[1] = vA[0][1]; }
            PG8_LDB(B0, 0, 0); PG8_LDB(B1, 0, 1); PG8_SCHED; PG8_LDA(At, 0, 0); PG8_STAGE(PG8_SA(1, 1), a1 + hsA, vA[GATHER ? 1 : 0]);
            PG8_WAIT_V(8); PG8_WAIT_L(0); PG8_BAR; PG8_MMA(0, 0, At, B0); PG8_MMA(0, 1, At, B1); PG8_BAR; PG8_SCHED;
            PG8_LDA(At, 0, 1); PG8_STAGE(PG8_SB(0, 0), b2, voffB); PG8_STAGE(PG8_SB(0, 1), b2 + hstepB, voffB); PG8_STAGE(PG8_SA(0, 0), a2, w0);
            PG8_WAIT_V(8); PG8_WAIT_L(0); PG8_BAR; PG8_MMA(1, 0, At, B0); PG8_MMA(1, 1, At, B1); PG8_BAR; PG8_SCHED;
            PG8_LDB(B0, 1, 0); PG8_LDB(B1, 1, 1); PG8_SCHED; PG8_LDA(At, 1, 0); PG8_STAGE(PG8_SA(0, 1), a2 + hsA, w1);
            PG8_WAIT_V(8); PG8_WAIT_L(0); PG8_BAR; PG8_MMA(0, 0, At, B0); PG8_MMA(0, 1, At, B1); PG8_BAR; PG8_SCHED;
            PG8_LDA(At, 1, 1); PG8_STAGE(PG8_SB(1, 0), b3, voffB); PG8_STAGE(PG8_SB(1, 1), b3 + hstepB, voffB); PG8_STAGE(PG8_SA(1, 0), a3, w0);
            PG8_WAIT_V(8); PG8_WAIT_L(0); PG8_BAR; PG8_MMA(1, 0, At, B0); PG8_MMA(1, 1, At, B1); PG8_BAR; PG8_SCHED;
        }
        if (wr == 0) PG8_BAR;
        { Unit cu; cu.pm = c_pm; cu.pn = c_pn; cu.e = c_e; cu.aoff = 0; cu.boff = 0; E(acc, cu, wr, wc, fr, fq); }
        if (!has_next) break;
#pragma unroll
        for (int a = 0; a < 2; ++a)
#pragma unroll
            for (int b = 0; b < 2; ++b)
#pragma unroll
                for (int m = 0; m < 4; ++m)
#pragma unroll
                    for (int n = 0; n < 2; ++n) acc[a][b][m][n] = (f32x4){0.f, 0.f, 0.f, 0.f};
        c_pm = nxt.pm; c_pn = nxt.pn; c_e = nxt.e; cA = nA; cB = nB; ++ui;
        if constexpr (GATHER) { vA[0][0] = nvA[0][0]; vA[0][1] = nvA[0][1]; vA[1][0] = nvA[1][0]; vA[1][1] = nvA[1][1]; }
        if (wr == 1) PG8_BAR;
    }
    PG8_WAIT_V(0);
    PG8_BAR;
#undef PG8_SA
#undef PG8_SB
#undef PG8_STAGE
#undef PG8_LDA
#undef PG8_LDB
#undef PG8_MMA
#undef PG8_WAIT_V
#undef PG8_WAIT_L
#undef PG8_BAR
#undef PG8_SCHED
#undef PG8_GIDX
}
}
namespace epi {
using pg8::Acc; using pg8::Unit; using pg8::cvt_pk_bf16;
constexpr int HALF = 128;
__device__ __forceinline__ void row_stats(const float* stat, int row, int fq, float& mu, float& rstd) {
    const f32x4 a = *(const f32x4*)(stat + (size_t)row * 32 + fq * 8), b = *(const f32x4*)(stat + (size_t)row * 32 + fq * 8 + 4);
    float s1 = (a[0] + a[2]) + (b[0] + b[2]), s2 = (a[1] + a[3]) + (b[1] + b[3]);
    s1 += __shfl_xor(s1, 16); s1 += __shfl_xor(s1, 32); s2 += __shfl_xor(s2, 16); s2 += __shfl_xor(s2, 32);
    mu = s1 * (1.0f / 1024.0f); const float var = fmaxf(s2 * (1.0f / 1024.0f) - mu * mu, 0.f); rstd = 1.0f / sqrtf(var + LN_EPS);
}
__device__ __forceinline__ v4u pack8(const f32x4 v0, const f32x4 v1) { v4u w; w.x = cvt_pk_bf16(v0[0], v0[1]); w.y = cvt_pk_bf16(v0[2], v0[3]); w.z = cvt_pk_bf16(v1[0], v1[1]); w.w = cvt_pk_bf16(v1[2], v1[3]); return w; }

struct EpiBf16 {
    static constexpr bool PERM = true;
    bf16* out; int ldc;
    __device__ __forceinline__ void operator()(const Acc& acc, const Unit& u, int wr, int wc, int fr, int fq) const {
        const int row0 = u.pm * 256 + wr * 64 + fr, col0 = u.pn * 256 + wc * 32 + 8 * fq;
#pragma unroll
        for (int ai = 0; ai < 2; ++ai)
#pragma unroll
            for (int m = 0; m < 4; ++m) { bf16* rowp = out + (size_t)(row0 + ai * HALF + m * 16) * ldc + col0;
#pragma unroll
                for (int bj = 0; bj < 2; ++bj) *(v4u*)(rowp + bj * HALF) = pack8(acc[ai][bj][m][0], acc[ai][bj][m][1]); }
    }
};

struct EpiMem {
    static constexpr bool PERM = true;
    bf16* mk; size_t estride; int ldc0, ldc1;
    __device__ __forceinline__ void operator()(const Acc& acc, const Unit& u, int wr, int wc, int fr, int fq) const {
        bf16* out = mk + (size_t)u.e * estride; const int ldc = u.e ? ldc1 : ldc0;
        const int row0 = u.pm * 256 + wr * 64 + fr, col0 = u.pn * 256 + wc * 32 + 8 * fq;
#pragma unroll
        for (int ai = 0; ai < 2; ++ai)
#pragma unroll
            for (int m = 0; m < 4; ++m) { bf16* rowp = out + (size_t)(row0 + ai * HALF + m * 16) * ldc + col0;
#pragma unroll
                for (int bj = 0; bj < 2; ++bj) *(v4u*)(rowp + bj * HALF) = pack8(acc[ai][bj][m][0], acc[ai][bj][m][1]); }
    }
};

struct EpiHeads64 {
    static constexpr bool PERM = true;
    bf16* base0; size_t tstride; int nrope; const float* rot16;
    __device__ __forceinline__ void operator()(Acc& acc, const Unit& u, int wr, int wc, int fr, int fq) const {
        const int t = u.pn >> 2; bf16* base = base0 + (size_t)t * tstride;
        const int row0 = u.pm * 256 + wr * 64 + fr, col0 = (u.pn & 3) * 256 + wc * 32 + 8 * fq;
        const bool ropew = (t < nrope) && ((wc & 1) == 0);
        const float sg = fq == 0 ? -1.0f : 1.0f, rt = fq < 2 ? 1.0f : 0.0f;
#pragma unroll
        for (int ai = 0; ai < 2; ++ai)
#pragma unroll
            for (int m = 0; m < 4; ++m) { const int row = row0 + ai * HALF + m * 16; bf16* rowp = base + (size_t)row * 1024 + col0;
                if (ropew) {
#pragma unroll
                    for (int n = 0; n < 2; ++n) { const f32x4 c0 = *(const f32x4*)(rot16 + (size_t)row * 16 + n * 8), c1 = *(const f32x4*)(rot16 + (size_t)row * 16 + n * 8 + 4);
                        const float cs[4] = {c0[0], c0[2], c1[0], c1[2]}, sn[4] = {c0[1], c0[3], c1[1], c1[3]};
#pragma unroll
                        for (int bj = 0; bj < 2; ++bj)
#pragma unroll
                            for (int e = 0; e < 4; ++e) { const float x = acc[ai][bj][m][n][e], p = __shfl_xor(x, 16);
                                acc[ai][bj][m][n][e] = x + rt * ((x * cs[e] - x) + sg * (p * sn[e])); } } }
#pragma unroll
                for (int bj = 0; bj < 2; ++bj) *(v4u*)(rowp + bj * HALF) = pack8(acc[ai][bj][m][0], acc[ai][bj][m][1]); }
    }
};

struct EpiQfull {
    static constexpr bool PERM = true;
    bf16* qf; const float* rot32;
    __device__ __forceinline__ void operator()(const Acc& acc, const Unit& u, int wr, int wc, int fr, int fq) const {
        const int row0 = u.pm * 256 + wr * 64 + fr; const float sg = fq < 2 ? -1.0f : 1.0f;
#pragma unroll
        for (int ai = 0; ai < 2; ++ai)
#pragma unroll
            for (int m = 0; m < 4; ++m) { const int row = row0 + ai * HALF + m * 16; bf16* rowp = qf + (size_t)row * (8 * KVW);
                if (u.pn < 8) {
#pragma unroll
                    for (int bj = 0; bj < 2; ++bj) *(v4u*)(rowp + u.pn * KVW + bj * HALF + wc * 32 + 8 * fq) = pack8(acc[ai][bj][m][0], acc[ai][bj][m][1]);
                } else {
                    f32x4 cs[2][2];
#pragma unroll
                    for (int n = 0; n < 2; ++n) { const float* rp = rot32 + (size_t)row * 32 + ((fq & 1) * 8 + n * 4) * 2; cs[n][0] = *(const f32x4*)rp; cs[n][1] = *(const f32x4*)(rp + 4); }
#pragma unroll
                    for (int bj = 0; bj < 2; ++bj) { f32x4 v[2] = {acc[ai][bj][m][0], acc[ai][bj][m][1]};
#pragma unroll
                        for (int n = 0; n < 2; ++n)
#pragma unroll
                            for (int e = 0; e < 4; ++e) { const float p = __shfl_xor(v[n][e], 32); const float c = cs[n][e >> 1][(e & 1) * 2], s = cs[n][e >> 1][(e & 1) * 2 + 1];
                                const float x = v[n][e]; v[n][e] = x * c + sg * (p * s); }
                        *(v4u*)(rowp + (4 * bj + wc) * KVW + 256 + 8 * fq) = pack8(v[0], v[1]); } } }
    }
};

template <bool OUTF32> struct EpiFold {
    static constexpr bool PERM = true;
    const float* stat; const float* gw; const float* bw; void* out; int ldc;
    __device__ __forceinline__ void operator()(const Acc& acc, const Unit& u, int wr, int wc, int fr, int fq) const {
        const int row0 = u.pm * 256 + wr * 64 + fr, col0 = u.pn * 256 + wc * 32 + 8 * fq;
        f32x4 gv[2][2], bv[2][2];
#pragma unroll
        for (int bj = 0; bj < 2; ++bj)
#pragma unroll
            for (int n = 0; n < 2; ++n) { gv[bj][n] = *(const f32x4*)(gw + col0 + bj * HALF + 4 * n); bv[bj][n] = *(const f32x4*)(bw + col0 + bj * HALF + 4 * n); }
#pragma unroll
        for (int ai = 0; ai < 2; ++ai)
#pragma unroll
            for (int m = 0; m < 4; ++m) { const int row = row0 + ai * HALF + m * 16; float mu, rstd; row_stats(stat, row, fq, mu, rstd);
#pragma unroll
                for (int bj = 0; bj < 2; ++bj) { const f32x4 v0 = (acc[ai][bj][m][0] - mu * gv[bj][0]) * rstd + bv[bj][0], v1 = (acc[ai][bj][m][1] - mu * gv[bj][1]) * rstd + bv[bj][1];
                    if (OUTF32) { float* p = (float*)out + (size_t)row * ldc + col0 + bj * HALF; *(f32x4*)p = v0; *(f32x4*)(p + 4) = v1; }
                    else *(v4u*)((bf16*)out + (size_t)row * ldc + col0 + bj * HALF) = pack8(v0, v1); } }
    }
};

template <int MODE, bool AUX = true> struct EpiPre {
    static constexpr bool PERM = false;
    const float* resid; float* pre; bf16* preb; const float* stat_old; float* stat_new; const float* g; const float* b;
    __device__ __forceinline__ void operator()(const Acc& acc, const Unit& u, int wr, int wc, int fr, int fq) const {
        const int row0 = u.pm * 256 + wr * 64 + fr, col0 = u.pn * 256 + wc * 32 + 4 * fq;
#pragma unroll
        for (int ai = 0; ai < 2; ++ai)
#pragma unroll
            for (int m = 0; m < 4; ++m) { const int row = row0 + ai * HALF + m * 16; const size_t off = (size_t)row * 1024 + col0;
                float mu = 0.f, rstd = 1.f; if (MODE == 1) row_stats(stat_old, row, fq, mu, rstd);
                float s1 = 0.f, s2 = 0.f;
#pragma unroll
                for (int bj = 0; bj < 2; ++bj)
#pragma unroll
                    for (int n = 0; n < 2; ++n) { f32x4 r;
                        { const v2u rw = *(const v2u*)(preb + off + bj * HALF + n * 16); r = (f32x4){bflo(rw.x), bfhi(rw.x), bflo(rw.y), bfhi(rw.y)}; }
                        if (MODE == 1) { const f32x4 gv = *(const f32x4*)(g + col0 + bj * HALF + n * 16), bv = *(const f32x4*)(b + col0 + bj * HALF + n * 16); r = (r - mu) * rstd * gv + bv; }
                        const f32x4 v = r * ALPHA + acc[ai][bj][m][n];
                        { v2u w; w.x = cvt_pk_bf16(v[0], v[1]); w.y = cvt_pk_bf16(v[2], v[3]); *(v2u*)(preb + off + bj * HALF + n * 16) = w; }
                        s1 += (v[0] + v[1]) + (v[2] + v[3]); s2 += (v[0] * v[0] + v[1] * v[1]) + (v[2] * v[2] + v[3] * v[3]);
                        if (MODE == 1 && n == 1) asm volatile("" ::: "memory"); }
                if (AUX) { s1 += __shfl_xor(s1, 16); s1 += __shfl_xor(s1, 32); s2 += __shfl_xor(s2, 16); s2 += __shfl_xor(s2, 32); }
                if (AUX && fq == 0) *(f32x2*)(stat_new + (size_t)row * 32 + (u.pn * 4 + wc) * 2) = (f32x2){s1, s2};
                asm volatile("" ::: "memory"); }
    }
};

struct EpiSoftmax {
    static constexpr bool PERM = true;
    bf16* out; int ldc; LAS float* xch;
    __device__ __forceinline__ void operator()(Acc& acc, const Unit& u, int wr, int wc, int fr, int fq) const {
        const int row0 = u.pm * 256 + wr * 64 + fr, col0 = u.pn * 256 + wc * 32 + 8 * fq;
#pragma unroll
        for (int ai = 0; ai < 2; ++ai)
#pragma unroll
            for (int m = 0; m < 4; ++m) { float mx = -INFINITY;
#pragma unroll
                for (int bj = 0; bj < 2; ++bj)
#pragma unroll
                    for (int n = 0; n < 2; ++n) { const f32x4 v = acc[ai][bj][m][n]; mx = fmaxf(mx, fmaxf(fmaxf(v[0], v[1]), fmaxf(v[2], v[3]))); }
                mx = fmaxf(mx, __shfl_xor(mx, 16)); mx = fmaxf(mx, __shfl_xor(mx, 32));
                if (fq == 0) xch[(ai * HALF + wr * 64 + m * 16 + fr) * 4 + wc] = mx; }
        asm volatile("s_waitcnt lgkmcnt(0)" ::: "memory"); __builtin_amdgcn_s_barrier(); asm volatile("" ::: "memory");
#pragma unroll
        for (int ai = 0; ai < 2; ++ai)
#pragma unroll
            for (int m = 0; m < 4; ++m) { const int r = ai * HALF + wr * 64 + m * 16 + fr; const f32x4 mm = *(const LAS f32x4*)(xch + r * 4);
                const float M = fmaxf(fmaxf(mm[0], mm[1]), fmaxf(mm[2], mm[3])); float s = 0.f;
#pragma unroll
                for (int bj = 0; bj < 2; ++bj)
#pragma unroll
                    for (int n = 0; n < 2; ++n) { f32x4 v = acc[ai][bj][m][n];
#pragma unroll
                        for (int e = 0; e < 4; ++e) { v[e] = __builtin_amdgcn_exp2f(v[e] - M); s += v[e]; }
                        acc[ai][bj][m][n] = v; }
                s += __shfl_xor(s, 16); s += __shfl_xor(s, 32);
                if (fq == 0) xch[1024 + r * 4 + wc] = s; }
        asm volatile("s_waitcnt lgkmcnt(0)" ::: "memory"); __builtin_amdgcn_s_barrier(); asm volatile("" ::: "memory");
#pragma unroll
        for (int ai = 0; ai < 2; ++ai)
#pragma unroll
            for (int m = 0; m < 4; ++m) { const int r = ai * HALF + wr * 64 + m * 16 + fr; const f32x4 ss = *(const LAS f32x4*)(xch + 1024 + r * 4);
                const float inv = 1.0f / ((ss[0] + ss[1]) + (ss[2] + ss[3])); bf16* rowp = out + (size_t)(row0 + ai * HALF + m * 16) * ldc + col0;
#pragma unroll
                for (int bj = 0; bj < 2; ++bj) *(v4u*)(rowp + bj * HALF) = pack8(acc[ai][bj][m][0] * inv, acc[ai][bj][m][1] * inv); }
    }
};

struct EpiFoldSoftmax {
    static constexpr bool PERM = true;
    const float* stat; const float* gwb; const float* bwb; bf16* out; LAS float* xch;
    __device__ __forceinline__ void operator()(Acc& acc, const Unit& u, int wr, int wc, int fr, int fq) const {
        const int row0 = u.pm * 256 + wr * 64 + fr, col0 = u.pn * 256 + wc * 32 + 8 * fq; const float* gw = gwb + u.e * 1024; const float* bw = bwb + u.e * 1024;
        { f32x4 gv[2][2], bv[2][2];
#pragma unroll
        for (int bj = 0; bj < 2; ++bj)
#pragma unroll
            for (int n = 0; n < 2; ++n) { gv[bj][n] = *(const f32x4*)(gw + col0 + bj * HALF + 4 * n); bv[bj][n] = *(const f32x4*)(bw + col0 + bj * HALF + 4 * n); }
#pragma unroll
        for (int ai = 0; ai < 2; ++ai)
#pragma unroll
            for (int m = 0; m < 4; ++m) { const int row = row0 + ai * HALF + m * 16; float mu, rstd; row_stats(stat, row, fq, mu, rstd); float mx = -INFINITY;
#pragma unroll
                for (int bj = 0; bj < 2; ++bj)
#pragma unroll
                    for (int n = 0; n < 2; ++n) { const f32x4 v = (acc[ai][bj][m][n] - mu * gv[bj][n]) * rstd + bv[bj][n]; acc[ai][bj][m][n] = v; mx = fmaxf(mx, fmaxf(fmaxf(v[0], v[1]), fmaxf(v[2], v[3]))); }
                mx = fmaxf(mx, __shfl_xor(mx, 16)); mx = fmaxf(mx, __shfl_xor(mx, 32));
                if (fq == 0) xch[(ai * HALF + wr * 64 + m * 16 + fr) * 4 + wc] = mx; } }
        asm volatile("s_waitcnt lgkmcnt(0)" ::: "memory"); __builtin_amdgcn_s_barrier(); asm volatile("" ::: "memory");
#pragma unroll
        for (int ai = 0; ai < 2; ++ai)
#pragma unroll
            for (int m = 0; m < 4; ++m) { const int r = ai * HALF + wr * 64 + m * 16 + fr; const f32x4 mm = *(const LAS f32x4*)(xch + r * 4);
                const float M = fmaxf(fmaxf(mm[0], mm[1]), fmaxf(mm[2], mm[3])); float s = 0.f;
#pragma unroll
                for (int bj = 0; bj < 2; ++bj)
#pragma unroll
                    for (int n = 0; n < 2; ++n) { f32x4 v = acc[ai][bj][m][n];
#pragma unroll
                        for (int e = 0; e < 4; ++e) { v[e] = __builtin_amdgcn_exp2f(v[e] - M); s += v[e]; }
                        acc[ai][bj][m][n] = v; }
                s += __shfl_xor(s, 16); s += __shfl_xor(s, 32);
                if (fq == 0) xch[1024 + r * 4 + wc] = s; }
        asm volatile("s_waitcnt lgkmcnt(0)" ::: "memory"); __builtin_amdgcn_s_barrier(); asm volatile("" ::: "memory");
#pragma unroll
        for (int ai = 0; ai < 2; ++ai)
#pragma unroll
            for (int m = 0; m < 4; ++m) { const int r = ai * HALF + wr * 64 + m * 16 + fr; const f32x4 ss = *(const LAS f32x4*)(xch + 1024 + r * 4);
                const float inv = 1.0f / ((ss[0] + ss[1]) + (ss[2] + ss[3])); bf16* rowp = out + (size_t)(row0 + ai * HALF + m * 16) * 1024 + col0;
#pragma unroll
                for (int bj = 0; bj < 2; ++bj) *(v4u*)(rowp + bj * HALF) = pack8(acc[ai][bj][m][0] * inv, acc[ai][bj][m][1] * inv); }
    }
};

struct EpiGateUp {
    static constexpr bool PERM = true;
    bf16* hid;
    __device__ __forceinline__ void operator()(const Acc& acc, const Unit& u, int wr, int wc, int fr, int fq) const {
        const int row0 = u.pm * 256 + wr * 64 + fr, col0 = u.pn * 128 + wc * 16 + 4 * fq;
#pragma unroll
        for (int ai = 0; ai < 2; ++ai)
#pragma unroll
            for (int m = 0; m < 4; ++m) { bf16* rowp = hid + (size_t)(row0 + ai * HALF + m * 16) * FF + col0;
#pragma unroll
                for (int bj = 0; bj < 2; ++bj) { const f32x4 v0 = acc[ai][bj][m][0], v1 = acc[ai][bj][m][1];
                    float h[4]; const float gt[4] = {v0[0], v0[2], v1[0], v1[2]}, up[4] = {v0[1], v0[3], v1[1], v1[3]};
#pragma unroll
                    for (int j = 0; j < 4; ++j) h[j] = gt[j] * __builtin_amdgcn_rcpf(1.0f + __builtin_amdgcn_exp2f(-gt[j] * LOG2E)) * up[j];
                    v2u w; w.x = cvt_pk_bf16(h[0], h[1]); w.y = cvt_pk_bf16(h[2], h[3]); *(v2u*)(rowp + bj * 64) = w; } }
    }
};
struct EpiDown {
    static constexpr bool PERM = true;
    bf16* y; const float* wsort;
    __device__ __forceinline__ void operator()(const Acc& acc, const Unit& u, int wr, int wc, int fr, int fq) const {
        const int row0 = u.pm * 256 + wr * 64 + fr, col0 = u.pn * 256 + wc * 32 + 8 * fq;
#pragma unroll
        for (int ai = 0; ai < 2; ++ai)
#pragma unroll
            for (int m = 0; m < 4; ++m) { const int row = row0 + ai * HALF + m * 16; const float w = wsort[row]; bf16* rowp = y + (size_t)row * 1024 + col0;
#pragma unroll
                for (int bj = 0; bj < 2; ++bj) *(v4u*)(rowp + bj * HALF) = pack8(acc[ai][bj][m][0] * w, acc[ai][bj][m][1] * w); }
    }
};
}
#include <hip/hip_bf16.h>
#include <cmath>
namespace attn_body {
using bf16=__hip_bfloat16;
using bf16x8=__attribute__((ext_vector_type(8)))short;
using s16x4=__attribute__((ext_vector_type(4)))short;
using f32x16=__attribute__((ext_vector_type(16)))float;
using u32x4=__attribute__((ext_vector_type(4)))unsigned;
constexpr int BATCH=8,NHEAD=16,SEQ=8192,D=64,DM=NHEAD*D;
constexpr int NW=8,QBLK=32,QB=QBLK*NW,KVBLK=64,NQB=SEQ/QB;
constexpr int ATTN_PITCH=DM, ATTN_UNIT_ROWS=QB;
__device__ __forceinline__ int crow(int r,int hi){return (r&3)+8*(r>>2)+4*hi;}
#define SBAR() __builtin_amdgcn_sched_barrier(0)
__device__ __forceinline__ void cmask(f32x16&p0,f32x16&p1,int jb,int qrel,int hi){
  const float NEG=-INFINITY; (void)hi;
  if(jb>(qrel>>6)){
  #pragma unroll
  for(int r=0;r<16;++r){p0[r]=NEG;p1[r]=NEG;}}
}


constexpr int NSLOT=3, SLOTB=8192, VSLOTB=16384;
constexpr int LDS_K=0, LDS_V=NSLOT*SLOTB, LDS_WS=LDS_V+NSLOT*VSLOTB, LDS_OST=LDS_WS+NW*64*4, LDS_BYTES=LDS_OST+NW*8192;
constexpr float C2=0.125f*1.4426950408889634f;
__device__ __forceinline__ void glds16(const void*gsrc,unsigned lds_dst){unsigned keep;
  asm volatile("s_mov_b32 %0, m0\n\ts_mov_b32 m0, %2\n\ts_nop 0\n\tglobal_load_lds_dwordx4 %1, off\n\ts_mov_b32 m0, %0":"=&s"(keep):"v"(gsrc),"s"(lds_dst):"memory");}
__device__ __forceinline__ float max3f(float a,float b,float c){float r;asm("v_max3_f32 %0, %1, %2, %3":"=v"(r):"v"(a),"v"(b),"v"(c));return r;}
__device__ __forceinline__ float max2f(float a,float b){float r;asm("v_max_f32_e32 %0, %1, %2":"=v"(r):"v"(a),"v"(b));return r;}
__device__ __forceinline__ float fadd_s(float a,float b){float r;asm("v_add_f32_e32 %0, %1, %2":"=v"(r):"v"(a),"v"(b));return r;}
__device__ __forceinline__ float fsub_s(float a,float b){float r;asm("v_sub_f32_e32 %0, %1, %2":"=v"(r):"v"(a),"v"(b));return r;}
typedef float f32x2_t __attribute__((ext_vector_type(2))); typedef __bf16 bf16x2_t __attribute__((ext_vector_type(2)));
__device__ __forceinline__ unsigned cvtpk_s(float lo,float hi){f32x2_t v={lo,hi};bf16x2_t b=__builtin_convertvector(v,bf16x2_t);return __builtin_bit_cast(unsigned,b);}
#define WAIT_BAR(N) asm volatile("s_waitcnt vmcnt(" #N ") lgkmcnt(0)\n\ts_barrier":::"memory")

__device__ __forceinline__ void qkt(f32x16&p0,f32x16&p1,const char*Kslot,const __attribute__((address_space(3))) char*qst,const f32x16&negm,int r32,int hi){
  #define QR(d0) (*(const __attribute__((address_space(3))) bf16x8*)(qst+(d0)*1024))
  const char*kb=Kslot+hi*1024+r32*16;
  #pragma unroll
  for(int d0=0;d0<4;++d0){
    const bf16x8 b0=*reinterpret_cast<const bf16x8*>(kb+d0*2048);
    const bf16x8 b1=*reinterpret_cast<const bf16x8*>(kb+d0*2048+512);
    if(d0==0){p0=__builtin_amdgcn_mfma_f32_32x32x16_bf16(b0,QR(0),negm,0,0,0);p1=__builtin_amdgcn_mfma_f32_32x32x16_bf16(b1,QR(0),negm,0,0,0);}
    else{p0=__builtin_amdgcn_mfma_f32_32x32x16_bf16(b0,QR(d0),p0,0,0,0);p1=__builtin_amdgcn_mfma_f32_32x32x16_bf16(b1,QR(d0),p1,0,0,0);}}
  #undef QR
}
typedef __attribute__((address_space(3))) const char* lds_cptr;
typedef short v4i16_t __attribute__((ext_vector_type(4)));
__device__ __forceinline__ void kload8(bf16x8*kf,lds_cptr kp){
  kf[0]=*(const __attribute__((address_space(3))) bf16x8*)(kp);      kf[1]=*(const __attribute__((address_space(3))) bf16x8*)(kp+512);
  kf[2]=*(const __attribute__((address_space(3))) bf16x8*)(kp+2048); kf[3]=*(const __attribute__((address_space(3))) bf16x8*)(kp+2560);
  kf[4]=*(const __attribute__((address_space(3))) bf16x8*)(kp+4096); kf[5]=*(const __attribute__((address_space(3))) bf16x8*)(kp+4608);
  kf[6]=*(const __attribute__((address_space(3))) bf16x8*)(kp+6144); kf[7]=*(const __attribute__((address_space(3))) bf16x8*)(kp+6656);
}
__device__ __forceinline__ void kload2(bf16x8*kf,lds_cptr kp,int j){ kf[2*j]=*(const __attribute__((address_space(3))) bf16x8*)(kp+j*2048); kf[2*j+1]=*(const __attribute__((address_space(3))) bf16x8*)(kp+j*2048+512); }
__device__ __forceinline__ s16x4 vtr(lds_cptr p){ return __builtin_bit_cast(s16x4,__builtin_amdgcn_ds_read_tr16_b64_v4i16((__attribute__((address_space(3))) v4i16_t*)p)); }
__device__ __forceinline__ float rowmax(const f32x16&p0,const f32x16&p1){
  float a=max3f(p0[0],p0[1],p1[0]),b=max3f(p0[2],p0[3],p1[1]);a=max3f(a,p1[2],p1[3]);
  #pragma unroll
  for(int r=4;r<16;r+=4){a=max3f(a,p0[r],p0[r+1]);b=max3f(b,p0[r+2],p0[r+3]);a=max3f(a,p1[r],p1[r+1]);b=max3f(b,p1[r+2],p1[r+3]);}
  const float m=max2f(a,b);
  auto rr=__builtin_amdgcn_permlane32_swap(__float_as_uint(m),__float_as_uint(m),false,false);
  return max2f(__uint_as_float(rr[0]),__uint_as_float(rr[1]));
}
__device__ __forceinline__ void pv(f32x16*o,int vb,bf16x8 pa0,bf16x8 pa1,bf16x8 pa2,bf16x8 pa3){
  #pragma unroll
  for(int d0=0;d0<2;++d0){s16x4 lo[4],hi[4];
    #pragma unroll
    for(int ks=0;ks<4;++ks){
      asm volatile("ds_read_b64_tr_b16 %0,%1 offset:%c2":"=&v"(lo[ks]):"v"(vb),"i"(d0*4096+ks*1024):"memory");
      asm volatile("ds_read_b64_tr_b16 %0,%1 offset:%c2":"=&v"(hi[ks]):"v"(vb),"i"(d0*4096+ks*1024+512):"memory");}
    asm volatile("s_waitcnt lgkmcnt(0)":::"memory");SBAR();
    #define PK(k) (bf16x8){lo[k][0],lo[k][1],lo[k][2],lo[k][3],hi[k][0],hi[k][1],hi[k][2],hi[k][3]}
    o[d0]=__builtin_amdgcn_mfma_f32_32x32x16_bf16(pa0,PK(0),o[d0],0,0,0);
    o[d0]=__builtin_amdgcn_mfma_f32_32x32x16_bf16(pa1,PK(1),o[d0],0,0,0);
    o[d0]=__builtin_amdgcn_mfma_f32_32x32x16_bf16(pa2,PK(2),o[d0],0,0,0);
    o[d0]=__builtin_amdgcn_mfma_f32_32x32x16_bf16(pa3,PK(3),o[d0],0,0,0);
    #undef PK
  }
}

#ifndef ATTN_STORE16
#define ATTN_STORE16(p,v) (*(u32x4*)(p)=(v))
#endif
template<int THRL> __device__ __forceinline__ void attn_unit(const int wid,int b,int h,int hv,int qb,const bf16*Q,const bf16*__restrict__ K,const bf16*__restrict__ V,bf16*O,char*shm){
  int lane_; asm volatile("v_mbcnt_lo_u32_b32 %0, -1, 0\n\tv_mbcnt_hi_u32_b32 %0, -1, %0":"=v"(lane_)); const int lane=lane_,r32=lane&31,hi=lane>>5;
  const long rowbase=(long)b*SEQ; const int q0=qb*QB;
  const bf16*Qw=Q+(rowbase+q0+wid*QBLK)*DM+h*D;
  const bf16*Kh=K+rowbase*DM+h*D,*Vh=V+rowbase*DM+hv*D;
  const unsigned lds0=(unsigned)(uintptr_t)shm;
  float*wsf=(float*)(shm+LDS_WS)+wid*64;
  const bf16*ksrc=Kh+(long)lane*DM+wid*8;
  const bf16*vsrc=Vh+(long)(16*(wid&3)+(lane>>2))*DM+(wid>>2)*32+(lane&3)*8;
  const unsigned kdst=lds0+LDS_K+wid*1024, vdst=lds0+LDS_V+wid*1024;
  #define DMA_K(t,slot) glds16(ksrc+(long)(t)*KVBLK*DM,(unsigned)__builtin_amdgcn_readfirstlane(kdst+(slot)))
  #define DMA_V(t,slot) do{ glds16(vsrc+(long)(t)*KVBLK*DM,(unsigned)__builtin_amdgcn_readfirstlane(vdst+2*(slot))); glds16(vsrc+64+(long)(t)*KVBLK*DM,(unsigned)__builtin_amdgcn_readfirstlane(vdst+8192+2*(slot))); }while(0)
  const int vb0=(int)(lds0+LDS_V)+((lane>>4)&1)*32+(lane&3)*8+(4*hi+((lane&15)>>2))*64;
  const char*Kbase=shm+LDS_K; bf16x8 kf[8];
  const lds_cptr shm3=(lds_cptr)shm; const lds_cptr kp0=shm3+LDS_K+hi*1024+r32*16; const lds_cptr vp0=shm3+LDS_V+((lane>>4)&1)*32+(lane&3)*8+(4*hi+((lane&15)>>2))*64;
  const int NT=(q0+QB)/KVBLK;
  DMA_K(0,0);DMA_V(0,0);DMA_K(1,SLOTB);
  const lds_cptr qst=(lds_cptr)shm+LDS_OST+wid*8192+lane*16;
  { bf16x8 qtmp[4];
  #pragma unroll
  for(int d0=0;d0<4;++d0)qtmp[d0]=*reinterpret_cast<const bf16x8*>(&Qw[(long)r32*DM+d0*16+hi*8]);
  #pragma unroll
  for(int d0=0;d0<4;++d0)*(__attribute__((address_space(3))) bf16x8*)((__attribute__((address_space(3))) char*)qst+d0*1024)=qtmp[d0]; }
  #define QR(d0) (*(const __attribute__((address_space(3))) bf16x8*)(qst+(d0)*1024))
  float mhat=0.f,l_reg=0.f;f32x16 o[4];o[0]=f32x16{};o[1]=f32x16{};o[2]=f32x16{};o[3]=f32x16{};const f32x16 negm=f32x16{};
  const int qrel=wid*QBLK+r32;
  #define CMASK(P0,P1,t) do{int jb_=(t)-(NT-4); if(jb_>=0)cmask(P0,P1,jb_,qrel,hi);}while(0)
  bool resc=false;
  #define START(P0,P1) do{ const float rm=rowmax(P0,P1); resc=false; \
    { const float dl=rm; mhat=fadd_s(mhat,dl); \
      _Pragma("unroll") for(int r=0;r<16;++r){P0[r]=fsub_s(P0[r],dl);P1[r]=fsub_s(P1[r],dl);} \
      } \
    _Pragma("unroll") for(int r=0;r<16;++r)P0[r]=__builtin_amdgcn_exp2f(P0[r]); }while(0)
  #define RESC() do{ if(resc){ asm volatile("s_waitcnt lgkmcnt(0)":::"memory"); \
      _Pragma("unroll") for(int d_=0;d_<4;++d_) _Pragma("unroll") for(int r=0;r<16;++r)o[d_][r]*=wsf[crow(r,hi)]; } }while(0)
  f32x16 pA0,pA1,pB0,pB1;
  int sl_prev=0,sl_cur=0,sl_next=SLOTB;
  #define ROT() do{sl_prev=sl_cur;sl_cur=sl_next;sl_next=(sl_next==(NSLOT-1)*SLOTB)?0:sl_next+SLOTB;}while(0)
  DMA_K(2,2*SLOTB);
  WAIT_BAR(3);
  qkt(pA0,pA1,Kbase,qst,negm,r32,hi);asm volatile("s_nop 15\n\ts_nop 7":"+v"(pA0),"+v"(pA1));CMASK(pA0,pA1,0);
  START(pA0,pA1);
  _Pragma("unroll") for(int r=0;r<16;++r)pA1[r]=__builtin_amdgcn_exp2f(pA1[r]);
  WAIT_BAR(0);
  DMA_K(3,0);DMA_V(1,SLOTB);
  ROT();
  kload8(kf,kp0+sl_cur);
  WAIT_BAR(3);
  s16x4 vlo[8],vhi[8]; u32x4 pw0,pw1,pw2,pw3;
  #define PKW(P,B) cvtpk_s(P[B],P[B+1])
  #define PAF(k) __builtin_bit_cast(bf16x8,pw##k)
  #define VFR(i) (bf16x8){vlo[i][0],vlo[i][1],vlo[i][2],vlo[i][3],vhi[i][0],vhi[i][1],vhi[i][2],vhi[i][3]}
  #define PIN(x) asm volatile("":"+v"(x))
  #define MX3(a,b,c) __builtin_fmaxf(__builtin_fmaxf((a),(b)),(c))
  #define GAPA(MF,A0,A1,A2,A3,W0,W1,PW) do{ MF; sacc+=A0; sacc+=A1; sacc+=A2; sacc+=A3; PIN(sacc); W0; W1; PIN(PW); SBAR(); }while(0)
  #define EX(v) __builtin_amdgcn_exp2f(v)
  #define GAPB(MF,X,B) do{ MF; X[B]=EX(X[B]); X[B+1]=EX(X[B+1]); X[B+2]=EX(X[B+2]); X[B+3]=EX(X[B+3]); PIN(X); SBAR(); }while(0)
  #define VRD(i) do{ vlo[i]=vtr(vp_+(((i)>>2)*4096+((i)&3)*1024)); vhi[i]=vtr(vp_+(((i)>>2)*4096+((i)&3)*1024+512)); }while(0)
  #define KRD(G,j) do{ if(G){ kload2(kf,kp0+sl_next,j); SBAR(); } }while(0)
  #define STEP(C0,C1,P0,P1,t,GK,GV,GL) do{ SBAR(); \
    const lds_cptr vp_=vp0+2*sl_prev; \
    VRD(0); SBAR(); float sacc=(P0[0]+P0[1]); \
    GAPA(C0=__builtin_amdgcn_mfma_f32_32x32x16_bf16(kf[0],QR(0),negm,0,0,0), P0[2],P0[3],P0[4],P0[5],     pw0[0]=PKW(P0,0), pw0[1]=PKW(P0,2), pw0); \
    VRD(4); SBAR(); GAPA(C1=__builtin_amdgcn_mfma_f32_32x32x16_bf16(kf[1],QR(0),negm,0,0,0), P0[6],P0[7],P0[8],P0[9],     pw0[2]=PKW(P0,4), pw0[3]=PKW(P0,6), pw0); \
    VRD(1); SBAR(); GAPA(C0=__builtin_amdgcn_mfma_f32_32x32x16_bf16(kf[2],QR(1),C0,0,0,0),   P0[10],P0[11],P0[12],P0[13], pw1[0]=PKW(P0,8), pw1[1]=PKW(P0,10), pw1); \
    VRD(5); SBAR(); GAPA(C1=__builtin_amdgcn_mfma_f32_32x32x16_bf16(kf[3],QR(1),C1,0,0,0),   P0[14],P0[15],P1[0],P1[1],   pw1[2]=PKW(P0,12),pw1[3]=PKW(P0,14), pw1); \
    VRD(2); SBAR(); GAPA(C0=__builtin_amdgcn_mfma_f32_32x32x16_bf16(kf[4],QR(2),C0,0,0,0),   P1[2],P1[3],P1[4],P1[5],     pw2[0]=PKW(P1,0), pw2[1]=PKW(P1,2), pw2); \
    VRD(6); SBAR(); GAPA(C1=__builtin_amdgcn_mfma_f32_32x32x16_bf16(kf[5],QR(2),C1,0,0,0),   P1[6],P1[7],P1[8],P1[9],     pw2[2]=PKW(P1,4), pw2[3]=PKW(P1,6), pw2); \
    VRD(3); SBAR(); GAPA(C0=__builtin_amdgcn_mfma_f32_32x32x16_bf16(kf[6],QR(3),C0,0,0,0),   P1[10],P1[11],P1[12],P1[13], pw3[0]=PKW(P1,8), pw3[1]=PKW(P1,10), pw3); \
    VRD(7); SBAR(); GAPA(C1=__builtin_amdgcn_mfma_f32_32x32x16_bf16(kf[7],QR(3),C1,0,0,0),   P1[14],P1[15],0.f,0.f,       pw3[2]=PKW(P1,12),pw3[3]=PKW(P1,14), pw3); \
    l_reg+=sacc; \
    if(GK){DMA_K((t)+3,sl_cur);} if(GV){DMA_V((t)+1,sl_next);} \
    _Pragma("unroll") for(int r=0;r<16;++r){C0[r]-=mhat;C1[r]-=mhat;} \
    CMASK(C0,C1,t); \
    { float a=MX3(C0[0],C0[1],C1[0]),b=MX3(C0[2],C0[3],C1[1]); a=MX3(a,C1[2],C1[3]); \
      _Pragma("unroll") for(int r=4;r<16;r+=4){a=MX3(a,C0[r],C0[r+1]);b=MX3(b,C0[r+2],C0[r+3]);a=MX3(a,C1[r],C1[r+1]);b=MX3(b,C1[r+2],C1[r+3]);} \
      float rm=__builtin_fmaxf(a,b); { auto rr=__builtin_amdgcn_permlane32_swap(__float_as_uint(rm),__float_as_uint(rm),false,false); rm=__builtin_fmaxf(__uint_as_float(rr[0]),__uint_as_float(rr[1])); } \
      resc=false; \
      if(__builtin_expect(__any(rm>(float)THRL),0)){ const float dl=__builtin_fmaxf(rm,0.f); mhat+=dl; \
        _Pragma("unroll") for(int r=0;r<16;++r){C0[r]-=dl;C1[r]-=dl;} \
        const float f=__builtin_amdgcn_exp2f(-dl); l_reg*=f; if(hi==0)wsf[r32]=f; resc=true; } } \
    SBAR(); \
    GAPB(o[0]=__builtin_amdgcn_mfma_f32_32x32x16_bf16(PAF(0),VFR(0),o[0],0,0,0), C0,0); \
    GAPB(o[1]=__builtin_amdgcn_mfma_f32_32x32x16_bf16(PAF(0),VFR(4),o[1],0,0,0), C0,4); \
    KRD(GL,0); GAPB(o[0]=__builtin_amdgcn_mfma_f32_32x32x16_bf16(PAF(1),VFR(1),o[0],0,0,0), C0,8); \
    KRD(GL,1); GAPB(o[1]=__builtin_amdgcn_mfma_f32_32x32x16_bf16(PAF(1),VFR(5),o[1],0,0,0), C0,12); \
    KRD(GL,2); GAPB(o[0]=__builtin_amdgcn_mfma_f32_32x32x16_bf16(PAF(2),VFR(2),o[0],0,0,0), C1,0); \
    KRD(GL,3); GAPB(o[1]=__builtin_amdgcn_mfma_f32_32x32x16_bf16(PAF(2),VFR(6),o[1],0,0,0), C1,4); \
    GAPB(o[0]=__builtin_amdgcn_mfma_f32_32x32x16_bf16(PAF(3),VFR(3),o[0],0,0,0), C1,8); \
    GAPB(o[1]=__builtin_amdgcn_mfma_f32_32x32x16_bf16(PAF(3),VFR(7),o[1],0,0,0), C1,12); \
    pv(o+2,vb0+2*sl_prev+8192,PAF(0),PAF(1),PAF(2),PAF(3));   \
    }while(0)
  int t=1;
  #undef CMASK
  #define CMASK(P0,P1,t) do{}while(0)
  for(;t+5<NT;t+=2){
    STEP(pB0,pB1,pA0,pA1,t,true,true,true);     WAIT_BAR(3); RESC(); ROT();
    STEP(pA0,pA1,pB0,pB1,t+1,true,true,true);   WAIT_BAR(3); RESC(); ROT();
  }
  #undef CMASK
  #define CMASK(P0,P1,t) do{int jb_=(t)-(NT-4); if(jb_>=0)cmask(P0,P1,jb_,qrel,hi);}while(0)
  #define ENDW(tt) do{ if((tt)+3<NT){WAIT_BAR(3);} else if((tt)+2<NT){WAIT_BAR(2);} else {WAIT_BAR(0);} }while(0)
  for(;t+1<NT;t+=2){
    STEP(pB0,pB1,pA0,pA1,t,(t+3<NT),(t+1<NT),(t+1<NT));       ENDW(t);   RESC(); ROT();
    STEP(pA0,pA1,pB0,pB1,t+1,(t+4<NT),(t+2<NT),(t+2<NT));     ENDW(t+1); RESC(); ROT();
  }
  STEP(pB0,pB1,pA0,pA1,NT-1,false,false,false); RESC();
  { float sacc=pB0[0]+pB0[1]; _Pragma("unroll") for(int r=2;r<16;++r)sacc+=pB0[r]; _Pragma("unroll") for(int r=0;r<16;++r)sacc+=pB1[r]; l_reg+=sacc;
    pw0=(u32x4){PKW(pB0,0),PKW(pB0,2),PKW(pB0,4),PKW(pB0,6)};pw1=(u32x4){PKW(pB0,8),PKW(pB0,10),PKW(pB0,12),PKW(pB0,14)};pw2=(u32x4){PKW(pB1,0),PKW(pB1,2),PKW(pB1,4),PKW(pB1,6)};pw3=(u32x4){PKW(pB1,8),PKW(pB1,10),PKW(pB1,12),PKW(pB1,14)};
    SBAR(); pv(o,vb0+2*sl_cur,PAF(0),PAF(1),PAF(2),PAF(3)); pv(o+2,vb0+2*sl_cur+8192,PAF(0),PAF(1),PAF(2),PAF(3)); }
  #undef PKW
  #undef PAF
  #undef VFR
  #undef PIN
  #undef MX3
  #undef GAPA
  #undef GAPB
  #undef EX
  #undef VRD
  #undef KRD
  #undef STEP
  #undef ENDW
  {auto rr=__builtin_amdgcn_permlane32_swap(__float_as_uint(l_reg),__float_as_uint(l_reg),false,false);l_reg=__uint_as_float(rr[0])+__uint_as_float(rr[1]);}
  if(hi==0)wsf[32+r32]=l_reg;asm volatile("s_waitcnt lgkmcnt(0)":::"memory");
  float rli[16];
  #pragma unroll
  for(int r=0;r<16;++r)rli[r]=__builtin_amdgcn_rcpf(wsf[32+crow(r,hi)]);
  bf16*Ow=O+(rowbase+q0+wid*QBLK)*DM+hv*D;
  { bf16*stg=(bf16*)(shm+LDS_OST)+wid*4096;
    #pragma unroll
    for(int r=0;r<16;++r){const int orow=crow(r,hi);
      #pragma unroll
      for(int d0=0;d0<4;++d0)stg[orow*128+d0*32+r32]=__float2bfloat16(o[d0][r]*rli[r]);}
    asm volatile("s_waitcnt lgkmcnt(0)":::"memory");
    #pragma unroll
    for(int i=0;i<8;++i){const int row=i*4+(lane>>4),ch=lane&15; const u32x4 v=*(const u32x4*)(stg+row*128+ch*8); ATTN_STORE16(Ow+(long)row*DM+ch*8,v);} }
  asm volatile("s_waitcnt lgkmcnt(0)\n\ts_barrier":::"memory");
  #undef QR
  #undef DMA_K
  #undef DMA_V
  #undef CMASK
  #undef START
  #undef RESC
  #undef ROT
}
constexpr int ATTN_LDS_BYTES=LDS_BYTES;
struct AttnTensors { const bf16* Q; const bf16* K; const bf16* V; bf16* O0; bf16* O1; };
template<int THRL=8> __device__ __forceinline__ void attn_phase(char*lds,const AttnTensors&T,int vcu,const int wid){
  const int bhc=vcu>>1, part=vcu&1, b=bhc>>4, h=(bhc>>1)&7, c=bhc&1;
  bf16*O=c?T.O1:T.O0;
  for(int i=0;i<16;++i){ const int j=2*(i>>1)+part, qb=(i&1)?(NQB-1-j):j; attn_unit<THRL>(wid,b,2*h+c,2*h,qb,T.Q,T.K,T.V,O,lds); }
}
#undef SBAR
#undef WAIT_BAR
}
#define XB_TMO      128
#define XB_XCNT(j)  (256  + 64 * (j))
#define XB_XSUB(j)  (1280 + 64 * (j))
#define XB_XGEN(j)  (2304 + 64 * (j))
#define XB_TOP      3328
#define XB_TOPGEN   3392
#define XCD_BAR_WORDS 3456
#define XB_SPIN_CAP (1u << 18)

__device__ __forceinline__ unsigned xb_ld(unsigned* p)              { return __hip_atomic_load(p, __ATOMIC_RELAXED, __HIP_MEMORY_SCOPE_AGENT); }
__device__ __forceinline__ unsigned xb_add(unsigned* p, unsigned v) { return __hip_atomic_fetch_add(p, v, __ATOMIC_RELAXED, __HIP_MEMORY_SCOPE_AGENT); }
__device__ __forceinline__ unsigned xb_xcc_id() { return (unsigned)__builtin_amdgcn_s_getreg((3 << 11) | 20) & 0xFu; }
#define XB_SPIN(cond, bar) do { unsigned _sp = 0; while (cond) { __builtin_amdgcn_s_sleep(1); \
    if ((++_sp & 255u) == 0u) { if (xb_ld(&(bar)[XB_TMO])) break; if (_sp > XB_SPIN_CAP) { atomicAdd(&(bar)[XB_TMO], 1u); break; } } } } while (0)

struct XcdBarrier {
    unsigned* bar; unsigned x;
    int wave;
    volatile LAS unsigned* st;
};

__device__ __forceinline__ bool xb_thread0(int wave) { return wave == 0 && __builtin_amdgcn_mbcnt_hi(~0u, __builtin_amdgcn_mbcnt_lo(~0u, 0u)) == 0u; }
__device__ __forceinline__ XcdBarrier xcd_barrier_post(unsigned* bar, volatile LAS unsigned* st, int wave) {
    XcdBarrier b; b.bar = bar; b.x = xb_xcc_id(); b.st = st; b.wave = wave;
    if (xb_thread0(wave)) (void)xb_add(&bar[XB_XCNT(b.x)], 1u);
    return b;
}
__device__ __forceinline__ void xcd_barrier_complete(unsigned* bar, unsigned x, unsigned& nloc, unsigned& nx) {
    const unsigned G = gridDim.x * gridDim.y * gridDim.z;
    unsigned sum, cnt, mine, sp = 0u;
    for (;;) {
        sum = 0u; cnt = 0u; mine = 0u;
#pragma unroll
        for (unsigned j = 0; j < 16; ++j) { const unsigned c = xb_ld(&bar[XB_XCNT(j)]); sum += c; cnt += (c > 0u) ? 1u : 0u; mine = (j == x) ? c : mine; }
        if (sum == G) break;
        __builtin_amdgcn_s_sleep(1);
        if ((++sp & 255u) == 0u) { if (xb_ld(&bar[XB_TMO])) break; if (sp > XB_SPIN_CAP) { atomicAdd(&bar[XB_TMO], 1u); break; } }
    }
    nloc = mine > 0u ? mine : 1u; nx = cnt > 0u ? cnt : 1u;
}

__device__ __forceinline__ void xcd_barrier(const XcdBarrier& b) {
    asm volatile("s_waitcnt vmcnt(0)" ::: "memory");
    __syncthreads();
    if (xb_thread0(b.wave)) {
        unsigned* bar = b.bar;
        __builtin_amdgcn_s_waitcnt(0);
        unsigned nloc = b.st[0], nx = b.st[1];
        if (nloc == 0u) { xcd_barrier_complete(bar, b.x, nloc, nx); b.st[0] = nloc; b.st[1] = nx; }
        const unsigned old = xb_add(&bar[XB_XSUB(b.x)], 1u);
        const unsigned gen = old / nloc;
        if (old + 1u == (gen + 1u) * nloc) {
            __builtin_amdgcn_fence(__ATOMIC_RELEASE, "agent");
            asm volatile("s_waitcnt vmcnt(0)" ::: "memory");
            const unsigned og = xb_add(&bar[XB_TOP], 1u);
            const unsigned tg = og / nx;
            if (og + 1u == (tg + 1u) * nx) xb_add(&bar[XB_TOPGEN], 1u);
            else XB_SPIN(xb_ld(&bar[XB_TOPGEN]) == tg, bar);
            __builtin_amdgcn_fence(__ATOMIC_ACQUIRE, "agent");
            xb_add(&bar[XB_XGEN(b.x)], 1u);
            asm volatile("s_waitcnt vmcnt(0)" ::: "memory");
        } else {
            XB_SPIN(xb_ld(&bar[XB_XGEN(b.x)]) == gen, bar);
            __builtin_amdgcn_fence(__ATOMIC_ACQUIRE, "agent");
            asm volatile("s_waitcnt vmcnt(0)" ::: "memory");
        }
    }
    __syncthreads();
}
enum { I_X = 0, I_MEM, I_POS, I_AWIN, I_ALAM, I_ASUBG, I_AWOUT, I_BWIN, I_BQG, I_BKVG, I_BWUQ, I_BWQIDX, I_BWUK, I_BWUV, I_BWOUT, I_MEMWKV, I_XAWQ, I_XAWOUT,
       I_MWG, I_MBG, I_MWE, I_MBE, I_MWGATE, I_MWUP, I_MWDOWN, I_LNG, I_LNB, N_IN };
struct Frame {
    LAS unsigned char* lds;
    volatile LAS unsigned* MISC;
    gu32* ctl;
    unsigned char* ws;
    int vcu, G, wave;
    float* out;
};
#define CAS __attribute__((address_space(4)))
__device__ __forceinline__ const float* ld_in(int i) { const float* CAS const* tab = (const float* CAS const*)__builtin_amdgcn_kernarg_segment_ptr(); asm volatile("" : "+s"(tab)); return tab[i]; }
#define WSP(T_, off) ((T_*)(F.ws + (off)))
__device__ __forceinline__ int hw_lane() { int l; asm volatile("v_mbcnt_lo_u32_b32 %0, -1, 0\n\tv_mbcnt_hi_u32_b32 %0, -1, %0" : "=v"(l)); return l;     }
#define PHASE_IDS() const int wave = F.wave, lane = hw_lane(), tid = wave * 64 + lane; (void)tid; (void)lane; (void)wave

__device__ __forceinline__ void tr_item(const float* W, int ldw, int c0, int N, bf16* WT, int ldt, int row_off, int rs, const float* kscale, float cs, int cs_lim, LAS float* scr, int item, int lane) {
    const int nblk = (N + 31) / 32, kb = item / nblk, nb = item % nblk, k0 = 64 * kb, n0 = 32 * nb;
    if ((N & 3) == 0 && (ldw & 3) == 0 && (c0 & 3) == 0) {
        const int n4 = n0 + 4 * (lane & 7); const bool nok = n4 < N; const float csn = n4 < cs_lim ? cs : 1.0f; f32x4 v[8];
#pragma unroll
        for (int i = 0; i < 8; ++i) { const int kk = 8 * i + (lane >> 3); v[i] = nok ? *(const GAS f32x4*)(W + (size_t)(k0 + kk) * ldw + c0 + n4) : (f32x4){0.f, 0.f, 0.f, 0.f}; }
#pragma unroll
        for (int i = 0; i < 8; ++i) { const int kk = 8 * i + (lane >> 3); float sc = csn; if (kscale) sc *= kscale[k0 + kk];
#pragma unroll
            for (int e = 0; e < 4; ++e) scr[kk * 33 + 4 * (lane & 7) + e] = v[i][e] * sc; }
    } else {
    const int nl = n0 + (lane & 31); const bool nok = nl < N; const float csn = nl < cs_lim ? cs : 1.0f;
#pragma unroll 8
    for (int i = 0; i < 32; ++i) { const int kk = 2 * i + (lane >> 5); float v = 0.f;
        if (nok) { v = W[(size_t)(k0 + kk) * ldw + c0 + nl] * csn; if (kscale) v *= kscale[k0 + kk]; }
        scr[kk * 33 + (lane & 31)] = v; }
    }
    LDS_WAIT(); asm volatile("" ::: "memory");
    const int c = lane & 7;
#pragma unroll
    for (int j = 0; j < 4; ++j) { const int n = (lane >> 3) + 8 * j; const LAS float* s = scr + (8 * c) * 33 + n;
        v4u o; o.x = pk2(s[0 * 33], s[1 * 33]); o.y = pk2(s[2 * 33], s[3 * 33]); o.z = pk2(s[4 * 33], s[5 * 33]); o.w = pk2(s[6 * 33], s[7 * 33]);
        if (n0 + n < N) *(GAS v4u*)(WT + (size_t)(row_off + (n0 + n) * rs) * ldt + k0 + 8 * c) = o; }
    LDS_WAIT(); asm volatile("" ::: "memory");
}
#ifndef MK_REP
#define MK_REP 0ull
#endif
#define P0REP(b) (1 + (int)((MK_REP >> (b)) & 1ull))
__device__ __forceinline__ void p0_prologue(Frame& F) {
    PHASE_IDS();
    LAS float* scr = (LAS float*)(F.lds + RING_OFF + wave * 16384);
    const int gw = F.vcu * NWAVES + wave, NGW = F.G * NWAVES;
    constexpr int IT_QKV = 16 * 96, IT_O = 16 * 32, IT_MKV = 16 * 64, IT_XQ = 16 * 32, IT_BIN = 16 * 20, IT_G = 16 * 16, IT_D = 8 * 32, IT_QIDX = 4 * 32, IT_QR = 4 * 1;
    constexpr int N1 = IT_QKV, N2 = N1 + IT_O, N3 = N2 + IT_MKV, N4 = N3 + 2 * IT_XQ, N5 = N4 + 2 * IT_XQ, N6 = N5 + IT_BIN, N7 = N6 + IT_QIDX, N8 = N7 + 8 * IT_QR;
    constexpr int PER_E = 2 * IT_G + IT_D, NITEMS = N8 + 32 * PER_E;
    const float* lng = ld_in(I_LNG);
    for (int rp = 0; rp < P0REP(22); ++rp)
    for (int it = gw; it < NITEMS; it += NGW) {
        if (it < N1) tr_item(ld_in(I_AWIN), 3072, 0, 3072, WSP(bf16, W_QKV), 1024, 0, 1, nullptr, C2, 1024, scr, it, lane);
        else if (it < N2) tr_item(ld_in(I_AWOUT), 1024, 0, 1024, WSP(bf16, W_O), 1024, 0, 1, nullptr, 1.f, 0, scr, it - N1, lane);
        else if (it < N3) tr_item(ld_in(I_MEMWKV), 2048, 0, 2048, WSP(bf16, W_MKV), 1024, 0, 1, nullptr, 1.f, 0, scr, it - N2, lane);
        else if (it < N4) { }
        else if (it < N5) { const int l = (it - N4) / IT_XQ; tr_item(ld_in(I_XAWOUT) + (size_t)l * 1048576, 1024, 0, 1024, WSP(bf16, W_XO) + (size_t)l * 1048576, 1024, 0, 1, nullptr, 1.f, 0, scr, (it - N4) % IT_XQ, lane); }
        else if (it < N6) tr_item(ld_in(I_BWIN), BIN_W, 0, BIN_W, WSP(bf16, W_BIN), 1024, 0, 1, lng + 2 * 1024, 1.f, 0, scr, it - N5, lane);
        else if (it < N7) tr_item(ld_in(I_BWQIDX), 1024, 0, 1024, WSP(bf16, W_Q2), 256, 2304, 1, nullptr, 1.f, 0, scr, it - N6, lane);
        else if (it < N8) { const int h = (it - N7) / IT_QR; tr_item(ld_in(I_BWUQ), 1024, h * 128, 32, WSP(bf16, W_Q2), 256, 2048 + h * 32, 1, nullptr, SC2, 1 << 30, scr, (it - N7) % IT_QR, lane); }
        else { const int r = it - N8, le = r / PER_E, q = r % PER_E;
            if (q < IT_G) tr_item(ld_in(I_MWGATE) + (size_t)le * 524288, 512, 0, 512, WSP(bf16, W_GU) + (size_t)le * 1048576, 1024, 0, 2, nullptr, 1.f, 0, scr, q, lane);
            else if (q < 2 * IT_G) tr_item(ld_in(I_MWUP) + (size_t)le * 524288, 512, 0, 512, WSP(bf16, W_GU) + (size_t)le * 1048576, 1024, 1, 2, nullptr, 1.f, 0, scr, q - IT_G, lane);
            else tr_item(ld_in(I_MWDOWN) + (size_t)le * 524288, 1024, 0, 1024, WSP(bf16, W_DN) + (size_t)le * 524288, 512, 0, 1, nullptr, 1.f, 0, scr, q - 2 * IT_G, lane); }
    }
    for (int rp = 0; rp < P0REP(23); ++rp) {
        const float* wuq = ld_in(I_BWUQ); const float* wuk = ld_in(I_BWUK); bf16* dst = WSP(bf16, W_Q2);
        for (int it = gw; it < 8 * 4 * 64; it += NGW) { const int rb = it & 63, kb = (it >> 6) & 3, h = it >> 8, k = kb * 64 + lane;
            const float* a = wuq + (size_t)k * 1024 + h * 128 + 32; float av[96];
#pragma unroll
            for (int n = 0; n < 96; n += 4) { const f32x4 v = *(const GAS f32x4*)(a + n); av[n] = v[0]; av[n + 1] = v[1]; av[n + 2] = v[2]; av[n + 3] = v[3]; }
#pragma unroll 1
            for (int r = rb * 4; r < rb * 4 + 4; ++r) { const float* bb = wuk + ((size_t)h * 256 + r) * 96; float s = 0.f;
#pragma unroll
                for (int n = 0; n < 96; n += 16) { const f32x4 b0 = *(const GAS f32x4*)(bb + n), b1 = *(const GAS f32x4*)(bb + n + 4), b2 = *(const GAS f32x4*)(bb + n + 8), b3 = *(const GAS f32x4*)(bb + n + 12);
                    s += (av[n] * b0[0] + av[n + 1] * b0[1]) + (av[n + 2] * b0[2] + av[n + 3] * b0[3]); s += (av[n + 4] * b1[0] + av[n + 5] * b1[1]) + (av[n + 6] * b1[2] + av[n + 7] * b1[3]);
                    s += (av[n + 8] * b2[0] + av[n + 9] * b2[1]) + (av[n + 10] * b2[2] + av[n + 11] * b2[3]); s += (av[n + 12] * b3[0] + av[n + 13] * b3[1]) + (av[n + 14] * b3[2] + av[n + 15] * b3[3]);
                    asm volatile("" ::: "memory"); }
                dst[(size_t)(h * 256 + r) * 256 + k] = (bf16)f2bf(s * SC2); } }
        const float* wuv = ld_in(I_BWUV); const float* wo = ld_in(I_BWOUT); bf16* d2 = WSP(bf16, W_UVO);
        for (int it = gw; it < 8 * 32 * 16; it += NGW) { const int nb = it & 15, r8 = (it >> 4) & 31, h = it >> 9, n = nb * 64 + lane;
            const float* a = wuv + ((size_t)h * 256 + r8 * 8) * 128; const float* bb = wo + (size_t)(h * 128) * 1024 + n; float acc[8];
#pragma unroll
            for (int jr = 0; jr < 8; ++jr) acc[jr] = 0.f;
#pragma unroll 8
            for (int v = 0; v < 128; v += 4) { const float b0 = bb[(size_t)v * 1024], b1 = bb[(size_t)(v + 1) * 1024], b2 = bb[(size_t)(v + 2) * 1024], b3 = bb[(size_t)(v + 3) * 1024];
#pragma unroll
                for (int jr = 0; jr < 8; ++jr) { const f32x4 av = *(const GAS f32x4*)(a + jr * 128 + v); acc[jr] += (av[0] * b0 + av[1] * b1) + (av[2] * b2 + av[3] * b3); } }
#pragma unroll
            for (int jr = 0; jr < 8; ++jr) d2[(size_t)n * 2048 + h * 256 + r8 * 8 + jr] = (bf16)f2bf(acc[jr]); }
    }
    const int gt = F.vcu * (NWAVES * 64) + tid, NGT = F.G * NWAVES * 64;
    for (int rp = 0; rp < P0REP(24); ++rp) {   const GAS f32x4* x4 = (const GAS f32x4*)ld_in(I_X); GAS v4u* xb = (GAS v4u*)WSP(bf16, S_XB);
        for (int i0 = gt; i0 < T * D / 8; i0 += 4 * NGT) { f32x4 a[4], b[4];
#pragma unroll
            for (int u = 0; u < 4; ++u) { a[u] = x4[2 * (size_t)(i0 + u * NGT)]; b[u] = x4[2 * (size_t)(i0 + u * NGT) + 1]; }
#pragma unroll
            for (int u = 0; u < 4; ++u) { v4u o; o.x = pk2(a[u][0], a[u][1]); o.y = pk2(a[u][2], a[u][3]); o.z = pk2(b[u][0], b[u][1]); o.w = pk2(b[u][2], b[u][3]); xb[i0 + u * NGT] = o; } }
        const GAS f32x4* m4 = (const GAS f32x4*)ld_in(I_MEM); GAS v4u* mb = (GAS v4u*)WSP(bf16, WS_MEMB);
        for (int i = gt; i < MEMROWS * D / 8; i += NGT) { const f32x4 a = m4[2 * (size_t)i], b = m4[2 * (size_t)i + 1]; v4u o; o.x = pk2(a[0], a[1]); o.y = pk2(a[2], a[3]); o.z = pk2(b[0], b[1]); o.w = pk2(b[2], b[3]); mb[i] = o; }
        { const GAS f32x4* q4 = (const GAS f32x4*)ld_in(I_XAWQ); GAS v4u* qb = (GAS v4u*)WSP(bf16, W_XQ); const float* lg = ld_in(I_LNG);
          for (int i = gt; i < 2 * 1024 * 1024 / 8; i += NGT) { const int l = i >> 17, k = (i >> 7) & 1023; const float sc = lg[(l * 3 + 0) * 1024 + k] * XQS; const f32x4 a = q4[2 * (size_t)i] * sc, b = q4[2 * (size_t)i + 1] * sc;
              v4u o; o.x = pk2(a[0], a[1]); o.y = pk2(a[2], a[3]); o.z = pk2(b[0], b[1]); o.w = pk2(b[2], b[3]); qb[i] = o; } }
        GAS v4u* zb = (GAS v4u*)(WSP(bf16, W_BIN) + (size_t)BIN_W * 1024);
        for (int i = gt; i < (BIN_LD - BIN_W) * 1024 / 8; i += NGT) zb[i] = (v4u){0u, 0u, 0u, 0u};
    }
    for (int rp = 0; rp < P0REP(25); ++rp) {   const int* pos = (const int*)ld_in(I_POS); float* r16 = WSP(float, WS_ROT16); float* r32 = WSP(float, WS_ROT32);
        for (int i = gt; i < T * 24; i += NGT) { const int t = i / 24, q = i % 24; const int jj = q < 8 ? 2 * q : q - 8;
            const double invf = exp2(-(double)jj * 1.1832230355827609), ang = (double)pos[t] * invf, n = rint(ang * 0.15915494309189535), red = fma(-n, 6.283185307179586, ang);
            const float rf = (float)red, c = cosf(rf), s = sinf(rf);
            float* d = q < 8 ? r16 + (size_t)t * 16 + q * 2 : r32 + (size_t)t * 32 + (q - 8) * 2; d[0] = c; d[1] = s; }
    }
    if (gt == 0) { const float* lam = ld_in(I_ALAM); float s01 = 0.f, s23 = 0.f; for (int i = 0; i < 64; ++i) { s01 += lam[i] * lam[64 + i]; s23 += lam[128 + i] * lam[192 + i]; }
        WSP(float, WS_SMALL)[SM_LAM] = expf(s01) - expf(s23) + 0.2f; }
}
__device__ __forceinline__ void fold_vectors(Frame& F) {
    PHASE_IDS();
    const int gw = F.vcu * NWAVES + wave, NGW = F.G * NWAVES;
    for (int it = gw; it < 3 * 1024; it += NGW) { const int f = it >> 10, n = it & 1023;
        const bf16* wt = f < 2 ? WSP(bf16, W_XQ) + (size_t)f * 1048576 : WSP(bf16, W_BIN);
        const float* w = f < 2 ? ld_in(I_XAWQ) + (size_t)f * 1048576 : ld_in(I_BWIN); const int ldw = f < 2 ? 1024 : BIN_W, nv = f < 2 ? 1024 : BIN_W;
        const float* bb = ld_in(I_LNB) + (f < 2 ? (f * 3 + 0) * 1024 : 2 * 1024); const float cs = f < 2 ? XQS : 1.0f;
        float* dst = WSP(float, WS_SMALL) + SM_GW + f * 2048;
        float sg = 0.f, sb = 0.f;
        if (n < nv) { v4u a = (v4u){0u, 0u, 0u, 0u}, b = a; if (f == 2) { a = *(const GAS v4u*)(wt + (size_t)n * 1024 + lane * 16); b = *(const GAS v4u*)(wt + (size_t)n * 1024 + lane * 16 + 8); }
            sg = ((bflo(a.x) + bfhi(a.x)) + (bflo(a.y) + bfhi(a.y))) + ((bflo(a.z) + bfhi(a.z)) + (bflo(a.w) + bfhi(a.w))) + ((bflo(b.x) + bfhi(b.x)) + (bflo(b.y) + bfhi(b.y))) + ((bflo(b.z) + bfhi(b.z)) + (bflo(b.w) + bfhi(b.w)));
            for (int k = lane; k < 1024; k += 64) sb += bb[k] * w[(size_t)k * ldw + n]; }
        sg = wave_sum(sg); sb = wave_sum(sb) * cs;
        if (lane == 0) { dst[n] = sg; dst[1024 + n] = sb; } }
}

__device__ __forceinline__ void diff_combine(Frame& F) {
    PHASE_IDS();
    const int gw = F.vcu * NWAVES + wave, NGW = F.G * NWAVES;
    const float lam = WSP(float, WS_SMALL)[SM_LAM]; const float* sg = ld_in(I_ASUBG);
    float gv[16];
#pragma unroll
    for (int i = 0; i < 16; ++i) gv[i] = sg[(lane & 7) * 16 + i] * 0.8f;
    const bf16* O0 = WSP(bf16, S_O0); const bf16* O1 = WSP(bf16, S_O1); bf16* ON = WSP(bf16, S_ON);
    constexpr int RB = 4;
    for (int m0 = gw; m0 < T; m0 += RB * NGW) {
        v4u a0v[RB], a1v[RB], b0v[RB], b1v[RB];
#pragma unroll
        for (int u = 0; u < RB; ++u) { const size_t mo = (size_t)(m0 + u * NGW) * 1024 + lane * 16;
            a0v[u] = *(const GAS v4u*)(O0 + mo); a1v[u] = *(const GAS v4u*)(O0 + mo + 8); b0v[u] = *(const GAS v4u*)(O1 + mo); b1v[u] = *(const GAS v4u*)(O1 + mo + 8); }
#pragma unroll
        for (int u = 0; u < RB; ++u) { const int m = m0 + u * NGW; const v4u a0 = a0v[u], a1 = a1v[u], b0 = b0v[u], b1 = b1v[u];
        const unsigned aw[8] = {a0.x, a0.y, a0.z, a0.w, a1.x, a1.y, a1.z, a1.w}, bw[8] = {b0.x, b0.y, b0.z, b0.w, b1.x, b1.y, b1.z, b1.w};
        float o[16]; float ss = 0.f;
#pragma unroll
        for (int i = 0; i < 8; ++i) { o[2 * i] = bflo(aw[i]) - lam * bflo(bw[i]); o[2 * i + 1] = bfhi(aw[i]) - lam * bfhi(bw[i]); ss += o[2 * i] * o[2 * i] + o[2 * i + 1] * o[2 * i + 1]; }
        ss += __shfl_xor(ss, 1); ss += __shfl_xor(ss, 2); ss += __shfl_xor(ss, 4);
        const float r = 1.0f / sqrtf(ss * (1.0f / 128.0f) + LN_EPS);
        v4u w0, w1;
        w0.x = pk2(o[0] * r * gv[0], o[1] * r * gv[1]); w0.y = pk2(o[2] * r * gv[2], o[3] * r * gv[3]); w0.z = pk2(o[4] * r * gv[4], o[5] * r * gv[5]); w0.w = pk2(o[6] * r * gv[6], o[7] * r * gv[7]);
        w1.x = pk2(o[8] * r * gv[8], o[9] * r * gv[9]); w1.y = pk2(o[10] * r * gv[10], o[11] * r * gv[11]); w1.z = pk2(o[12] * r * gv[12], o[13] * r * gv[13]); w1.w = pk2(o[14] * r * gv[14], o[15] * r * gv[15]);
        *(GAS v4u*)(ON + (size_t)m * 1024 + lane * 16) = w0; *(GAS v4u*)(ON + (size_t)m * 1024 + lane * 16 + 8) = w1; }
    }
}

__device__ __forceinline__ void moe_route(Frame& F, int layer) {
    PHASE_IDS();
    const int gw = F.vcu * NWAVES + wave, NGW = F.G * NWAVES;
    LAS float* wl = (LAS float*)(F.lds + RING_OFF);
    { const float* wg = ld_in(I_MWG) + (size_t)layer * 1024 * 4; const float* we = ld_in(I_MWE) + (size_t)layer * 1024 * 16;
      float tg[8], te[32];
#pragma unroll
      for (int k = 0; k < 8; ++k) tg[k] = wg[tid + k * (NWAVES * 64)];
#pragma unroll
      for (int k = 0; k < 32; ++k) te[k] = we[tid + k * (NWAVES * 64)];
#pragma unroll
      for (int k = 0; k < 8; ++k) { const int i = tid + k * (NWAVES * 64); wl[(i & 3) * 1024 + (i >> 2)] = tg[k]; }
#pragma unroll
      for (int k = 0; k < 32; ++k) { const int i = tid + k * (NWAVES * 64); wl[(4 + (i & 15)) * 1024 + (i >> 4)] = te[k]; } }
    LAS unsigned* lcnt = (LAS unsigned*)(F.lds + RING_OFF + 81920);
    if (tid < 16) lcnt[tid] = 0u;
    __syncthreads();
    const bf16* preb = WSP(bf16, WS_PREB); const float* g = ld_in(I_LNG) + (layer * 3 + 1) * 1024; const float* b = ld_in(I_LNB) + (layer * 3 + 1) * 1024;
    const float* bg = ld_in(I_MBG) + layer * 4; const float* be = ld_in(I_MBE) + layer * 16;
    f32x4 gl[4], bl[4];
#pragma unroll
    for (int j = 0; j < 4; ++j) { gl[j] = *(const f32x4*)(g + 256 * j + 4 * lane); bl[j] = *(const f32x4*)(b + 256 * j + 4 * lane); }
    bf16* XH = WSP(bf16, S_XH); f32x2* statf = WSP(f32x2, WS_STATF); int* route = WSP(int, WS_ROUTE); f32x2* routew = WSP(f32x2, WS_ROUTEW);
    gu32* cnt = F.ctl + CW_CNT + layer * 16 * 64;
    constexpr int RB = 4;
    auto rows_load = [&](v2u (&r)[RB][4], const int m0) __attribute__((always_inline)) {
#pragma unroll
        for (int u = 0; u < RB; ++u) { const bf16* xr = preb + (size_t)(m0 + u * NGW) * 1024 + 4 * lane;
#pragma unroll
            for (int j = 0; j < 4; ++j) r[u][j] = *(const GAS v2u*)(xr + 256 * j); } };
    auto rows_body = [&](v2u (&r)[RB][4], const int m0) __attribute__((always_inline)) {
        float mean[RB], rstd[RB]; f32x4 v[RB][4];
#pragma unroll
        for (int u = 0; u < RB; ++u)
#pragma unroll
            for (int j = 0; j < 4; ++j) v[u][j] = (f32x4){bflo(r[u][j].x), bfhi(r[u][j].x), bflo(r[u][j].y), bfhi(r[u][j].y)};
#pragma unroll
        for (int u = 0; u < RB; ++u) { float s = 0.f;
#pragma unroll
            for (int j = 0; j < 4; ++j) s += (v[u][j][0] + v[u][j][1]) + (v[u][j][2] + v[u][j][3]);
            mean[u] = wave_sum(s) * (1.f / 1024.f); }
#pragma unroll
        for (int u = 0; u < RB; ++u) { float s2 = 0.f;
#pragma unroll
            for (int j = 0; j < 4; ++j) { v[u][j] = v[u][j] - mean[u]; s2 += (v[u][j][0] * v[u][j][0] + v[u][j][1] * v[u][j][1]) + (v[u][j][2] * v[u][j][2] + v[u][j][3] * v[u][j][3]); }
            rstd[u] = 1.f / sqrtf(wave_sum(s2) * (1.f / 1024.f) + LN_EPS); }
#pragma unroll
        for (int u = 0; u < RB; ++u) { const int m = m0 + u * NGW;
#pragma unroll
            for (int j = 0; j < 4; ++j) { v[u][j] = v[u][j] * rstd[u] * gl[j] + bl[j];
                v2u w; w.x = pk2(v[u][j][0], v[u][j][1]); w.y = pk2(v[u][j][2], v[u][j][3]); *(GAS v2u*)(XH + (size_t)m * 1024 + 256 * j + 4 * lane) = w; } }
        float gq[RB][4];
#pragma unroll
        for (int o = 0; o < 4; ++o) { f32x4 w[4];
#pragma unroll
            for (int j = 0; j < 4; ++j) w[j] = *(const LAS f32x4*)(wl + o * 1024 + 256 * j + 4 * lane);
#pragma unroll
            for (int u = 0; u < RB; ++u) { float p = 0.f;
#pragma unroll
                for (int j = 0; j < 4; ++j) p += (v[u][j][0] * w[j][0] + v[u][j][1] * w[j][1]) + (v[u][j][2] * w[j][2] + v[u][j][3] * w[j][3]);
                gq[u][o] = wave_sum(p) + bg[o]; } }
#pragma unroll
        for (int u = 0; u < RB; ++u) { const int m = m0 + u * NGW;
            const float g0 = gq[u][0], g1 = gq[u][1], g2 = gq[u][2], g3 = gq[u][3];
            int gs = 0; float gm = g0; if (g1 > gm) { gm = g1; gs = 1; } if (g2 > gm) { gm = g2; gs = 2; } if (g3 > gm) { gm = g3; gs = 3; }
            const float gate = __builtin_amdgcn_rcpf(__builtin_amdgcn_exp2f((g0 - gm) * LOG2E) + __builtin_amdgcn_exp2f((g1 - gm) * LOG2E) + __builtin_amdgcn_exp2f((g2 - gm) * LOG2E) + __builtin_amdgcn_exp2f((g3 - gm) * LOG2E));
            gs = __builtin_amdgcn_readfirstlane(gs);
            float e[4];
#pragma unroll
            for (int o = 0; o < 4; ++o) { float p = 0.f; const LAS float* wp = wl + (4 + gs * 4 + o) * 1024;
#pragma unroll
                for (int j = 0; j < 4; ++j) { const f32x4 w = *(const LAS f32x4*)(wp + 256 * j + 4 * lane); p += (v[u][j][0] * w[0] + v[u][j][1] * w[1]) + (v[u][j][2] * w[2] + v[u][j][3] * w[3]); }
                e[o] = wave_sum(p) + be[gs * 4 + o]; }
            int i1 = 0; float v1 = e[0]; if (e[1] > v1) { v1 = e[1]; i1 = 1; } if (e[2] > v1) { v1 = e[2]; i1 = 2; } if (e[3] > v1) { v1 = e[3]; i1 = 3; }
            int i2 = -1; float v2 = -INFINITY;
#pragma unroll
            for (int i = 0; i < 4; ++i) if (i != i1 && (i2 < 0 || e[i] > v2)) { v2 = e[i]; i2 = i; }
            const float e2 = __builtin_amdgcn_exp2f((v2 - v1) * LOG2E), w1 = gate * __builtin_amdgcn_rcpf(1.0f + e2), w2 = gate - w1;
            if (lane == 0) { const int ea = gs * 4 + i1, eb = gs * 4 + i2;
                const int pa = (int)__hip_atomic_fetch_add(lcnt + ea, 1u, __ATOMIC_RELAXED, __HIP_MEMORY_SCOPE_WORKGROUP), pb = (int)__hip_atomic_fetch_add(lcnt + eb, 1u, __ATOMIC_RELAXED, __HIP_MEMORY_SCOPE_WORKGROUP);
                *(GAS v4i*)(route + (size_t)m * 4) = (v4i){ea, eb, pa, pb}; routew[m] = (f32x2){w1, w2}; statf[m] = (f32x2){mean[u], rstd[u]}; } }
        };
    v2u va[RB][4], vb[RB][4];
    rows_load(va, gw);
    for (int m0 = gw; m0 < T; m0 += 2 * RB * NGW) { const int m1 = m0 + RB * NGW, m2 = m0 + 2 * RB * NGW;
        if (m1 < T) rows_load(vb, m1);
        rows_body(va, m0);
        if (m1 < T) { if (m2 < T) rows_load(va, m2); rows_body(vb, m1); }
    }
    __syncthreads();
    if (tid < 16) WSP(int, WS_WGB)[F.vcu * 16 + tid] = (int)__hip_atomic_fetch_add(cnt + tid * 64, lcnt[tid], RLX_AGENT);
}
__device__ __forceinline__ void moe_index(Frame& F, int layer) {
    PHASE_IDS();
    gu32* cnt = F.ctl + CW_CNT + layer * 16 * 64;
    int c[16], off[16]; int acc = 0;
#pragma unroll
    for (int e = 0; e < 16; ++e) { c[e] = (int)__hip_atomic_load(cnt + e * 64, RLX_AGENT); off[e] = acc; acc += ((c[e] + 255) >> 8) << 8; }
    int* rowidx = WSP(int, WS_ROWIDX); float* wsort = WSP(float, WS_WSORT); int* tile_e = WSP(int, WS_TILEE); int* pos2 = WSP(int, WS_POS2);
    const int* route = WSP(int, WS_ROUTE); const f32x2* routew = WSP(f32x2, WS_ROUTEW);
    const int gt = F.vcu * (NWAVES * 64) + tid, NGT = F.G * NWAVES * 64;
    for (int t = gt; t < T; t += NGT) { const v4i r = *(const GAS v4i*)(route + (size_t)t * 4); const f32x2 w = routew[t];
        int oa = 0, ob = 0;
#pragma unroll
        for (int e = 0; e < 16; ++e) { oa = r[0] == e ? off[e] : oa; ob = r[1] == e ? off[e] : ob; }
        const int* wgb = WSP(int, WS_WGB) + ((t & (F.G * NWAVES - 1)) >> 3) * 16;
        const int ra = oa + wgb[r[0]] + r[2], rb = ob + wgb[r[1]] + r[3];
        rowidx[ra] = t; wsort[ra] = w[0]; rowidx[rb] = t; wsort[rb] = w[1]; pos2[2 * t] = ra; pos2[2 * t + 1] = rb; }
    if (F.vcu == 0) {
#pragma unroll
        for (int e = 0; e < 16; ++e) { const int pad = (((c[e] + 255) >> 8) << 8) - c[e];
            for (int i = tid; i < pad; i += NWAVES * 64) { rowidx[off[e] + c[e] + i] = 0; wsort[off[e] + c[e] + i] = 0.f; }
            for (int i = tid; i < ((c[e] + 255) >> 8); i += NWAVES * 64) tile_e[16 + (off[e] >> 8) + i] = e; }
        if (tid == 0) tile_e[0] = acc >> 8;
    }
}
struct MoeOrder {
    const int* tile_e; int ntiles, G, c; long wstride; int nn;
    __device__ bool next(int i, pg8::Unit& u) const {
        const long L = (long)i * G + c; if (L >= (long)ntiles * nn) return false;
        const int rt = (int)(L / nn), pn = (int)(L % nn), e = tile_e[16 + rt];
        u.pm = rt; u.pn = pn; u.e = e; u.aoff = 0; u.boff = (long)e * wstride + (long)pn * 256 * (wstride / 1024); return true;
    }
};
__device__ __forceinline__ void moe_combine(Frame& F, int layer) {
    PHASE_IDS();
    const int gw = F.vcu * NWAVES + wave, NGW = F.G * NWAVES;
    float* pre = F.out; const float* g = ld_in(I_LNG) + (layer * 3 + 1) * 1024; const float* b = ld_in(I_LNB) + (layer * 3 + 1) * 1024;
    const float* g2 = ld_in(I_LNG) + (layer * 3 + 2) * 1024; const float* b2 = ld_in(I_LNB) + (layer * 3 + 2) * 1024;
    const f32x2* statf = WSP(f32x2, WS_STATF); const int* pos2 = WSP(int, WS_POS2); const bf16* Y = WSP(bf16, S_Y);
    bf16* preb = WSP(bf16, WS_PREB); float* stat_new = WSP(float, WS_STAT) + (size_t)((layer * 3 + 2) & 1) * T * 32;
    constexpr int RB = 4;
    for (int m0 = gw; m0 < T; m0 += RB * NGW) {
        v2u xv[RB][4]; v2u ya[RB][4], yb[RB][4]; f32x2 st[RB];
#pragma unroll
        for (int u = 0; u < RB; ++u) { const int m = m0 + u * NGW; st[u] = statf[m]; const int ra = pos2[2 * m], rb = pos2[2 * m + 1];
#pragma unroll
            for (int j = 0; j < 4; ++j) { xv[u][j] = *(const GAS v2u*)(preb + (size_t)m * 1024 + 256 * j + 4 * lane); ya[u][j] = *(const GAS v2u*)(Y + (size_t)ra * 1024 + 256 * j + 4 * lane); yb[u][j] = *(const GAS v2u*)(Y + (size_t)rb * 1024 + 256 * j + 4 * lane); } }
#pragma unroll
        for (int u = 0; u < RB; ++u) { const int m = m0 + u * NGW;
        GAS f32x4* xr = (GAS f32x4*)(pre + (size_t)m * 1024) + lane;
        f32x4 v[4]; float s = 0.f, s2 = 0.f;
#pragma unroll
        for (int j = 0; j < 4; ++j) { const f32x4 gj = *(const f32x4*)(g + 256 * j + 4 * lane), bj = *(const f32x4*)(b + 256 * j + 4 * lane);
            const f32x4 xf = (f32x4){bflo(xv[u][j].x), bfhi(xv[u][j].x), bflo(xv[u][j].y), bfhi(xv[u][j].y)};
            const f32x4 h = (xf - st[u][0]) * st[u][1] * gj + bj;
            const f32x4 y = (f32x4){bflo(ya[u][j].x) + bflo(yb[u][j].x), bfhi(ya[u][j].x) + bfhi(yb[u][j].x), bflo(ya[u][j].y) + bflo(yb[u][j].y), bfhi(ya[u][j].y) + bfhi(yb[u][j].y)};
            v[j] = h * ALPHA + y; s += (v[j][0] + v[j][1]) + (v[j][2] + v[j][3]); s2 += (v[j][0] * v[j][0] + v[j][1] * v[j][1]) + (v[j][2] * v[j][2] + v[j][3] * v[j][3]); }
        if (layer == 0) {
#pragma unroll
            for (int j = 0; j < 4; ++j) { v2u w; w.x = pk2(v[j][0], v[j][1]); w.y = pk2(v[j][2], v[j][3]); *(GAS v2u*)(preb + (size_t)m * 1024 + 256 * j + 4 * lane) = w; }
            s = wave_sum(s); s2 = wave_sum(s2);
            if (lane < 16) *(GAS f32x2*)(stat_new + (size_t)m * 32 + lane * 2) = lane == 0 ? (f32x2){s, s2} : (f32x2){0.f, 0.f};
        } else {
            const float mean = wave_sum(s) * (1.f / 1024.f); float q = 0.f;
#pragma unroll
            for (int j = 0; j < 4; ++j) { v[j] = v[j] - mean; q += (v[j][0] * v[j][0] + v[j][1] * v[j][1]) + (v[j][2] * v[j][2] + v[j][3] * v[j][3]); }
            const float rstd = 1.f / sqrtf(wave_sum(q) * (1.f / 1024.f) + LN_EPS);
#pragma unroll
            for (int j = 0; j < 4; ++j) { const f32x4 gj = *(const f32x4*)(g2 + 256 * j + 4 * lane), bj = *(const f32x4*)(b2 + 256 * j + 4 * lane); xr[64 * j] = v[j] * rstd * gj + bj; }
        } }
    }
}
__device__ __forceinline__ void dsa_prep(Frame& F) {
    PHASE_IDS();
    const int gw = F.vcu * NWAVES + wave, NGW = F.G * NWAVES;
    const bf16* bin = WSP(bf16, S_BIN); bf16* cq = WSP(bf16, S_CQ); bf16* kvl = WSP(bf16, S_KVL); bf16* kidx = WSP(bf16, S_KIDX); float* widx = WSP(float, S_WIDX);
    const float* r16 = WSP(float, WS_ROT16); const float* r32 = WSP(float, WS_ROT32);
    const f32x4 gq = *(const f32x4*)(ld_in(I_BQG) + 4 * lane), gk = *(const f32x4*)(ld_in(I_BKVG) + 4 * lane);
    constexpr int RB = 4;
    for (int m0 = gw; m0 < T; m0 += RB * NGW) {
        f32x4 av[RB], cv[RB]; float x1v[RB], x2v[RB], c32v[RB], s32v[RB], xkv[RB], pkv[RB], c16v[RB], s16v[RB], wwv[RB];
#pragma unroll
        for (int u = 0; u < RB; ++u) { const int m = m0 + u * NGW; const bf16* row = bin + (size_t)m * BIN_LD;
            { const v2u aw = *(const GAS v2u*)(row + 4 * lane), cw = *(const GAS v2u*)(row + 256 + 4 * lane);
              av[u] = (f32x4){bflo(aw.x), bfhi(aw.x), bflo(aw.y), bfhi(aw.y)}; cv[u] = (f32x4){bflo(cw.x), bfhi(cw.x), bflo(cw.y), bfhi(cw.y)}; }
            x1v[u] = bf2f(row[512 + (lane & 15)]); x2v[u] = bf2f(row[528 + (lane & 15)]); c32v[u] = r32[(size_t)m * 32 + 2 * (lane & 15)]; s32v[u] = r32[(size_t)m * 32 + 2 * (lane & 15) + 1];
            xkv[u] = bf2f(row[544 + lane]); pkv[u] = bf2f(row[544 + ((lane ^ 8) & 63)]); c16v[u] = r16[(size_t)m * 16 + 2 * (lane & 7)]; s16v[u] = r16[(size_t)m * 16 + 2 * (lane & 7) + 1]; wwv[u] = bf2f(row[608 + (lane & 15)]); }
#pragma unroll
        for (int u = 0; u < RB; ++u) { const int m = m0 + u * NGW; const f32x4 a = av[u], c = cv[u];
        const float sa = wave_sum((a[0] * a[0] + a[1] * a[1]) + (a[2] * a[2] + a[3] * a[3])), sc = wave_sum((c[0] * c[0] + c[1] * c[1]) + (c[2] * c[2] + c[3] * c[3]));
        const float ra = 1.f / sqrtf(sa * (1.f / 256.f) + LN_EPS), rc = 1.f / sqrtf(sc * (1.f / 256.f) + LN_EPS);
        v2u w; w.x = pk2(a[0] * ra * gq[0], a[1] * ra * gq[1]); w.y = pk2(a[2] * ra * gq[2], a[3] * ra * gq[3]); *(GAS v2u*)(cq + (size_t)m * 256 + 4 * lane) = w;
        w.x = pk2(c[0] * rc * gk[0], c[1] * rc * gk[1]); w.y = pk2(c[2] * rc * gk[2], c[3] * rc * gk[3]); *(GAS v2u*)(kvl + (size_t)m * KVW + 4 * lane) = w;
        if (lane < 16) { const float x1 = x1v[u], x2 = x2v[u], cs = c32v[u], sn = s32v[u];
            kvl[(size_t)m * KVW + 256 + lane] = (bf16)f2bf(x1 * cs - x2 * sn); kvl[(size_t)m * KVW + 272 + lane] = (bf16)f2bf(x2 * cs + x1 * sn); }
        { const float x = xkv[u]; float o = x; const float p = pkv[u];
          if (lane < 16) { const float cs = c16v[u], sn = s16v[u]; o = lane < 8 ? x * cs - p * sn : x * cs + p * sn; }
          kidx[(size_t)m * 64 + lane] = (bf16)f2bf(o); }
        if (lane < 16) widx[(size_t)m * 16 + lane] = wwv[u] * 0.03125f; }
    }
    for (int i = F.vcu * (NWAVES * 64) + tid; i < NB * 256 * TOPK; i += F.G * NWAVES * 64) { const int bb = i >> 16, s = (i >> 8) & 255, j = i & 255; WSP(unsigned short, S_IDX)[((size_t)bb * SEQ + s) * TOPK + j] = (unsigned short)j; }
}
struct bfrx { bf16x8 f[4]; };
__device__ __forceinline__ float relu_s(float x) { float r; asm("v_max_f32_e32 %0, 0, %1" : "=v"(r) : "v"(x)); return r; }
__device__ __forceinline__ float fma_s(float a, float b, float c) { float r; asm("v_fma_f32 %0, %1, %2, %3" : "=v"(r) : "v"(a), "v"(b), "v"(c)); return r; }
__device__ __forceinline__ void lds_add(LAS unsigned* p, unsigned v) { asm volatile("ds_add_u32 %0, %1" :: "v"((unsigned)(unsigned long)p), "v"(v) : "memory"); }
__device__ __forceinline__ unsigned pk_max_u16(unsigned a, unsigned b) { unsigned r; asm("v_pk_max_u16 %0, %1, %2" : "=v"(r) : "v"(a), "v"(b)); return r; }
__device__ __forceinline__ unsigned pk_min_u16(unsigned a, unsigned b) { unsigned r; asm("v_pk_min_u16 %0, %1, %2" : "=v"(r) : "v"(a), "v"(b)); return r; }
template <int CTRL> __device__ __forceinline__ unsigned dpp_u(unsigned x) { return (unsigned)__builtin_amdgcn_update_dpp((int)x, (int)x, CTRL, 0xf, 0xf, false); }
__device__ __forceinline__ unsigned half_min_pk(unsigned x) {
    x = pk_min_u16(x, dpp_u<0xB1>(x)); x = pk_min_u16(x, dpp_u<0x4E>(x)); x = pk_min_u16(x, dpp_u<0x141>(x)); x = pk_min_u16(x, dpp_u<0x140>(x));
    return pk_min_u16(x, (unsigned)__shfl_xor((int)x, 16));
}
__device__ __forceinline__ float relu_v(float x) { float r; asm volatile("v_max_f32_e32 %0, 0, %1" : "=v"(r) : "v"(x)); return r; }
__device__ __forceinline__ float fma_v(float a, float b, float c) { float r; asm volatile("v_fma_f32 %0, %1, %2, %3" : "=v"(r) : "v"(a), "v"(b), "v"(c)); return r; }
__device__ __forceinline__ unsigned fkey(float x) { const unsigned u = __float_as_uint(x + 0.0f); return (u & 0x80000000u) ? ~u : (u | 0x80000000u); }
__device__ __forceinline__ unsigned wave_excl_prefix(unsigned x, int lane, unsigned& total) {
    unsigned v = x;
#pragma unroll
    for (int d = 1; d < 64; d <<= 1) { const unsigned y = __shfl_up(v, d); if (lane >= d) v += y; }
    total = (unsigned)__builtin_amdgcn_readlane((int)v, 63); return v - x;
}
template <int NP>
__device__ __forceinline__ void topk16_select(const unsigned short* sc16, int n, unsigned short* out, LAS unsigned* h0, LAS unsigned* hw, LAS unsigned short* cidx, LAS float* csc,
                                              const bf16* qrow, const bf16* KI, const float* wrow, int lane, const unsigned th16) {
    unsigned kp[NP * 4];
    int l8 = 8 * lane;
#pragma unroll
    for (int i = 0; i < NP; ++i) { const v4u v = *(const GAS v4u*)(sc16 + 512 * i + 8 * lane);
        if ((i & 3) == 0) asm volatile("" : "+v"(l8));
        const unsigned m = (512 * i + l8 < n) ? 0xffffffffu : 0u;
        kp[4 * i] = v.x & m; kp[4 * i + 1] = v.y & m; kp[4 * i + 2] = v.z & m; kp[4 * i + 3] = v.w & m; }
    const unsigned ninv = (unsigned)(NP * 512 - n);
    unsigned want = TOPK, T = 0u;
#pragma unroll
    for (int pass = 0; pass < 2; ++pass) {
        LAS unsigned* hist = pass == 0 ? h0 : hw;
        if (pass == 1) {
            *(LAS v4u*)(hw + 4 * lane) = (v4u){0u, 0u, 0u, 0u};
            LDS_WAIT();
#pragma unroll
            for (int i = 0; i < NP * 4; ++i) {
#pragma unroll
                for (int hf = 0; hf < 2; ++hf) { const unsigned k = hf ? kp[i] >> 16 : kp[i] & 0xffffu;
                    if ((k >> 8) == T && k >= th16) __hip_atomic_fetch_add(hw + (k & 255u), 1u, __ATOMIC_RELAXED, __HIP_MEMORY_SCOPE_WORKGROUP); } }
            LDS_WAIT();
        }
        v4u c4;
        if (pass == 0) {
            const v4u a = *(const LAS v4u*)(h0 + 8 * lane), e = *(const LAS v4u*)(h0 + 8 * lane + 4);
            c4.x = ((a.x & 0xffffu) + (a.y & 0xffffu)) + ((a.z & 0xffffu) + (a.w & 0xffffu)); c4.y = ((a.x >> 16) + (a.y >> 16)) + ((a.z >> 16) + (a.w >> 16));
            c4.z = ((e.x & 0xffffu) + (e.y & 0xffffu)) + ((e.z & 0xffffu) + (e.w & 0xffffu)); c4.w = ((e.x >> 16) + (e.y >> 16)) + ((e.z >> 16) + (e.w >> 16));
        } else c4 = *(const LAS v4u*)(hist + 4 * lane);
        const unsigned tl = c4.x + c4.y + c4.z + c4.w; unsigned S = tl;
#pragma unroll
        for (int d = 1; d < 64; d <<= 1) { const unsigned v = __shfl_down(S, d); if (lane + d < 64) S += v; }
        const unsigned long long bal = __ballot(S >= want);
        const int L = 63 - __clzll(bal | 1ull);
        const unsigned above = __shfl(S - tl, L), c1 = __shfl(c4.y, L), c2 = __shfl(c4.z, L), c3 = __shfl(c4.w, L);
        unsigned cum = above; int d;
        if (cum + c3 >= want) d = 3; else { cum += c3; if (cum + c2 >= want) d = 2; else { cum += c2; if (cum + c1 >= want) d = 1; else { cum += c1; d = 0; } } }
        want -= cum; T = pass == 0 ? (unsigned)(4 * L + d) : ((T << 8) | (unsigned)(4 * L + d));
    }
    if (lane == 0) { hw[0] = 0u; hw[1] = 0u; }
    LDS_WAIT();
    int l4 = 8 * lane;
#pragma unroll
    for (int i = 0; i < NP * 4; ++i) { if ((i & 7) == 0) asm volatile("" : "+v"(l4));
#pragma unroll
        for (int hf = 0; hf < 2; ++hf) { const unsigned k = hf ? kp[i] >> 16 : kp[i] & 0xffffu; const int idx = 512 * (i >> 2) + l4 + 2 * (i & 3) + hf;
            if (k >= T) {
                if (k > T) { const unsigned pos = __hip_atomic_fetch_add(hw, 1u, __ATOMIC_RELAXED, __HIP_MEMORY_SCOPE_WORKGROUP); out[pos] = (unsigned short)idx; }
                else { const unsigned cp = __hip_atomic_fetch_add(hw + 1, 1u, __ATOMIC_RELAXED, __HIP_MEMORY_SCOPE_WORKGROUP); if (cp < 512u) cidx[cp] = (unsigned short)idx; } } }
        if ((i & 7) == 7) asm volatile("" ::: "memory"); }
    LDS_WAIT();
    const unsigned nab = (unsigned)__builtin_amdgcn_readfirstlane((int)hw[0]), c = (unsigned)__builtin_amdgcn_readfirstlane((int)hw[1]);
    if (c == want) { for (unsigned jj = lane; jj < c; jj += 64) out[nab + jj] = cidx[jj]; }
    else if (c <= 512u) {
        const int hh = lane >> 2, dq = lane & 3; const float wh = wrow[hh];
        const v4u q0 = *(const GAS v4u*)(qrow + hh * 64 + 16 * dq), q1 = *(const GAS v4u*)(qrow + hh * 64 + 16 * dq + 8);
        for (unsigned jj = 0; jj < c; ++jj) { const int idx = (int)cidx[jj]; const bf16* kr = KI + (size_t)idx * 64 + 16 * dq;
            const v4u k0 = *(const GAS v4u*)kr, k1 = *(const GAS v4u*)(kr + 8);
            float dsum = ((bflo(q0.x) * bflo(k0.x) + bfhi(q0.x) * bfhi(k0.x)) + (bflo(q0.y) * bflo(k0.y) + bfhi(q0.y) * bfhi(k0.y))) + ((bflo(q0.z) * bflo(k0.z) + bfhi(q0.z) * bfhi(k0.z)) + (bflo(q0.w) * bflo(k0.w) + bfhi(q0.w) * bfhi(k0.w)))
                       + ((bflo(q1.x) * bflo(k1.x) + bfhi(q1.x) * bfhi(k1.x)) + (bflo(q1.y) * bflo(k1.y) + bfhi(q1.y) * bfhi(k1.y))) + ((bflo(q1.z) * bflo(k1.z) + bfhi(q1.z) * bfhi(k1.z)) + (bflo(q1.w) * bflo(k1.w) + bfhi(q1.w) * bfhi(k1.w)));
            dsum += dpp_f(dsum, dsum, 0xB1, 0xf); dsum += dpp_f(dsum, dsum, 0x4E, 0xf);
            const float sc = wave_sum(wh * fmaxf(dsum, 0.f)) * 0.25f;
            if (lane == 0) csc[jj] = sc; }
        LDS_WAIT();
        for (unsigned jj = lane; jj < c; jj += 64) { const float sj = csc[jj]; const unsigned ij = cidx[jj]; unsigned r = 0u;
            for (unsigned ii = 0; ii < c; ++ii) { const float si = csc[ii]; const unsigned ix = cidx[ii]; r += (si > sj || (si == sj && ix < ij)) ? 1u : 0u; }
            if (r < want) out[nab + r] = (unsigned short)ij; }
    } else {
        unsigned run = 0u; int l5 = 8 * lane;
#pragma unroll
        for (int i = 0; i < NP; ++i) { if ((i & 1) == 0) asm volatile("" : "+v"(l5));
            unsigned fl = 0u;
#pragma unroll
            for (int e = 0; e < 8; ++e) { const unsigned k = (e & 1) ? kp[4 * i + (e >> 1)] >> 16 : kp[4 * i + (e >> 1)] & 0xffffu; fl |= (k == T ? 1u : 0u) << e; }
            unsigned tot; unsigned base = run + wave_excl_prefix((unsigned)__popc(fl), lane, tot);
#pragma unroll
            for (int e = 0; e < 8; ++e) if ((fl >> e) & 1u) { if (base < want) out[nab + base] = (unsigned short)(512 * i + l5 + e); ++base; }
            run += tot; }
    }
    LDS_WAIT();
}
__device__ __forceinline__ void dsa_index(Frame& F) {
    PHASE_IDS();
    const int w = wave, b = F.vcu >> 5, iw = F.vcu & 31, r32 = lane & 31, hi = lane >> 5;
    const bf16* QI = WSP(bf16, S_QI) + (size_t)b * SEQ * 1024; const bf16* KI = WSP(bf16, S_KIDX) + (size_t)b * SEQ * 64; const float* WI = WSP(float, S_WIDX) + (size_t)b * SEQ * 16;
    unsigned short* IDX = WSP(unsigned short, S_IDX) + (size_t)b * SEQ * TOPK;
    unsigned short* sc = WSP(unsigned short, S_SC) + (size_t)F.vcu * 32 * SEQ;
    LAS unsigned* h4 = (LAS unsigned*)(F.lds + RING_OFF + w * 10240);
    LAS float* csc = (LAS float*)(h4 + 2048);
    LAS unsigned char* kb = F.lds + RING_OFF + 81920;
    for (int ui = 0; ui < 4; ++ui) {
        const int c = ui == 0 ? 127 - iw : (ui == 1 ? 64 + iw : (ui == 2 ? 63 - iw : iw));
        if (c < 4) continue;
        const int n = (c + 1) * 64, ntile = n / 32, nblk = (n + 255) >> 8;
        for (int sub = 0; sub < 2; ++sub) { const int qbase = c * 64 + sub * 32 + 4 * w;
            bf16x8 af[2][4]; float wv[2][16];
#pragma unroll
            for (int tt = 0; tt < 2; ++tt) { const int q = qbase + 2 * tt + ((r32 >> 2) & 1), head = (r32 & 3) + 4 * (r32 >> 3);
#pragma unroll
                for (int ks = 0; ks < 4; ++ks) af[tt][ks] = *(const GAS bf16x8*)(QI + (size_t)q * 1024 + head * 64 + 16 * ks + 8 * hi);
                const float* wp = WI + (size_t)(qbase + 2 * tt + hi) * 16;
#pragma unroll
                for (int j = 0; j < 4; ++j) { const f32x4 v = *(const GAS f32x4*)(wp + 4 * j); wv[tt][4 * j] = v[0]; wv[tt][4 * j + 1] = v[1]; wv[tt][4 * j + 2] = v[2]; wv[tt][4 * j + 3] = v[3]; } }
            unsigned short* scw = sc + (size_t)(4 * w) * SEQ;
            LAS unsigned* hq = h4 + hi * 512 + (lane & 3);
            for (int rp_ = 0; rp_ < P0REP(26); ++rp_) {
#pragma unroll
            for (int j = 0; j < 8; ++j) *(LAS v4u*)(h4 + 256 * j + 4 * lane) = (v4u){0u, 0u, 0u, 0u};
            LDS_WAIT();
#define IDX_DMA(j_) do { _Pragma("unroll") for (int p_ = 0; p_ < 4; ++p_) { const int kn_ = 256 * (j_) + 8 * (4 * w + p_) + (lane >> 3), kr_ = kn_ < n ? kn_ : n - 1, ch_ = (lane & 7) ^ (kn_ & 7); \
                __builtin_amdgcn_global_load_lds((const unsigned*)(KI + (size_t)kr_ * 64 + ch_ * 8), (LAS unsigned*)(kb + ((j_) & 1) * 32768 + (4 * w + p_) * 1024), 16, 0, 0); } } while (0)
#define IDX_LDF(ks_, t_) KF.f[ks_] = *(const LAS bf16x8*)(kb + (((t_) >> 3) & 1) * 32768 + (32 * ((t_) & 7) + r32) * 128 + (((2 * (ks_) + hi) ^ (r32 & 7)) << 4))
#define MF0(acc, a, b) asm volatile("v_mfma_f32_32x32x16_bf16 %0, %1, %2, 0" : "=&v"(acc) : "v"(a), "v"(b))
#define MFA(acc, a, b) asm volatile("v_mfma_f32_32x32x16_bf16 %0, %1, %2, %0" : "+v"(acc) : "v"(a), "v"(b))
#define VAL4(C, W, sa, sb, r) do { sa = fma_v(W[r], relu_v(C[r]), sa); sb = fma_v(W[(r) + 1], relu_v(C[(r) + 1]), sb); sa = fma_v(W[(r) + 2], relu_v(C[(r) + 2]), sa); sb = fma_v(W[(r) + 3], relu_v(C[(r) + 3]), sb); } while (0)
            IDX_DMA(0);
            if (nblk > 1) { IDX_DMA(1); asm volatile("s_waitcnt vmcnt(4)" ::: "memory"); } else asm volatile("s_waitcnt vmcnt(0)" ::: "memory");
            __builtin_amdgcn_s_barrier(); asm volatile("" ::: "memory");
            bfrx KF; f32x16 A0a, A0b, A1a, A1b;
#pragma unroll
            for (int ks = 0; ks < 4; ++ks) IDX_LDF(ks, 0);
            MF0(A0a, af[0][0], KF.f[0]); MF0(A0b, af[1][0], KF.f[0]); IDX_LDF(0, 1);
            MFA(A0a, af[0][1], KF.f[1]); MFA(A0b, af[1][1], KF.f[1]); IDX_LDF(1, 1);
            MFA(A0a, af[0][2], KF.f[2]); MFA(A0b, af[1][2], KF.f[2]); IDX_LDF(2, 1);
            MFA(A0a, af[0][3], KF.f[3]); MFA(A0b, af[1][3], KF.f[3]); IDX_LDF(3, 1);
#define IDX_STEP(t_, j_, Ca, Cb, Na, Nb) do { const int tq_ = (t_), t2_ = tq_ + 2 < ntile ? tq_ + 2 : tq_ + 1; \
                if (tq_ + 2 < ntile && ((tq_ + 2) & 7) == 0) { const int jn_ = (tq_ + 2) >> 3; asm volatile("s_waitcnt vmcnt(8) lgkmcnt(0)" ::: "memory"); __builtin_amdgcn_s_barrier(); asm volatile("" ::: "memory"); if (jn_ + 1 < nblk) IDX_DMA(jn_ + 1); } \
                float s0a = 0.f, s0b = 0.f, s1a = 0.f, s1b = 0.f; \
                if (tq_ + 1 < ntile) { \
                    MF0(Na, af[0][0], KF.f[0]); VAL4(Ca, wv[0], s0a, s0b, 0); MF0(Nb, af[1][0], KF.f[0]); IDX_LDF(0, t2_); VAL4(Cb, wv[1], s1a, s1b, 0); \
                    MFA(Na, af[0][1], KF.f[1]); VAL4(Ca, wv[0], s0a, s0b, 4); MFA(Nb, af[1][1], KF.f[1]); IDX_LDF(1, t2_); VAL4(Cb, wv[1], s1a, s1b, 4); \
                    MFA(Na, af[0][2], KF.f[2]); VAL4(Ca, wv[0], s0a, s0b, 8); MFA(Nb, af[1][2], KF.f[2]); IDX_LDF(2, t2_); VAL4(Cb, wv[1], s1a, s1b, 8); \
                    MFA(Na, af[0][3], KF.f[3]); VAL4(Ca, wv[0], s0a, s0b, 12); MFA(Nb, af[1][3], KF.f[3]); IDX_LDF(3, t2_); VAL4(Cb, wv[1], s1a, s1b, 12); \
                } else { VAL4(Ca, wv[0], s0a, s0b, 0); VAL4(Cb, wv[1], s1a, s1b, 0); VAL4(Ca, wv[0], s0a, s0b, 4); VAL4(Cb, wv[1], s1a, s1b, 4); VAL4(Ca, wv[0], s0a, s0b, 8); VAL4(Cb, wv[1], s1a, s1b, 8); VAL4(Ca, wv[0], s0a, s0b, 12); VAL4(Cb, wv[1], s1a, s1b, 12); } \
                const float s0 = s0a + s0b, s1 = s1a + s1b; const unsigned k0 = fkey(s0), k1 = fkey(s1); \
                scw[(size_t)hi * SEQ + 32 * tq_ + r32] = (unsigned short)(k0 >> 16); scw[(size_t)(2 + hi) * SEQ + 32 * tq_ + r32] = (unsigned short)(k1 >> 16); \
                RM[j_] = pk_max_u16(RM[j_], (k1 & 0xffff0000u) | (k0 >> 16)); \
                if (k0 >= (th << 16)) lds_add(hq + ((k0 >> 25) << 2), (k0 & 0x1000000u) ? 65536u : 1u);     \
                if (k1 >= (th & 0xffff0000u)) lds_add(hq + 1024 + ((k1 >> 25) << 2), (k1 & 0x1000000u) ? 65536u : 1u); \
            } while (0)
            unsigned RM[8], th = 0u;
#pragma unroll
            for (int j = 0; j < 8; ++j) RM[j] = 0u;
#define IDX_TH() do { th = half_min_pk(pk_min_u16(pk_min_u16(pk_min_u16(RM[0], RM[1]), pk_min_u16(RM[2], RM[3])), pk_min_u16(pk_min_u16(RM[4], RM[5]), pk_min_u16(RM[6], RM[7])))); } while (0)
            for (int t = 0; t < ntile; t += 8) {
                IDX_STEP(t, 0, A0a, A0b, A1a, A1b); IDX_STEP(t + 1, 1, A1a, A1b, A0a, A0b); if (t + 2 >= ntile) break;
                IDX_STEP(t + 2, 2, A0a, A0b, A1a, A1b); IDX_STEP(t + 3, 3, A1a, A1b, A0a, A0b); if (t + 4 >= ntile) break;
                IDX_STEP(t + 4, 4, A0a, A0b, A1a, A1b); IDX_STEP(t + 5, 5, A1a, A1b, A0a, A0b); if (t + 6 >= ntile) break;
                IDX_STEP(t + 6, 6, A0a, A0b, A1a, A1b); IDX_STEP(t + 7, 7, A1a, A1b, A0a, A0b);
                IDX_TH();
            }
            IDX_TH();
            if (r32 == 0) { F.MISC[16 + 4 * w + hi] = th & 0xffffu; F.MISC[16 + 4 * w + 2 + hi] = th >> 16; }
#undef IDX_TH
            asm volatile("s_waitcnt lgkmcnt(0)" ::: "memory"); __builtin_amdgcn_s_barrier(); asm volatile("" ::: "memory");
#undef IDX_STEP
#undef VAL4
#undef MFA
#undef MF0
#undef IDX_LDF
#undef IDX_DMA
            LDS_WAIT(); }
            VM_WAIT(); __builtin_amdgcn_fence(__ATOMIC_ACQUIRE, "agent"); VM_WAIT(); LDS_WAIT();
            for (int rp_ = 0; rp_ < P0REP(27); ++rp_)
            for (int qq = 0; qq < 4; ++qq) { const unsigned short* row = scw + (size_t)qq * SEQ; unsigned short* o = IDX + (size_t)(qbase + qq) * TOPK; LAS unsigned* h0 = h4 + 512 * qq; LAS unsigned* hw = h0; LAS unsigned short* cidx = (LAS unsigned short*)(h0 + 256);
                unsigned th16 = F.MISC[16 + 4 * w + qq]; th16 = th16 > 1u ? th16 : 1u;
                const bf16* qrow = QI + (size_t)(qbase + qq) * 1024; const float* wrow = WI + (size_t)(qbase + qq) * 16;
                if (n <= 2048) topk16_select<4>(row, n, o, h0, hw, cidx, csc, qrow, KI, wrow, lane, th16); else if (n <= 4096) topk16_select<8>(row, n, o, h0, hw, cidx, csc, qrow, KI, wrow, lane, th16);
                else if (n <= 6144) topk16_select<12>(row, n, o, h0, hw, cidx, csc, qrow, KI, wrow, lane, th16); else topk16_select<16>(row, n, o, h0, hw, cidx, csc, qrow, KI, wrow, lane, th16); }
        }
    }
}

__device__ __forceinline__ s16x4 tr16(LAS const unsigned char* p) { typedef short v4i16_t __attribute__((ext_vector_type(4))); return __builtin_bit_cast(s16x4, __builtin_amdgcn_ds_read_tr16_b64_v4i16((LAS v4i16_t*)p)); }
__device__ __forceinline__ void sparse_attn(Frame& F) {
    PHASE_IDS();
    const int w = wave, b = F.vcu >> 5, wb = (F.vcu & 31) * 8 + w, n16 = lane & 15, g = lane >> 4;
    constexpr int RS = 592;
    LAS unsigned char* tile = F.lds + RING_OFF + w * 19456;
    const bf16* QF = WSP(bf16, S_QF); const unsigned char* KV = (const unsigned char*)(WSP(bf16, S_KVL) + (size_t)b * SEQ * KVW);
    const unsigned short* IDX = WSP(unsigned short, S_IDX); bf16* OL = WSP(bf16, S_OL);
    const int trq = (n16 >> 2), trp = n16 & 3;
    for (int i = 0; i < 32; ++i) {
        const int s = wb + 256 * i; const size_t t = (size_t)b * SEQ + s;
        const int nv = ((s >> 6) + 1) * 64 < TOPK ? ((s >> 6) + 1) * 64 : TOPK, ntile = nv >> 5;
        bf16x8 qb[9]; { int qo = (n16 & 7) * KVW + 8 * g; asm volatile("" : "+v"(qo)); const bf16* qp = QF + t * (8 * KVW) + qo;
#pragma unroll
            for (int ks = 0; ks < 9; ++ks) qb[ks] = *(const GAS bf16x8*)(qp + 32 * ks); }
        float mrun = -INFINITY, lrun = 0.f;
        f32x4 o[16];
#pragma unroll
        for (int dt = 0; dt < 16; ++dt) o[dt] = (f32x4){0.f, 0.f, 0.f, 0.f};
        int koff[19];
        { const int mi = (int)IDX[t * TOPK + (lane & 31)];
#pragma unroll
          for (int j = 0; j < 19; ++j) { const int L = j * 1024 + lane * 16, row = L / RS; koff[j] = __shfl(mi, row & 31) * (KVW * 2); } }
        for (int tl = 0; tl < ntile; ++tl) {
#pragma unroll
            for (int j = 0; j < 19; ++j) { const int L = j * 1024 + lane * 16, row = L / RS, col = L - row * RS;
                const unsigned char* src = (col < KVW * 2 && row < 32) ? KV + (size_t)(unsigned)koff[j] + col : KV;
                __builtin_amdgcn_global_load_lds((const unsigned*)src, (LAS unsigned*)(tile + j * 1024), 16, 0, 0); }
            const int mi_n = (int)IDX[t * TOPK + 32 * (tl + 1 < ntile ? tl + 1 : tl) + (lane & 31)];
            asm volatile("s_waitcnt vmcnt(0)" ::: "memory");
            LDS_WAIT();
            f32x4 s0 = (f32x4){0.f, 0.f, 0.f, 0.f}, s1 = s0;
#pragma unroll
            for (int ks = 0; ks < 9; ++ks) { const bf16x8 a0 = *(const LAS bf16x8*)(tile + n16 * RS + (32 * ks + 8 * g) * 2), a1 = *(const LAS bf16x8*)(tile + (16 + n16) * RS + (32 * ks + 8 * g) * 2);
                s0 = __builtin_amdgcn_mfma_f32_16x16x32_bf16(a0, qb[ks], s0, 0, 0, 0); s1 = __builtin_amdgcn_mfma_f32_16x16x32_bf16(a1, qb[ks], s1, 0, 0, 0); }
            float mx = fmaxf(fmaxf(fmaxf(s0[0], s0[1]), fmaxf(s0[2], s0[3])), fmaxf(fmaxf(s1[0], s1[1]), fmaxf(s1[2], s1[3])));
            { auto r16 = __builtin_amdgcn_permlane16_swap(__float_as_uint(mx), __float_as_uint(mx), false, false); mx = fmaxf(__uint_as_float(r16[0]), __uint_as_float(r16[1]));
              auto r32 = __builtin_amdgcn_permlane32_swap(__float_as_uint(mx), __float_as_uint(mx), false, false); mx = fmaxf(__uint_as_float(r32[0]), __uint_as_float(r32[1])); }
            const bool resc = __ballot(mx > mrun + 8.0f) != 0ull;
            const float mnew = resc ? fmaxf(mrun, mx) : mrun, alpha = resc ? __builtin_amdgcn_exp2f(mrun - mnew) : 1.0f;
            float p0[4], p1[4], ps = 0.f;
#pragma unroll
            for (int r = 0; r < 4; ++r) { p0[r] = __builtin_amdgcn_exp2f(s0[r] - mnew); p1[r] = __builtin_amdgcn_exp2f(s1[r] - mnew); ps += p0[r] + p1[r]; }
            lrun = lrun * alpha + ps; mrun = mnew;
            v4u pw; pw.x = pg8::cvt_pk_bf16(p0[0], p0[1]); pw.y = pg8::cvt_pk_bf16(p0[2], p0[3]); pw.z = pg8::cvt_pk_bf16(p1[0], p1[1]); pw.w = pg8::cvt_pk_bf16(p1[2], p1[3]);
            const bf16x8 pa = __builtin_bit_cast(bf16x8, pw);
            if (resc) { float ar[4];
#pragma unroll
                for (int r = 0; r < 4; ++r) ar[r] = __shfl(alpha, 4 * g + r);
#pragma unroll
                for (int dt = 0; dt < 16; ++dt)
#pragma unroll
                    for (int r = 0; r < 4; ++r) o[dt][r] *= ar[r]; }
#pragma unroll
            for (int j = 0; j < 19; ++j) { const int L = j * 1024 + lane * 16, row = L / RS; koff[j] = __shfl(mi_n, row & 31) * (KVW * 2); }
#pragma unroll
            for (int dt = 0; dt < 16; ++dt) {
                const s16x4 lo = tr16(tile + (4 * g + trq) * RS + (16 * dt + 4 * trp) * 2), hi4 = tr16(tile + (16 + 4 * g + trq) * RS + (16 * dt + 4 * trp) * 2);
                const bf16x8 vb = (bf16x8){lo[0], lo[1], lo[2], lo[3], hi4[0], hi4[1], hi4[2], hi4[3]};
                o[dt] = __builtin_amdgcn_mfma_f32_16x16x32_bf16(pa, vb, o[dt], 0, 0, 0); }
            LDS_WAIT();
        }
        lrun += __shfl_xor(lrun, 16); lrun += __shfl_xor(lrun, 32);
        const float linv = 1.0f / lrun; float li[4];
#pragma unroll
        for (int r = 0; r < 4; ++r) li[r] = __shfl(linv, 4 * g + r);
        if (g < 2) {
#pragma unroll
            for (int dt = 0; dt < 16; ++dt)
#pragma unroll
                for (int r = 0; r < 4; ++r) ((LAS bf16*)tile)[(4 * g + r) * 256 + 16 * dt + n16] = (bf16)f2bf(o[dt][r] * li[r]); }
        LDS_WAIT();
#pragma unroll
        for (int j = 0; j < 4; ++j) { const int c = lane + 64 * j; *(GAS v4u*)(OL + t * 2048 + c * 8) = *(const LAS v4u*)(tile + c * 16); }
        LDS_WAIT();
    }
}
#if !MK_DBG
#define DBG_AFTER_PHASE(p) do { } while (0)
#else
#define DBGK 256
__device__ __forceinline__ unsigned hsh(unsigned x) { x ^= x >> 16; x *= 0x7feb352du; x ^= x >> 15; x *= 0x846ca68bu; x ^= x >> 16; return x; }
__device__ __forceinline__ void err_max(unsigned char* ws, int id, float v) { if (!(v >= 0.f)) v = 1e30f; atomicMax((unsigned*)(ws + WS_CTL) + CW_ERR + id, __float_as_uint(v)); }
__device__ __forceinline__ float block_sum(float v, float* sh) { const int t = threadIdx.x; sh[t] = v; __syncthreads(); for (int o = DBGK / 2; o > 0; o >>= 1) { if (t < o) sh[t] += sh[t + o]; __syncthreads(); } const float r = sh[0]; __syncthreads(); return r; }
__device__ __forceinline__ float block_max(float v, float* sh) { const int t = threadIdx.x; sh[t] = v; __syncthreads(); for (int o = DBGK / 2; o > 0; o >>= 1) { if (t < o) sh[t] = fmaxf(sh[t], sh[t + o]); __syncthreads(); } const float r = sh[0]; __syncthreads(); return r; }
__device__ __forceinline__ void rope_cs(const int* pos, int t, int jj  , float& c, float& s) { const double a = (double)pos[t] * pow(500000.0, -(double)jj / 16.0); c = (float)cos(a); s = (float)sin(a); }
__device__ __forceinline__ void ln_row(const float* row, const float* g, const float* b, float* sh_h, float* sh) {
    const int t = threadIdx.x; float v[4], s = 0.f; for (int j = 0; j < 4; ++j) { v[j] = row[t + 256 * j]; s += v[j]; }
    const float mean = block_sum(s, sh) * (1.f / 1024.f); float q = 0.f; for (int j = 0; j < 4; ++j) { v[j] -= mean; q += v[j] * v[j]; }
    const float rstd = 1.f / sqrtf(block_sum(q, sh) * (1.f / 1024.f) + LN_EPS);
    for (int j = 0; j < 4; ++j) sh_h[t + 256 * j] = v[j] * rstd * g[t + 256 * j] + b[t + 256 * j];
    __syncthreads();
}
struct DArgs { const float* in[N_IN]; float* out; unsigned char* ws; int layer, pad; };
#define DWS(T_, off) ((T_*)(a.ws + (off)))
__global__ void __launch_bounds__(DBGK) chk_topk(DArgs a) {
    __shared__ float sc[SEQ]; __shared__ unsigned char sel[SEQ]; __shared__ float sh[DBGK]; __shared__ int cnt;
    const int smp = blockIdx.x, t = threadIdx.x, b = smp & 7; const int s = 256 + (hsh(smp * 7 + 1) % (SEQ - 256)), n = ((s >> 6) + 1) * 64; const size_t tok = (size_t)b * SEQ + s;
    const bf16* QI = DWS(bf16, S_QI) + tok * 1024; const bf16* KI = DWS(bf16, S_KIDX) + (size_t)b * SEQ * 64; const float* WI = DWS(float, S_WIDX) + tok * 16;
    for (int k = t; k < n; k += DBGK) { float acc = 0.f; for (int h = 0; h < 16; ++h) { float l = 0.f; for (int d = 0; d < 64; ++d) l += bf2f(QI[h * 64 + d]) * bf2f(KI[(size_t)k * 64 + d]); acc += WI[h] * fmaxf(l, 0.f); } sc[k] = acc; sel[k] = 0; }
    if (t == 0) cnt = 0; __syncthreads();
    const unsigned short* idx = DWS(unsigned short, S_IDX) + tok * TOPK;
    { const int k = idx[t]; bool ok = k < n; if (ok) { sel[k] = 1; } else atomicAdd(&cnt, 1000); }
    __syncthreads();
    int c = 0; float mn = 1e30f, mxu = -1e30f, lo = 1e30f, hi = -1e30f; for (int k = t; k < n; k += DBGK) { c += sel[k]; if (sel[k]) mn = fminf(mn, sc[k]); else mxu = fmaxf(mxu, sc[k]); lo = fminf(lo, sc[k]); hi = fmaxf(hi, sc[k]); }
    const float nsel = block_sum((float)c, sh), smin = -block_max(-mn, sh), umax = block_max(mxu, sh), rlo = -block_max(-lo, sh), rhi = block_max(hi, sh);
    if (t == 0) { float e = fmaxf(0.f, umax - smin) / (rhi - rlo + 1e-20f); if (nsel != 256.f || cnt != 0) e = 1e3f; err_max(a.ws, 1, e); }
}
__global__ void __launch_bounds__(DBGK) chk_sparse(DArgs a) {
    __shared__ float p[256]; __shared__ float sh[DBGK];
    const int smp = blockIdx.x, t = threadIdx.x, b = smp & 7; const int s = (smp < 16) ? (smp * 13) % 256 : hsh(smp * 11 + 3) % SEQ; const size_t tok = (size_t)b * SEQ + s;
    const int nv = ((s >> 6) + 1) * 64 < TOPK ? ((s >> 6) + 1) * 64 : TOPK;
    const bf16* QF = DWS(bf16, S_QF) + tok * 8 * KVW; const bf16* KV = DWS(bf16, S_KVL) + (size_t)b * SEQ * KVW; const unsigned short* idx = DWS(unsigned short, S_IDX) + tok * TOPK; const bf16* OL = DWS(bf16, S_OL) + tok * 2048;
    float emax = 0.f, omax = 0.f;
    for (int h = 0; h < 8; ++h) { float sc = -INFINITY; if (t < nv) { sc = 0.f; const bf16* kr = KV + (size_t)idx[t] * KVW; for (int d = 0; d < KVW; ++d) sc += bf2f(QF[h * KVW + d]) * bf2f(kr[d]); }
        const float m = block_max(sc, sh); const float e = t < nv ? exp2f(sc - m) : 0.f; const float l = block_sum(e, sh); p[t] = e / l; __syncthreads();
        float o = 0.f; for (int k = 0; k < nv; ++k) o += p[k] * bf2f(KV[(size_t)idx[k] * KVW + t]);
        emax = fmaxf(emax, fabsf(o - bf2f(OL[h * 256 + t]))); omax = fmaxf(omax, fabsf(o)); __syncthreads(); }
    const float e = block_max(emax, sh), o = block_max(omax, sh); if (t == 0) err_max(a.ws, 2, e / (o + 1e-20f));
}
__global__ void __launch_bounds__(DBGK) chk_x1p(DArgs a) {
    __shared__ float hrow[1024]; __shared__ float q[1024]; __shared__ float sh[DBGK];
    const int smp = blockIdx.x, t = threadIdx.x, L = a.layer; const size_t tok = hsh(smp * 5 + 9 + L) % T; const int b = (int)(tok / SEQ);
    ln_row(a.out + tok * 1024, a.in[I_LNG] + (L * 3) * 1024, a.in[I_LNB] + (L * 3) * 1024, hrow, sh);
    const float* W = a.in[I_XAWQ] + (size_t)L * 1048576;
    for (int j = 0; j < 4; ++j) { const int c = t + 256 * j; float o = 0.f; for (int k = 0; k < 1024; ++k) o += hrow[k] * W[(size_t)k * 1024 + c]; q[c] = o * XQS; }
    __syncthreads();
    const bf16* MK = DWS(bf16, WS_MK) + (size_t)b * 256 * 1024; const bf16* P = DWS(bf16, S_P) + tok * 1024; float emax = 0.f;
    for (int h = 0; h < 4; ++h) { float sc = 0.f; for (int d = 0; d < 256; ++d) sc += q[h * 256 + d] * bf2f(MK[(size_t)t * 1024 + h * 256 + d]);
        const float m = block_max(sc, sh); const float e = exp2f(sc - m); const float l = block_sum(e, sh); emax = fmaxf(emax, fabsf(e / l - bf2f(P[h * 256 + t]))); }
    const float e = block_max(emax, sh); if (t == 0) err_max(a.ws, 4, e * 16.f);
}
__global__ void __launch_bounds__(DBGK) chk_x4p(DArgs a, int salt) {
    __shared__ float hrow[1024]; __shared__ float ov[1024]; __shared__ float sh[DBGK];
    const int t = threadIdx.x, L = a.layer; const size_t tok = hsh(blockIdx.x * 29 + salt) % T; const int b = (int)(tok / SEQ); const float* snap = DWS(float, WS_SMALL) + 65536 + (size_t)blockIdx.x * 1024;
    ln_row(snap, a.in[I_LNG] + (L * 3) * 1024, a.in[I_LNB] + (L * 3) * 1024, hrow, sh);
    const bf16* P = DWS(bf16, S_P) + tok * 1024; const bf16* MV = DWS(bf16, WS_MVT) + (size_t)b * 256 * 1024;
    for (int j = 0; j < 4; ++j) { const int c = t + 256 * j, h = c >> 8; float o = 0.f; for (int m = 0; m < 256; ++m) o += bf2f(P[h * 256 + m]) * bf2f(MV[(size_t)m * 1024 + c]); ov[c] = o; }
    __syncthreads();
    const float* W = a.in[I_XAWOUT] + (size_t)L * 1048576; float emax = 0.f, omax = 0.f;
    for (int j = 0; j < 4; ++j) { const int c = t + 256 * j; float o = 0.f; for (int k = 0; k < 1024; ++k) o += ov[k] * W[(size_t)k * 1024 + c]; emax = fmaxf(emax, fabsf(ALPHA * hrow[c] + o - a.out[tok * 1024 + c])); omax = fmaxf(omax, fabsf(o)); }
    const float e = block_max(emax, sh), o = block_max(omax, sh); if (t == 0) err_max(a.ws, 3, e / (o + 1e-20f));
}
__global__ void __launch_bounds__(DBGK) chk_fold(DArgs a, int which  ) {
    __shared__ float hrow[1024]; __shared__ float sh[DBGK];
    const int smp = blockIdx.x, t = threadIdx.x; const size_t tok = hsh(smp * 3 + 17 + which + a.layer) % T;
    const int ln = which == 0 ? a.layer * 3 + 0 : 2;
    ln_row(a.out + tok * 1024, a.in[I_LNG] + ln * 1024, a.in[I_LNB] + ln * 1024, hrow, sh);
    float emax = 0.f, omax = 0.f;
    if (which == 0) { const float* W = a.in[I_XAWQ] + (size_t)a.layer * 1048576; const bf16* QX = DWS(bf16, S_QX) + tok * 1024;
        for (int j = 0; j < 4; ++j) { const int c = t + 256 * j; float o = 0.f; for (int k = 0; k < 1024; ++k) o += hrow[k] * W[(size_t)k * 1024 + c]; o *= XQS; emax = fmaxf(emax, fabsf(o - bf2f(QX[c]))); omax = fmaxf(omax, fabsf(o)); } }
    else { const float* W = a.in[I_BWIN]; const float* BIN = DWS(float, S_BIN) + tok * BIN_LD;
        for (int c = t; c < BIN_W; c += DBGK) { float o = 0.f; for (int k = 0; k < 1024; ++k) o += hrow[k] * W[(size_t)k * BIN_W + c]; emax = fmaxf(emax, fabsf(o - BIN[c])); omax = fmaxf(omax, fabsf(o)); } }
    const float e = block_max(emax, sh), o = block_max(omax, sh); if (t == 0) err_max(a.ws, 4 + which, e / (o + 1e-20f));
}
__global__ void __launch_bounds__(DBGK) chk_moe(DArgs a) {
    __shared__ float hrow[1024]; __shared__ float hid[512]; __shared__ float sh[DBGK]; __shared__ float lg[20]; __shared__ int se[2]; __shared__ float sw[2];
    const int smp = blockIdx.x, t = threadIdx.x, L = a.layer; const size_t tok = hsh(smp * 13 + 5 + L) % T;
    ln_row(a.out + tok * 1024, a.in[I_LNG] + (L * 3 + 1) * 1024, a.in[I_LNB] + (L * 3 + 1) * 1024, hrow, sh);
    for (int o = 0; o < 20; ++o) { float p = 0.f; for (int j = 0; j < 4; ++j) { const int k = t + 256 * j; p += hrow[k] * (o < 4 ? a.in[I_MWG][(size_t)L * 4096 + k * 4 + o] : a.in[I_MWE][(size_t)L * 16384 + k * 16 + (o - 4)]); }
        const float v = block_sum(p, sh); if (t == 0) lg[o] = v + (o < 4 ? a.in[I_MBG][L * 4 + o] : a.in[I_MBE][L * 16 + o - 4]); }
    __syncthreads();
    if (t == 0) { int gs = 0; for (int i = 1; i < 4; ++i) if (lg[i] > lg[gs]) gs = i; float den = 0.f; for (int i = 0; i < 4; ++i) den += expf(lg[i] - lg[gs]); const float gate = 1.f / den;
        const float* e = lg + 4 + gs * 4; int i1 = 0; for (int i = 1; i < 4; ++i) if (e[i] > e[i1]) i1 = i; int i2 = -1; for (int i = 0; i < 4; ++i) if (i != i1 && (i2 < 0 || e[i] > e[i2])) i2 = i;
        const float m = e[i1], z = expf(e[i1] - m) + expf(e[i2] - m); se[0] = gs * 4 + i1; se[1] = gs * 4 + i2; sw[0] = expf(e[i1] - m) / z * gate; sw[1] = expf(e[i2] - m) / z * gate; }
    __syncthreads();
    const int* route = DWS(int, WS_ROUTE) + tok * 4; const float* rw = DWS(float, WS_ROUTEW) + tok * 2; const int* pos2 = DWS(int, WS_POS2) + tok * 2;
    float emax = 0.f, omax = 0.f; float rerr = 0.f;
    if (route[0] != se[0] || route[1] != se[1]) rerr = 1e3f; rerr = fmaxf(rerr, fabsf(rw[0] - sw[0]) / sw[0]); rerr = fmaxf(rerr, fabsf(rw[1] - sw[1]) / sw[1]);
    if (DWS(int, WS_ROWIDX)[pos2[0]] != (int)tok || DWS(int, WS_ROWIDX)[pos2[1]] != (int)tok) rerr = 2e3f;
    for (int j = 0; j < 2; ++j) { const int e = se[j]; const float* Wg = a.in[I_MWGATE] + ((size_t)L * 16 + e) * 524288; const float* Wu = a.in[I_MWUP] + ((size_t)L * 16 + e) * 524288; const float* Wd = a.in[I_MWDOWN] + ((size_t)L * 16 + e) * 524288;
        for (int f = t; f < 512; f += DBGK) { float g = 0.f, u = 0.f; for (int k = 0; k < 1024; ++k) { g += hrow[k] * Wg[(size_t)k * 512 + f]; u += hrow[k] * Wu[(size_t)k * 512 + f]; } hid[f] = g / (1.f + expf(-g)) * u; }
        __syncthreads();
        const bf16* Y = DWS(bf16, S_Y) + (size_t)pos2[j] * 1024;
        for (int jj = 0; jj < 4; ++jj) { const int c = t + 256 * jj; float o = 0.f; for (int f = 0; f < 512; ++f) o += hid[f] * Wd[(size_t)f * 1024 + c]; o *= sw[j]; emax = fmaxf(emax, fabsf(o - bf2f(Y[c]))); omax = fmaxf(omax, fabsf(o)); }
        __syncthreads(); }
    const float e = block_max(emax, sh), o = block_max(omax, sh); if (t == 0) { err_max(a.ws, 6, e / (o + 1e-20f)); err_max(a.ws, 7, rerr); }
}
__global__ void __launch_bounds__(DBGK) chk_q2(DArgs a) {
    __shared__ float cq[256]; __shared__ float q[1024]; __shared__ float sh[DBGK];
    const int smp = blockIdx.x, t = threadIdx.x; const size_t tok = hsh(smp * 19 + 2) % T; const int* pos = (const int*)a.in[I_POS];
    cq[t] = bf2f(DWS(bf16, S_CQ)[tok * 256 + t]); __syncthreads();
    for (int j = 0; j < 4; ++j) { const int c = t + 256 * j; float o = 0.f; for (int k = 0; k < 256; ++k) o += cq[k] * a.in[I_BWUQ][(size_t)k * 1024 + c]; q[c] = o; }
    __syncthreads();
    float emax = 0.f, omax = 0.f; const bf16* QF = DWS(bf16, S_QF) + tok * 8 * KVW;
    for (int h = 0; h < 8; ++h) { float o = 0.f; for (int n = 0; n < 96; ++n) o += q[h * 128 + 32 + n] * a.in[I_BWUK][((size_t)h * 256 + t) * 96 + n]; o *= SC2;
        emax = fmaxf(emax, fabsf(o - bf2f(QF[h * KVW + t]))); omax = fmaxf(omax, fabsf(o));
        if (t < 32) { const int j = t & 15; float c, s; rope_cs(pos, (int)tok, j, c, s); const float x1 = q[h * 128 + j], x2 = q[h * 128 + 16 + j]; const float r = (t < 16 ? x1 * c - x2 * s : x2 * c + x1 * s) * SC2;
            emax = fmaxf(emax, fabsf(r - bf2f(QF[h * KVW + 256 + t]))); omax = fmaxf(omax, fabsf(r)); } }
    const float e = block_max(emax, sh), o = block_max(omax, sh); if (t == 0) err_max(a.ws, 8, e / (o + 1e-20f));
    __syncthreads();
    if (tok >= T / 4 + 64) { float e2 = 0.f, o2 = 0.f; const bf16* QI = DWS(bf16, S_QI) + tok * 1024;
        for (int j = 0; j < 4; ++j) { const int c = t + 256 * j; float o = 0.f; for (int k = 0; k < 256; ++k) o += cq[k] * a.in[I_BWQIDX][(size_t)k * 1024 + c]; q[c] = o; }
        __syncthreads();
        for (int j = 0; j < 4; ++j) { const int c = t + 256 * j, d = c & 63; float r = q[c]; if (d < 16) { float cs, sn; rope_cs(pos, (int)tok, 2 * (d & 7), cs, sn); r = d < 8 ? q[c] * cs - q[c + 8] * sn : q[c] * cs + q[c - 8] * sn; }
            e2 = fmaxf(e2, fabsf(r - bf2f(QI[c]))); o2 = fmaxf(o2, fabsf(r)); }
        const float ee = block_max(e2, sh), oo = block_max(o2, sh); if (t == 0) err_max(a.ws, 9, ee / (oo + 1e-20f)); }
}
__global__ void __launch_bounds__(DBGK) chk_prep(DArgs a) {
    __shared__ float sh[DBGK];
    const int smp = blockIdx.x, t = threadIdx.x; const size_t tok = hsh(smp * 23 + 4) % T; const float* row = DWS(float, S_BIN) + tok * BIN_LD; const int* pos = (const int*)a.in[I_POS];
    const float sa = block_sum(row[t] * row[t], sh), scv = block_sum(row[256 + t] * row[256 + t], sh); const float ra = 1.f / sqrtf(sa / 256.f + LN_EPS), rc = 1.f / sqrtf(scv / 256.f + LN_EPS);
    float e = fabsf(row[t] * ra * a.in[I_BQG][t] - bf2f(DWS(bf16, S_CQ)[tok * 256 + t])); e = fmaxf(e, fabsf(row[256 + t] * rc * a.in[I_BKVG][t] - bf2f(DWS(bf16, S_KVL)[tok * KVW + t])));
    if (t < 32) { const int j = t & 15; float c, s; rope_cs(pos, (int)tok, j, c, s); const float x1 = row[512 + j], x2 = row[528 + j]; const float r = t < 16 ? x1 * c - x2 * s : x2 * c + x1 * s; e = fmaxf(e, fabsf(r - bf2f(DWS(bf16, S_KVL)[tok * KVW + 256 + t]))); }
    if (t < 64) { float r = row[544 + t]; if (t < 16) { float c, s; rope_cs(pos, (int)tok, 2 * (t & 7), c, s); r = t < 8 ? row[544 + t] * c - row[552 + t] * s : row[544 + t] * c + row[536 + t] * s; } e = fmaxf(e, fabsf(r - bf2f(DWS(bf16, S_KIDX)[tok * 64 + t]))); }
    if (t < 16) e = fmaxf(e, 32.f * fabsf(row[608 + t] / 32.f - DWS(float, S_WIDX)[tok * 16 + t]));
    const float ee = block_max(e, sh); if (t == 0) err_max(a.ws, 10, ee);
}
__global__ void __launch_bounds__(DBGK) dbg_snap(DArgs a, int salt) { const size_t tok = hsh(blockIdx.x * 29 + salt) % T; float* snap = DWS(float, WS_SMALL) + 65536 + (size_t)blockIdx.x * 1024; for (int j = 0; j < 4; ++j) snap[threadIdx.x + 256 * j] = a.out[tok * 1024 + threadIdx.x + 256 * j]; }
__global__ void __launch_bounds__(DBGK) chk_b6(DArgs a, int salt) {
    __shared__ float hrow[1024]; __shared__ float ov[1024]; __shared__ float sh[DBGK];
    const int t = threadIdx.x; const size_t tok = hsh(blockIdx.x * 29 + salt) % T; const float* snap = DWS(float, WS_SMALL) + 65536 + (size_t)blockIdx.x * 1024;
    ln_row(snap, a.in[I_LNG] + 2 * 1024, a.in[I_LNB] + 2 * 1024, hrow, sh);
    const bf16* OL = DWS(bf16, S_OL) + tok * 2048;
    for (int j = 0; j < 4; ++j) { const int c = t + 256 * j, h = c >> 7, v = c & 127; float o = 0.f; for (int r = 0; r < 256; ++r) o += bf2f(OL[h * 256 + r]) * a.in[I_BWUV][((size_t)h * 256 + r) * 128 + v]; ov[c] = o; }
    __syncthreads();
    float emax = 0.f, omax = 0.f;
    for (int j = 0; j < 4; ++j) { const int c = t + 256 * j; float o = 0.f; for (int k = 0; k < 1024; ++k) o += ov[k] * a.in[I_BWOUT][(size_t)k * 1024 + c]; const float ref = ALPHA * hrow[c] + o; emax = fmaxf(emax, fabsf(ref - a.out[tok * 1024 + c])); omax = fmaxf(omax, fabsf(o)); }
    const float e = block_max(emax, sh), o = block_max(omax, sh); if (t == 0) err_max(a.ws, 11, e / (o + 1e-20f));
}
__global__ void __launch_bounds__(DBGK) chk_m3(DArgs a, int salt) {
    __shared__ float hrow[1024]; __shared__ float sh[DBGK];
    const int t = threadIdx.x; const size_t tok = hsh(blockIdx.x * 29 + salt) % T; const float* snap = DWS(float, WS_SMALL) + 65536 + (size_t)blockIdx.x * 1024;
    ln_row(snap, a.in[I_LNG] + 1 * 1024, a.in[I_LNB] + 1 * 1024, hrow, sh);
    const int* pos2 = DWS(int, WS_POS2) + tok * 2; const bf16* Y = DWS(bf16, S_Y); float emax = 0.f, omax = 0.f;
    for (int j = 0; j < 4; ++j) { const int c = t + 256 * j; const float y = bf2f(Y[(size_t)pos2[0] * 1024 + c]) + bf2f(Y[(size_t)pos2[1] * 1024 + c]); emax = fmaxf(emax, fabsf(ALPHA * hrow[c] + y - a.out[tok * 1024 + c])); omax = fmaxf(omax, fabsf(y)); }
    const float e = block_max(emax, sh), o = block_max(omax, sh); if (t == 0) err_max(a.ws, 12, e / (o + 1e-20f));
}
__global__ void __launch_bounds__(DBGK) chk_attn(DArgs a) {
    __shared__ float sh[DBGK]; __shared__ float pm[DBGK];
    const int smp = blockIdx.x, t = threadIdx.x, b = smp & 7, hc = (smp >> 3) & 15; const int s = hsh(smp * 31 + 7) % SEQ; const size_t tok = (size_t)b * SEQ + s; const int n = ((s >> 6) + 1) * 64, c = hc & 1, h = hc >> 1;
    const bf16* Q = DWS(bf16, S_Q) + tok * 1024 + hc * 64; const bf16* K = DWS(bf16, S_K) + (size_t)b * SEQ * 1024 + hc * 64; const bf16* V = DWS(bf16, S_V) + (size_t)b * SEQ * 1024 + h * 128;
    const bf16* O = (c ? DWS(bf16, S_O1) : DWS(bf16, S_O0)) + tok * 1024 + h * 128;
    float m = -INFINITY; for (int k = t; k < n; k += DBGK) { float sc = 0.f; for (int d = 0; d < 64; ++d) sc += bf2f(Q[d]) * bf2f(K[(size_t)k * 1024 + d]); m = fmaxf(m, sc); }
    m = block_max(m, sh);
    float l = 0.f, o[128]; for (int d = 0; d < 128; ++d) o[d] = 0.f;
    float emax = 0.f, omax = 0.f;
    for (int d0 = 0; d0 < 128; d0 += 1) { float acc = 0.f, ll = 0.f; for (int k = t; k < n; k += DBGK) { float sc = 0.f; for (int d = 0; d < 64; ++d) sc += bf2f(Q[d]) * bf2f(K[(size_t)k * 1024 + d]); const float p = exp2f(sc - m); ll += p; acc += p * bf2f(V[(size_t)k * 1024 + d0]); }
        const float num = block_sum(acc, sh), den = block_sum(ll, sh); const float ref = num / den; emax = fmaxf(emax, fabsf(ref - bf2f(O[d0]))); omax = fmaxf(omax, fabsf(ref)); }
    (void)l; (void)o; (void)pm;
    if (t == 0) err_max(a.ws, 13, emax / (omax + 1e-20f));
}
__global__ void dbg_encode(DArgs a) {
    const float tol[16] = {0, 2e-3f, 0.03f, 0.03f, 0.03f, 0.03f, 0.03f, 1e-3f, 0.03f, 0.03f, 0.02f, 0.03f, 0.03f, 0.03f, 0, 0};
    const unsigned* err = (const unsigned*)(a.ws + WS_CTL) + CW_ERR; int bad = 0; float ev = 0.f;
#if MK_DBG >= 100
    bad = MK_DBG - 100; ev = __uint_as_float(err[bad]); const float f = 1.0f + fminf(100.f * (ev + 0.001f), 10.f);
#else
    for (int i = 1; i < 16; ++i) if (tol[i] > 0.f && __uint_as_float(err[i]) > tol[i]) { bad = i; break; }
    const float f = 1.0f + 0.1f * bad; (void)ev;
#endif
    for (size_t i = (size_t)blockIdx.x * blockDim.x + threadIdx.x; i < (size_t)T * D; i += (size_t)gridDim.x * blockDim.x) a.out[i] *= f;
}
static void dbg_after_phase(int p, const void* argsv, hipStream_t stream);
#define DBG_AFTER_PHASE(p) dbg_after_phase((p), (const void*)&a, stream)
#endif
struct XOrder {
    int vcu; long a_rt, a_h, b_b, b_h;
    __device__ bool next(int i, pg8::Unit& u) const {
        if (i >= 4) return false;
        const int idx = i * 32 + (vcu & 31), b = vcu >> 5, h = idx >> 5, rt = idx & 31;
        u.pm = b * 32 + rt; u.pn = h; u.e = 0; u.aoff = (long)(b * 32 + rt) * a_rt + h * a_h; u.boff = (long)b * b_b + (long)h * b_h; return true;
    }
};
struct MemOrder {
    int G, c;
    __device__ bool next(int i, pg8::Unit& u) const {
        const int L = i * G + c; if (L >= 64) return false;
        const int j = L >> 5, r = L & 31; u.e = j;
        u.pm = r >> 2; u.pn = r & 3; u.aoff = (long)WS_MEMB + (long)u.pm * 256 * 2048; u.boff = (long)W_MKV + (long)(j * 1024 + u.pn * 256) * 2048;
        return true;
    }
};
struct ProdOrder {
    int G, c, l;
    __device__ bool next(int i, pg8::Unit& u) const {
        const int L = i * G + c; if (L >= 256) return false;
        const int e = L >> 7, r = L & 127, t4 = r & 3, bh = r >> 2, b = bh >> 2, h = bh & 3; u.e = e;
        if (e == 0) { u.pm = bh; u.pn = t4; u.aoff = (long)WS_MK + ((long)b * 256 * 1024 + h * 256) * 2; u.boff = (long)W_XQ + (long)l * 2097152 + ((long)t4 * 256 * 1024 + h * 256) * 2; }
        else { u.pm = t4; u.pn = bh; u.aoff = (long)W_XO + (long)l * 2097152 + ((long)t4 * 256 * 1024 + h * 256) * 2; u.boff = (long)WS_MVT + ((long)b * 256 * 1024 + h * 256) * 2; }
        return true;
    }
};
struct XbOrder {
    int vcu; long b_b, b_pn;
    __device__ bool next(int i, pg8::Unit& u) const {
        if (i >= 4) return false;
        const int idx = i * 32 + (vcu & 31), b = vcu >> 5, rt = idx >> 2, pn = idx & 3;
        u.pm = b * 32 + rt; u.pn = pn; u.e = b; u.aoff = (long)u.pm * 256 * 1024 * 2; u.boff = (long)b * b_b + (long)pn * b_pn; return true;
    }
};
struct MoeOrderA : MoeOrder { long astride; __device__ bool next(int i, pg8::Unit& u) const { const bool ok = MoeOrder::next(i, u); if (ok) u.aoff = (long)u.pm * astride; return ok; } };

constexpr int NPH = 30;
struct Args { const float* in[N_IN]; float* out; unsigned char* ws; int ph_lo, ph_hi; };
static_assert(sizeof(Args) == (N_IN + 2) * 8 + 8, "Args has no holes");
extern __shared__ __attribute__((aligned(16))) unsigned char lds[];
__device__ __forceinline__ Frame make_frame(const int wave_s) {
    const CAS Args* a = (const CAS Args*)__builtin_amdgcn_kernarg_segment_ptr(); asm volatile("" : "+s"(a));
    Frame F;
    F.lds = (LAS unsigned char*)lds;
    F.MISC = (volatile LAS unsigned*)(F.lds + MISC_OFF);
    F.wave = wave_s;
    F.G = gridDim.x; { const int bx = blockIdx.x; F.vcu = (F.G % 8 == 0) ? (bx % 8) * (F.G / 8) + bx / 8 : bx; }
    F.ws = a->ws; F.ctl = (gu32*)(a->ws + WS_CTL); F.out = a->out;
    return F;
}
__device__ __forceinline__ void xattn_products(Frame& F, LAS unsigned char* ring, int l) {
    pg8::Gemm g{WSP(bf16, 0), WSP(bf16, 0), 1024, 1024, 256, nullptr}; ProdOrder S{F.G, F.vcu, l};
    epi::EpiMem E{WSP(bf16, S_WQK), (size_t)(S_WVO - S_WQK) / 2, 1024, 8192};
    pg8::gemm_phase<epi::EpiMem, ProdOrder>(ring, g, S, E, F.wave);
}
__device__ __forceinline__ void xattn_vectors(Frame& F, int l) {
    PHASE_IDS();
    const int gw = F.vcu * NWAVES + wave, NGW = F.G * NWAVES; float* dst = WSP(float, WS_SMALL) + SM_GWB; const float* bwq = WSP(float, WS_SMALL) + SM_GW + l * 2048 + 1024;
    for (int it = gw; it < 8192; it += NGW) { const int b = it >> 10, hm = it & 1023, h = hm >> 8, m = hm & 255;
        const bf16* wt = WSP(bf16, S_WQK) + (size_t)it * 1024;
        const v4u a = *(const GAS v4u*)(wt + lane * 16), c = *(const GAS v4u*)(wt + lane * 16 + 8);
        float sg = ((bflo(a.x) + bfhi(a.x)) + (bflo(a.y) + bfhi(a.y))) + ((bflo(a.z) + bfhi(a.z)) + (bflo(a.w) + bfhi(a.w))) + ((bflo(c.x) + bfhi(c.x)) + (bflo(c.y) + bfhi(c.y))) + ((bflo(c.z) + bfhi(c.z)) + (bflo(c.w) + bfhi(c.w)));
        const bf16* mk = WSP(bf16, WS_MK) + (size_t)(b * 256 + m) * 1024 + h * 256; const v2u kv = *(const GAS v2u*)(mk + 4 * lane); const f32x4 bq = *(const f32x4*)(bwq + h * 256 + 4 * lane);
        float sb = (bflo(kv.x) * bq[0] + bfhi(kv.x) * bq[1]) + (bflo(kv.y) * bq[2] + bfhi(kv.y) * bq[3]);
        sg = wave_sum(sg); sb = wave_sum(sb);
        if (lane == 0) { dst[it] = sg; dst[8192 + it] = sb; } }
}
template <int LO, int HI, int layer> __device__ __forceinline__ void layer_phases(const int wave_s);
template <int LO, int HI> __device__ __forceinline__ void run_phases(const int wave_s) {
    constexpr int lo = LO, hi = HI;
#ifndef MK_PHMASK
#define MK_PHMASK 0x3fffffffull
#endif
#define IN(k) (((MK_PHMASK >> ((k) < 14 ? (k) : ((k) >= 21 ? (k) - 16 : (k)))) & 1ull) && lo <= (k) && (k) < hi)
#ifndef MK_REP
#define MK_REP 0ull
#endif
#define REPS(k) (1 + (int)((MK_REP >> ((k) < 14 ? (k) : ((k) >= 21 ? (k) - 16 : (k)))) & 1ull))
#define SEAM(k) do { if (IN((k) + 1)) { XcdBarrier bar_; bar_.bar = (unsigned*)(F.ctl + CW_BAR); bar_.x = xb_xcc_id(); bar_.st = F.MISC + 8; bar_.wave = wave_s; xcd_barrier(bar_); } } while (0)
#define PRE (F.out)
#define PREB WSP(bf16, WS_PREB)
#define STAT0 WSP(float, WS_STAT)
#define STAT1 (WSP(float, WS_STAT) + (size_t)T * 32)
#define SMALL WSP(float, WS_SMALL)
#define PH_BEGIN() Frame F = make_frame(wave_s); LAS unsigned char* ring = F.lds + RING_OFF; const int bx = (int)blockIdx.x; (void)ring; (void)bx

    if (IN(0)) { PH_BEGIN(); for (int rep_ = 0; rep_ < REPS(0); ++rep_) { p0_prologue(F); } SEAM(0); }

    if constexpr (hi > 1 && lo < 14) layer_phases<LO, HI, 0>(wave_s);
    if constexpr (hi > 14) layer_phases<LO, HI, 1>(wave_s);
}
template <int LO, int HI, int layer> __device__ __forceinline__ void layer_phases(const int wave_s) {
    constexpr int lo = LO, hi = HI;
    {
        if constexpr (layer == 0) {
            if (IN(1)) { PH_BEGIN(); for (int rep_ = 0; rep_ < REPS(1); ++rep_) {
                { pg8::Gemm g{WSP(bf16, S_XB), WSP(bf16, W_QKV), 1024, 1024, 1024, nullptr}; pg8::StaticOrder S; S.init(T, 3072, 1024, 1024, F.G, bx);
                  epi::EpiHeads64 E{WSP(bf16, S_Q), (size_t)(S_K - S_Q) / 2, 2, WSP(float, WS_ROT16)};
                  static_assert(S_V - S_K == S_K - S_Q, "Q, K, V arrays at one stride");
                  pg8::gemm_phase<epi::EpiHeads64, pg8::StaticOrder>(ring, g, S, E, F.wave); }
                {
                  pg8::Gemm g{WSP(bf16, 0), WSP(bf16, 0), 1024, 1024, 1024, nullptr}; MemOrder S{F.G, F.vcu};
                  epi::EpiMem E{WSP(bf16, WS_MK), (size_t)(WS_MVT - WS_MK) / 2, 1024, 1024};
                  pg8::gemm_phase<epi::EpiMem, MemOrder>(ring, g, S, E, F.wave); }
                fold_vectors(F);
                } SEAM(1); }
            if (IN(2)) { PH_BEGIN(); for (int rep_ = 0; rep_ < REPS(2); ++rep_) {
                const attn_body::AttnTensors AT{(const attn_body::bf16*)WSP(bf16, S_Q), (const attn_body::bf16*)WSP(bf16, S_K), (const attn_body::bf16*)WSP(bf16, S_V), (attn_body::bf16*)WSP(bf16, S_O0), (attn_body::bf16*)WSP(bf16, S_O1)};
                attn_body::attn_phase<8>((char*)lds + RING_OFF, AT, F.vcu, F.wave);
                } SEAM(2); }
            if (IN(3)) { PH_BEGIN(); for (int rep_ = 0; rep_ < REPS(3); ++rep_) { diff_combine(F); xattn_products(F, ring, 0); } SEAM(3); }
            if (IN(4)) { PH_BEGIN(); for (int rep_ = 0; rep_ < REPS(4); ++rep_) {
                pg8::Gemm g{WSP(bf16, S_ON), WSP(bf16, W_O), 1024, 1024, 1024, nullptr}; pg8::StaticOrder S; S.init(T, 1024, 1024, 1024, F.G, bx);
                epi::EpiPre<0> E{ld_in(I_X), PRE, PREB, nullptr, STAT0, nullptr, nullptr};
                pg8::gemm_phase<epi::EpiPre<0>, pg8::StaticOrder>(ring, g, S, E, F.wave);
                xattn_vectors(F, 0);
                } SEAM(4); }
        } else {
            if (IN(14)) { PH_BEGIN(); for (int rep_ = 0; rep_ < REPS(14); ++rep_) {
                pg8::Gemm g{PREB, WSP(bf16, W_BIN), 1024, 1024, 1024, nullptr}; pg8::StaticOrder S; S.init(T, BIN_LD, 1024, 1024, F.G, bx);
                epi::EpiFold<false> E{STAT0, SMALL + SM_GW + 2 * 2048, SMALL + SM_GW + 2 * 2048 + 1024, WSP(bf16, S_BIN), BIN_LD};
                pg8::gemm_phase<epi::EpiFold<false>, pg8::StaticOrder>(ring, g, S, E, F.wave);
                } SEAM(14); }
            if (IN(15)) { PH_BEGIN(); for (int rep_ = 0; rep_ < REPS(15); ++rep_) { dsa_prep(F); xattn_products(F, ring, 1); } SEAM(15); }
            if (IN(16)) { PH_BEGIN(); for (int rep_ = 0; rep_ < REPS(16); ++rep_) {
                pg8::Gemm g{WSP(bf16, S_CQ), WSP(bf16, W_Q2) + 2304 * 256, 256, 256, 256, nullptr}; pg8::StaticOrder S; S.init(T, 1024, 256, 256, F.G, bx);
                epi::EpiHeads64 E{WSP(bf16, S_QI), 0, 1, WSP(float, WS_ROT16)};
                pg8::gemm_phase<epi::EpiHeads64, pg8::StaticOrder>(ring, g, S, E, F.wave);
                xattn_vectors(F, 1);
                } SEAM(16); }
            if (IN(17)) { PH_BEGIN(); for (int rep_ = 0; rep_ < REPS(17); ++rep_) { dsa_index(F); } SEAM(17); }
            if (IN(18)) { PH_BEGIN(); for (int rep_ = 0; rep_ < REPS(18); ++rep_) {
                pg8::Gemm g{WSP(bf16, S_CQ), WSP(bf16, W_Q2), 256, 256, 256, nullptr}; pg8::StaticOrder S; S.init(T, 2304, 256, 256, F.G, bx);
                epi::EpiQfull E{WSP(bf16, S_QF), WSP(float, WS_ROT32)};
                pg8::gemm_phase<epi::EpiQfull, pg8::StaticOrder>(ring, g, S, E, F.wave);
                } SEAM(18); }
            if (IN(19)) { PH_BEGIN(); for (int rep_ = 0; rep_ < REPS(19); ++rep_) { sparse_attn(F); } SEAM(19); }
            if (IN(20)) { PH_BEGIN(); for (int rep_ = 0; rep_ < REPS(20); ++rep_) {
                pg8::Gemm g{WSP(bf16, S_OL), WSP(bf16, W_UVO), 2048, 2048, 2048, nullptr}; pg8::StaticOrder S; S.init(T, 1024, 2048, 2048, F.G, bx);
                epi::EpiPre<1> E{PRE, PRE, PREB, STAT0, STAT1, ld_in(I_LNG) + 2 * 1024, ld_in(I_LNB) + 2 * 1024};
                pg8::gemm_phase<epi::EpiPre<1>, pg8::StaticOrder>(ring, g, S, E, F.wave);
                } SEAM(20); }
        }
        constexpr int px = layer == 0 ? 5 : 21;
#define st_mix (WSP(float, WS_STAT) + (size_t)(layer == 0 ? 0 : 1) * T * 32)
#define st_x (WSP(float, WS_STAT) + (size_t)(layer == 0 ? 1 : 0) * T * 32)
        if (IN(px)) { PH_BEGIN(); for (int rep_ = 0; rep_ < REPS(px); ++rep_) {
            pg8::Gemm g{PREB, WSP(bf16, S_WQK), 1024, 1024, 1024, nullptr};
            XbOrder S{F.vcu, 2097152L, 256L * 1024 * 2};
            epi::EpiFoldSoftmax E{st_mix, SMALL + SM_GWB, SMALL + SM_GWB + 8192, WSP(bf16, S_P), (LAS float*)(F.lds + XCH_OFF)};
            pg8::gemm_phase<epi::EpiFoldSoftmax, XbOrder>(ring, g, S, E, F.wave);
            } SEAM(px); }
        if (IN(px + 1)) { PH_BEGIN(); for (int rep_ = 0; rep_ < REPS(px + 1); ++rep_) {
            pg8::Gemm g{WSP(bf16, S_P), WSP(bf16, S_WVO), 1024, 8192, 1024, nullptr};
            XbOrder S{F.vcu, 1024L * 2, 256L * 8192 * 2};
            epi::EpiPre<1, false> E{PRE, PRE, PREB, st_mix, st_x, ld_in(I_LNG) + (layer * 3 + 0) * 1024, ld_in(I_LNB) + (layer * 3 + 0) * 1024};
            pg8::gemm_phase<epi::EpiPre<1, false>, XbOrder>(ring, g, S, E, F.wave);
            } SEAM(px + 3); }
        if (IN(px + 4)) { PH_BEGIN(); for (int rep_ = 0; rep_ < REPS(px + 4); ++rep_) { moe_route(F, layer); } SEAM(px + 4); }
        if (IN(px + 5)) { PH_BEGIN(); for (int rep_ = 0; rep_ < REPS(px + 5); ++rep_) { moe_index(F, layer); } SEAM(px + 5); }
        if (IN(px + 6)) { PH_BEGIN(); for (int rep_ = 0; rep_ < REPS(px + 6); ++rep_) {
            const int* tile_e = WSP(int, WS_TILEE);
            pg8::Gemm g{WSP(bf16, S_XH), WSP(bf16, W_GU) + (size_t)layer * 16 * 1048576, 1024, 1024, 1024, WSP(int, WS_ROWIDX)};
            MoeOrder S{tile_e, tile_e[0], F.G, F.vcu, 2L * 1048576, 4};
            epi::EpiGateUp E{WSP(bf16, S_HID)};
            pg8::gemm_phase<epi::EpiGateUp, MoeOrder, true>(ring, g, S, E, F.wave);
            } SEAM(px + 6); }
        if (IN(px + 7)) { PH_BEGIN(); for (int rep_ = 0; rep_ < REPS(px + 7); ++rep_) {
            const int* tile_e = WSP(int, WS_TILEE);
            pg8::Gemm g{WSP(bf16, S_HID), WSP(bf16, W_DN) + (size_t)layer * 16 * 524288, 512, 512, 512, nullptr};
            MoeOrderA S; S.tile_e = tile_e; S.ntiles = tile_e[0]; S.G = F.G; S.c = F.vcu; S.wstride = 1048576L; S.nn = 4; S.astride = 256L * 512 * 2;
            epi::EpiDown E{WSP(bf16, S_Y), WSP(float, WS_WSORT)};
            pg8::gemm_phase<epi::EpiDown, MoeOrderA>(ring, g, S, E, F.wave);
            } SEAM(px + 7); }
        if (IN(px + 8)) { PH_BEGIN(); for (int rep_ = 0; rep_ < REPS(px + 8); ++rep_) { moe_combine(F, layer); } if (layer == 0) SEAM(px + 8); }
    }
#undef IN
#undef SEAM
}
template <int LO, int HI> __global__ void __launch_bounds__(NWAVES * 64, 2) fwd(Args args) {
    const int wave_s = __builtin_amdgcn_readfirstlane((int)threadIdx.x >> 6);
    if constexpr (HI - LO > 1) {
        Frame F = make_frame(wave_s);
        if (wave_s == 0) ((LAS unsigned*)(F.lds + MISC_OFF))[__builtin_amdgcn_mbcnt_hi(~0u, __builtin_amdgcn_mbcnt_lo(~0u, 0u))] = 0u;
        __syncthreads();
        (void)xcd_barrier_post((unsigned*)(F.ctl + CW_BAR), F.MISC + 8, wave_s);
    }
    run_phases<LO, HI>(wave_s);
}

#if MK_DBG
static void dbg_after_phase(int p, const void* argsv, hipStream_t stream) {
    const Args& A = *(const Args*)argsv; DArgs a{}; for (int i = 0; i < N_IN; ++i) a.in[i] = A.in[i]; a.out = A.out; a.ws = A.ws; a.layer = p >= 14 ? 1 : 0; a.pad = 0;
    const dim3 g(64), b(DBGK);
    if (p == 2) hipLaunchKernelGGL(chk_attn, g, b, 0, stream, a);
    if (p == 14) hipLaunchKernelGGL(chk_fold, g, b, 0, stream, a, 1);
    if (p == 15) hipLaunchKernelGGL(chk_prep, g, b, 0, stream, a);
    if (p == 17) hipLaunchKernelGGL(chk_topk, g, b, 0, stream, a);
    if (p == 18) hipLaunchKernelGGL(chk_q2, g, b, 0, stream, a);
    if (p == 19) { hipLaunchKernelGGL(chk_sparse, g, b, 0, stream, a); hipLaunchKernelGGL(dbg_snap, g, b, 0, stream, a, 101); }
    if (p == 20) hipLaunchKernelGGL(chk_b6, g, b, 0, stream, a, 101);
    if (p == 5 || p == 21) { hipLaunchKernelGGL(chk_x1p, g, b, 0, stream, a); hipLaunchKernelGGL(dbg_snap, g, b, 0, stream, a, 303); }
    if (p == 6 || p == 22) hipLaunchKernelGGL(chk_x4p, g, b, 0, stream, a, 303);
    if (p == 12 || p == 28) { hipLaunchKernelGGL(chk_moe, g, b, 0, stream, a); if (p == 12) hipLaunchKernelGGL(dbg_snap, g, b, 0, stream, a, 202); }
    if (p == 13) hipLaunchKernelGGL(chk_m3, g, b, 0, stream, a, 202);
    if (p == NPH - 1) hipLaunchKernelGGL(dbg_encode, dim3(2048), dim3(256), 0, stream, a);
}
#endif
#if MK_PER_PHASE
template <int P> static void launch_phases(int grid, hipStream_t stream, Args a) {
    if constexpr (P < NPH) {
        static bool once = false; if (!once) { once = true; (void)hipFuncSetAttribute((const void*)fwd<P, P + 1>, hipFuncAttributeMaxDynamicSharedMemorySize, LDS_BYTES); }
        a.ph_lo = P; a.ph_hi = P + 1; hipLaunchKernelGGL((fwd<P, P + 1>), dim3(grid), dim3(NWAVES * 64), LDS_BYTES, stream, a); DBG_AFTER_PHASE(P);
        launch_phases<P + 1>(grid, stream, a);
    }
}
#endif
extern "C" void kernel_launch(void* const* d_in, const int* in_sizes, int n_in, void* d_out, int out_size, void* d_ws, size_t ws_size, hipStream_t stream) {
    static int grid = 0;
    if (grid == 0) {
        if (n_in != N_IN || in_sizes[0] != T * D || out_size != T * D || ws_size < WS_END) { fprintf(stderr, "kernel_launch: shape / workspace mismatch (n_in %d, in0 %d, out %d, ws %zu); nothing launched\n", n_in, n_in > 0 ? in_sizes[0] : -1, out_size, ws_size); grid = -1; return; }
#if !MK_PER_PHASE
        if (hipFuncSetAttribute((const void*)fwd<0, NPH>, hipFuncAttributeMaxDynamicSharedMemorySize, LDS_BYTES) != hipSuccess) { fprintf(stderr, "kernel_launch: hipFuncSetAttribute failed\n"); grid = -1; return; }
        int per_cu = 0;
        if (hipOccupancyMaxActiveBlocksPerMultiprocessor(&per_cu, (const void*)fwd<0, NPH>, NWAVES * 64, LDS_BYTES) != hipSuccess || per_cu < 1) fprintf(stderr, "kernel_launch: note: occupancy query reports %d workgroups per CU\n", per_cu);
        (void)hipGetLastError();
#endif
        grid = 256;
    }
    if (grid < 0) return;
    if (hipMemsetAsync((char*)d_ws + WS_CTL, 0, CTL_ZERO_BYTES, stream) != hipSuccess) { fprintf(stderr, "kernel_launch: hipMemsetAsync failed\n"); return; }
    Args a{};
    for (int i = 0; i < N_IN; ++i) a.in[i] = (const float*)d_in[i];
    a.out = (float*)d_out; a.ws = (unsigned char*)d_ws;
#if MK_PER_PHASE
    launch_phases<0>(grid, stream, a);
#else
    a.ph_lo = 0; a.ph_hi = NPH; hipLaunchKernelGGL((fwd<0, NPH>), dim3(grid), dim3(NWAVES * 64), LDS_BYTES, stream, a);
#endif
    const hipError_t le = hipPeekAtLastError();
    if (le != hipSuccess) fprintf(stderr, "kernel_launch: launch failed: %s\n", hipGetErrorName(le));
}
```

```cpp
#include <hip/hip_runtime.h>
#include <cstdio>
#include <cstdint>

#ifndef MK_PER_PHASE
#define MK_PER_PHASE 0
#endif
#ifndef MK_DBG
#define MK_DBG 0
#endif

#define GAS __attribute__((address_space(1)))
#define LAS __attribute__((address_space(3)))
typedef unsigned short bf16;
typedef unsigned v4u __attribute__((ext_vector_type(4)));
typedef unsigned v2u __attribute__((ext_vector_type(2)));
typedef int v4i __attribute__((ext_vector_type(4)));
typedef float f32x4 __attribute__((ext_vector_type(4)));
typedef float f32x2 __attribute__((ext_vector_type(2)));
typedef float f32x16 __attribute__((ext_vector_type(16)));
typedef short bf16x8 __attribute__((ext_vector_type(8)));
typedef short s16x4 __attribute__((ext_vector_type(4)));
typedef GAS unsigned gu32;
#define RLX_AGENT __ATOMIC_RELAXED, __HIP_MEMORY_SCOPE_AGENT
#define LDS_WAIT() asm volatile("s_waitcnt lgkmcnt(0)" ::: "memory")
#define VM_WAIT() asm volatile("s_waitcnt vmcnt(0)" ::: "memory")
__device__ __forceinline__ unsigned pk2(float lo, float hi) { unsigned r; asm("v_cvt_pk_bf16_f32 %0, %1, %2" : "=v"(r) : "v"(lo), "v"(hi)); return r; }
__device__ __forceinline__ unsigned f2bf(float f) { return pk2(f, 0.f) & 0xffffu; }
__device__ __forceinline__ float bf2f(unsigned short b) { return __builtin_bit_cast(float, (unsigned)b << 16); }
__device__ __forceinline__ float bflo(unsigned w) { return __builtin_bit_cast(float, w << 16); }
__device__ __forceinline__ float bfhi(unsigned w) { return __builtin_bit_cast(float, w & 0xffff0000u); }
__device__ __forceinline__ float dpp_f(float old, float x, const int ctrl, const int rmask) {
    switch (ctrl) {
        case 0xB1: return __builtin_bit_cast(float, __builtin_amdgcn_update_dpp(__builtin_bit_cast(int, old), __builtin_bit_cast(int, x), 0xB1, 0xf, 0xf, false));
        case 0x4E: return __builtin_bit_cast(float, __builtin_amdgcn_update_dpp(__builtin_bit_cast(int, old), __builtin_bit_cast(int, x), 0x4E, 0xf, 0xf, false));
        case 0x141: return __builtin_bit_cast(float, __builtin_amdgcn_update_dpp(__builtin_bit_cast(int, old), __builtin_bit_cast(int, x), 0x141, 0xf, 0xf, false));
        case 0x140: return __builtin_bit_cast(float, __builtin_amdgcn_update_dpp(__builtin_bit_cast(int, old), __builtin_bit_cast(int, x), 0x140, 0xf, 0xf, false));
        case 0x142: return __builtin_bit_cast(float, __builtin_amdgcn_update_dpp(__builtin_bit_cast(int, old), __builtin_bit_cast(int, x), 0x142, 0xa, 0xf, false));
        default: return __builtin_bit_cast(float, __builtin_amdgcn_update_dpp(__builtin_bit_cast(int, old), __builtin_bit_cast(int, x), 0x143, 0xc, 0xf, false));
    }
    (void)rmask;
}
__device__ __forceinline__ float wave_sum(float v) {
    v += dpp_f(v, v, 0xB1, 0xf);
    v += dpp_f(v, v, 0x4E, 0xf);
    v += dpp_f(v, v, 0x141, 0xf);
    v += dpp_f(v, v, 0x140, 0xf);
    v += dpp_f(0.f, v, 0x142, 0xa);
    v += dpp_f(0.f, v, 0x143, 0xc);
    return __builtin_bit_cast(float, __builtin_amdgcn_readlane(__builtin_bit_cast(int, v), 63));
}

constexpr int NB = 8, SEQ = 8192, D = 1024, T = NB * SEQ;
constexpr int MEML = 256, MEMROWS = NB * MEML;
constexpr int NEXP = 16, FF = 512;
constexpr int BIN_W = 624, BIN_LD = 768;
constexpr int KVW = 288;
constexpr int TOPK = 256;
constexpr float LN_EPS = 1e-5f;
constexpr float ALPHA = 1.41421356237309515f;
constexpr float LOG2E = 1.4426950408889634f;
constexpr float C2 = 0.125f * LOG2E;
constexpr float SC2 = 0.08838834764831845f * LOG2E;
constexpr float XQS = 0.0625f * LOG2E;
constexpr int MOE_ROWS = 2 * T + NEXP * 256;
constexpr int MOE_TILES = MOE_ROWS / 256;

constexpr size_t MiB = 1u << 20;
constexpr size_t WS_CTL = 0, CTL_ZERO_BYTES = 1 * MiB;
constexpr size_t WS_SMALL = 1 * MiB;
constexpr size_t WS_ROT16 = 2 * MiB;
constexpr size_t WS_ROT32 = 6 * MiB;
constexpr size_t WS_W = 16 * MiB;
constexpr size_t W_QKV = WS_W;
constexpr size_t W_O = W_QKV + 6 * MiB;
constexpr size_t W_MKV = W_O + 2 * MiB;
constexpr size_t W_XQ = W_MKV + 4 * MiB;
constexpr size_t W_XO = W_XQ + 4 * MiB;
constexpr size_t W_BIN = W_XO + 4 * MiB;
constexpr size_t W_Q2 = W_BIN + 2 * MiB;
constexpr size_t W_UVO = W_Q2 + 2 * MiB;
constexpr size_t W_GU = W_UVO + 4 * MiB;
constexpr size_t W_DN = W_GU + 64 * MiB;
constexpr size_t WS_W_END = W_DN + 32 * MiB;
constexpr size_t WS_PREB = 144 * MiB;
constexpr size_t WS_STAT = 272 * MiB;
constexpr size_t WS_MISC = 288 * MiB;
constexpr size_t WS_STATF = WS_MISC;
constexpr size_t WS_ROUTE = WS_STATF + T * 8;
constexpr size_t WS_ROUTEW = WS_ROUTE + (size_t)T * 16;
constexpr size_t WS_POS2 = WS_ROUTEW + (size_t)T * 8;
constexpr size_t WS_ROWIDX = WS_POS2 + (size_t)T * 8;
constexpr size_t WS_WSORT = WS_ROWIDX + (size_t)MOE_ROWS * 4;
constexpr size_t WS_TILEE = WS_WSORT + (size_t)MOE_ROWS * 4;
constexpr size_t WS_WGB = WS_TILEE + 4096;
constexpr size_t WS_MK = 292 * MiB;
constexpr size_t WS_MVT = 296 * MiB;
constexpr size_t WS_MEMB = 300 * MiB;
constexpr size_t WS_BIG = 304 * MiB;
constexpr size_t S_XB = WS_PREB, S_O0 = WS_BIG;
constexpr size_t S_Q = WS_BIG + 128 * MiB, S_ON = S_Q;
constexpr size_t S_K = WS_BIG + 256 * MiB, S_V = WS_BIG + 384 * MiB, S_O1 = WS_BIG + 512 * MiB;
constexpr size_t S_QX = WS_BIG, S_P = WS_BIG + 128 * MiB, S_OX = WS_BIG + 256 * MiB;
constexpr size_t S_XH = WS_BIG, S_HID = WS_BIG + 128 * MiB, S_Y = WS_BIG + 264 * MiB;
constexpr size_t S_KVL = WS_BIG;
constexpr size_t S_KIDX = S_KVL + 36 * MiB;
constexpr size_t S_WIDX = S_KIDX + 8 * MiB;
constexpr size_t S_IDX = S_WIDX + 4 * MiB;
constexpr size_t S_CQ = S_IDX + 32 * MiB;
constexpr size_t S_QF = S_CQ + 32 * MiB;
constexpr size_t S_SC = S_QF;
constexpr size_t S_QI = S_SC + 256 * MiB;
constexpr size_t S_OL = S_QF + 288 * MiB;
constexpr size_t S_BIN = S_QI + 128 * MiB;
constexpr size_t S_WQK = WS_BIG + 688 * MiB;
constexpr size_t S_WVO = WS_BIG + 704 * MiB;
constexpr size_t WS_END = WS_BIG + 720 * MiB;
static_assert(WS_W_END <= WS_PREB && (MOE_TILES + 16) * 4 <= 4096 && WS_WGB + 256 * 16 * 4 <= WS_MK, "ws map");
static_assert(S_BIN + (size_t)T * BIN_LD * 4 <= WS_END && S_OL + (size_t)T * 2048 * 2 <= WS_END && S_Y + (size_t)MOE_ROWS * 1024 * 2 <= WS_END && S_O1 + 128 * MiB <= WS_END, "ws map");
static_assert(S_HID + (size_t)MOE_ROWS * 512 * 2 <= S_Y && S_QF + (size_t)T * 8 * KVW * 2 <= S_OL && WS_END == 1024 * MiB, "ws map");
constexpr int SM_LAM = 0;
constexpr int SM_GW = 64;
constexpr int SM_GWB = 8192;
constexpr int CW_BAR = 4096;
constexpr int CW_CNT = 8192;
constexpr int CW_ERR = 16384;

constexpr int RING_OFF = 0, RING_BYTES = 131072;
constexpr int XCH_OFF = RING_BYTES;
constexpr int MISC_OFF = 160 * 1024 - 256;
constexpr int LDS_BYTES = 160 * 1024;
constexpr int NWAVES = 8;
namespace pg8 {
#define PG8_LAS __attribute__((address_space(3)))
typedef unsigned short bf16_t;
constexpr int BM = 256, BK = 64, HALF = 128, HTB = HALF * BK * 2  , STAGE_BYTES = 8 * HTB, NXCD = 8, WGM = 8;

__host__ __device__ __forceinline__ int lds_byte(int r, int c) { const int st = (r >> 4) * 2 + (c >> 5), rr = r & 15, cc = c & 31, ob = rr * 64 + cc * 2; return st * 1024 + (ob ^ (((ob >> 9) & 1) << 5)); }
__host__ __device__ __forceinline__ void stage_rc(int b, int& R, int& C) { const int st = b / 1024, sb = b % 1024, swz = sb ^ (((sb >> 9) & 1) << 5); R = (st >> 1) * 16 + swz / 64; C = (st & 1) * 32 + (swz % 64) / 2; }
__host__ __device__ __forceinline__ int perm32(int rho) { const int n = rho >> 4, i = rho & 15; return 8 * (i >> 2) + 4 * n + (i & 3); }

struct Unit { int pm, pn, e; long aoff, boff; };
struct Gemm { const bf16_t* A; const bf16_t* Bt; int lda, ldb, K; const int* gidx; };

struct StaticOrder {
    int nM, nN, nwg, G, c; long tsA, tsB;
    __device__ void init(int M, int N, int lda, int ldb, int G_, int c_) { nM = M / BM; nN = N / BM; nwg = nM * nN; G = G_; c = c_; tsA = (long)BM * lda * 2; tsB = (long)BM * ldb * 2; }
    __device__ bool next(int i, Unit& u) const {
        const long L = (long)i * G + c; if (L >= nwg) return false;
        int wgid = (int)L; { const int q = nwg / NXCD, r = nwg % NXCD, xcd = wgid % NXCD, off = wgid / NXCD; wgid = (xcd < r ? xcd * (q + 1) : r * (q + 1) + (xcd - r) * q) + off; }
        const int nig = WGM * nN, gid = wgid / nig, fm = gid * WGM, gsz = (nM - fm) < WGM ? (nM - fm) : WGM;
        u.pm = fm + ((wgid % nig) % gsz); u.pn = (wgid % nig) / gsz; u.e = 0; u.aoff = u.pm * tsA; u.boff = u.pn * tsB; return true;
    }
};

__device__ __forceinline__ unsigned cvt_pk_bf16(float lo, float hi) { unsigned r; asm volatile("v_cvt_pk_bf16_f32 %0, %1, %2" : "=v"(r) : "v"(lo), "v"(hi)); return r; }
typedef f32x4 Acc[2][2][4][2];

template <class Epi, class Sched, bool GATHER = false>
__device__ __forceinline__ void gemm_phase(PG8_LAS unsigned char* lds, const Gemm g, const Sched& S, const Epi& E, const int wid) {
    int lane_; asm volatile("v_mbcnt_lo_u32_b32 %0, -1, 0\n\tv_mbcnt_hi_u32_b32 %0, -1, %0" : "=v"(lane_));
    const int lane = lane_, tid = wid * 64 + lane, wr = wid >> 2, wc = wid & 3, fr = lane & 15, fq = lane >> 4;
    int Kq = g.K; asm volatile("" : "+s"(Kq));
    const int nt = Kq / BK;
    unsigned vA[2][2], nvA[2][2], voffB[2];
#pragma unroll
    for (int i = 0; i < 2; ++i) { int R, C; stage_rc(tid * 16 + i * 8192, R, C); const int Rb = Epi::PERM ? ((R & ~31) + perm32(R & 31)) : R;
        voffB[i] = (unsigned)(Rb * g.ldb + C) * 2u;
        vA[0][i] = (unsigned)(R * g.lda + C) * 2u; vA[1][i] = vA[0][i]; nvA[0][i] = vA[0][i]; nvA[1][i] = vA[0][i]; }
    const size_t hsA = GATHER ? (size_t)0 : (size_t)HALF * g.lda * 2;
    const size_t kstep = (size_t)(BK * 2);
    const size_t hstepB = (size_t)HALF * g.ldb * 2;
    const unsigned ldsw = (unsigned)wid * 1024u;
    const int aoff = lds_byte(wr * 64 + fr, fq * 8), boff = lds_byte(wc * 32 + fr, fq * 8);
#define PG8_SA(b, h) (((b) * 2 + (h)) * HTB)
#define PG8_SB(b, h) ((4 + (b) * 2 + (h)) * HTB)
#define PG8_STAGE(bufoff, gbase, voff) do { _Pragma("unroll") for (int _i = 0; _i < 2; ++_i) \
        __builtin_amdgcn_global_load_lds((const unsigned*)((const char*)(gbase) + (voff)[_i]), (PG8_LAS unsigned*)(lds + (bufoff) + ldsw + _i * 8192), 16, 0, 0); } while (0)
#define PG8_LDA(dst, b, h) do { _Pragma("unroll") for (int m = 0; m < 4; ++m) _Pragma("unroll") for (int k = 0; k < 2; ++k) dst[m][k] = *(const PG8_LAS bf16x8*)(lds + PG8_SA(b, h) + aoff + m * 2048 + k * 1024); } while (0)
#define PG8_LDB(dst, b, h) do { _Pragma("unroll") for (int n = 0; n < 2; ++n) _Pragma("unroll") for (int k = 0; k < 2; ++k) dst[n][k] = *(const PG8_LAS bf16x8*)(lds + PG8_SB(b, h) + boff + n * 2048 + k * 1024); } while (0)
#define PG8_MMA(ai, bj, At, Bt) do { __builtin_amdgcn_s_setprio(1); _Pragma("unroll") for (int m = 0; m < 4; ++m) _Pragma("unroll") for (int n = 0; n < 2; ++n) _Pragma("unroll") for (int k = 0; k < 2; ++k) \
        acc[ai][bj][m][n] = __builtin_amdgcn_mfma_f32_16x16x32_bf16(Bt[n][k], At[m][k], acc[ai][bj][m][n], 0, 0, 0); __builtin_amdgcn_s_setprio(0); } while (0)
#define PG8_WAIT_V(n) asm volatile("s_waitcnt vmcnt(" #n ")" ::: "memory")
#define PG8_WAIT_L(n) asm volatile("s_waitcnt lgkmcnt(" #n ")" ::: "memory")
#define PG8_BAR __builtin_amdgcn_s_barrier()
#define PG8_SCHED __builtin_amdgcn_sched_barrier(0)
#define PG8_GIDX(dst, u) do { if constexpr (GATHER) { int _t = tid; asm volatile("" : "+v"(_t)); _Pragma("unroll") for (int _i = 0; _i < 2; ++_i) { int _R, _C; stage_rc(_t * 16 + _i * 8192, _R, _C); \
        _Pragma("unroll") for (int _h = 0; _h < 2; ++_h) dst[_h][_i] = (unsigned)(g.gidx[(u).pm * BM + _h * HALF + _R] * g.lda + _C) * 2u; } } } while (0)
    int c_pm, c_pn, c_e, ui = 0; const char* cA; const char* cB;
    { Unit u0; if (!S.next(0, u0)) return; PG8_GIDX(vA, u0); c_pm = u0.pm; c_pn = u0.pn; c_e = u0.e; cA = (const char*)g.A + u0.aoff; cB = (const char*)g.Bt + u0.boff; }
    Acc acc;
#pragma unroll
    for (int a = 0; a < 2; ++a)
#pragma unroll
        for (int b = 0; b < 2; ++b)
#pragma unroll
            for (int m = 0; m < 4; ++m)
#pragma unroll
                for (int n = 0; n < 2; ++n) acc[a][b][m][n] = (f32x4){0.f, 0.f, 0.f, 0.f};
    bf16x8 At[4][2], B0[2][2], B1[2][2];
    PG8_STAGE(PG8_SB(0, 0), cB, voffB); PG8_STAGE(PG8_SB(0, 1), cB + hstepB, voffB); PG8_STAGE(PG8_SA(0, 0), cA, vA[0]); PG8_STAGE(PG8_SA(0, 1), cA + hsA, vA[GATHER ? 1 : 0]);
    if (wr == 1) PG8_BAR;
    PG8_WAIT_V(2); PG8_BAR;
    PG8_STAGE(PG8_SB(1, 0), cB + kstep, voffB); PG8_STAGE(PG8_SA(1, 0), cA + kstep, vA[0]); PG8_STAGE(PG8_SB(1, 1), cB + hstepB + kstep, voffB);
    PG8_WAIT_V(6); PG8_BAR;
    for (;;) {
        Unit nxt; const bool has_next = S.next(ui + 1, nxt);
        const char* nA = has_next ? (const char*)g.A + nxt.aoff : cA; const char* nB = has_next ? (const char*)g.Bt + nxt.boff : cB;
        if constexpr (GATHER) { if (has_next) { PG8_GIDX(nvA, nxt); } else { nvA[0][0] = vA[0][0]; nvA[0][1] = vA[0][1]; nvA[1][0] = vA[1][0]; nvA[1][1] = vA[1][1]; } }
#pragma unroll 1
        for (int t = 0; t < nt; t += 2) {
            const bool last = (t == nt - 2);
            const char* a1 = cA + (size_t)(t + 1) * kstep;
            const char* a2 = last ? nA : cA + (size_t)(t + 2) * kstep; const char* b2 = last ? nB : cB + (size_t)(t + 2) * kstep;
            const char* a3 = a2 + kstep; const char* b3 = b2 + kstep;
            unsigned w0[2], w1[2];
            if constexpr (GATHER) { w0[0] = last ? nvA[0][0] : vA[0][0]; w0[1] = last ? nvA[0][1] : vA[0][1]; w1[0] = last ? nvA[1][0] : vA[1][0]; w1[1] = last ? nvA[1][1] : vA[1][1]; }
            else { w0[0] = vA[0][0]; w0[1] = vA[0][1]; w1[0] = vA[0][0]; w1[1] = vA[0][1]; }
            PG8_LDB(B0, 0, 0); PG8_LDB(B1, 0, 1); PG8_SCHED; PG8_LDA(At, 0, 0); PG8_STAGE(PG8_SA(1, 1), a1 + hsA, vA[GATHER ? 1 : 0]);
            PG8_WAIT_V(8); PG8_WAIT_L(0); PG8_BAR; PG8_MMA(0, 0, At, B0); PG8_MMA(0, 1, At, B1); PG8_BAR; PG8_SCHED;
            PG8_LDA(At, 0, 1); PG8_STAGE(PG8_SB(0, 0), b2, voffB); PG8_STAGE(PG8_SB(0, 1), b2 + hstepB, voffB); PG8_STAGE(PG8_SA(0, 0), a2, w0);
            PG8_WAIT_V(8); PG8_WAIT_L(0); PG8_BAR; PG8_MMA(1, 0, At, B0); PG8_MMA(1, 1, At, B1); PG8_BAR; PG8_SCHED;
            PG8_LDB(B0, 1, 0); PG8_LDB(B1, 1, 1); PG8_SCHED; PG8_LDA(At, 1, 0); PG8_STAGE(PG8_SA(0, 1), a2 + hsA, w1);
            PG8_WAIT_V(8); PG8_WAIT_L(0); PG8_BAR; PG8_MMA(0, 0, At, B0); PG8_MMA(0, 1, At, B1); PG8_BAR; PG8_SCHED;
            PG8_LDA(At, 1, 1); PG8_STAGE(PG8_SB(1, 0), b3, voffB); PG8_STAGE(PG8_SB(1, 1), b3 + hstepB, voffB); PG8_STAGE(PG8_SA(1, 0), a3, w0);
            PG8_WAIT_V(8); PG8_WAIT_L(0); PG8_BAR; PG8_MMA(1, 0, At, B0); PG8_MMA(1, 1, At, B1); PG8_BAR; PG8_SCHED;
        }
        if (wr == 0) PG8_BAR;
        { Unit cu; cu.pm = c_pm; cu.pn = c_pn; cu.e = c_e; cu.aoff = 0; cu.boff = 0; E(acc, cu, wr, wc, fr, fq); }
        if (!has_next) break;
#pragma unroll
        for (int a = 0; a < 2; ++a)
#pragma unroll
            for (int b = 0; b < 2; ++b)
#pragma unroll
                for (int m = 0; m < 4; ++m)
#pragma unroll
                    for (int n = 0; n < 2; ++n) acc[a][b][m][n] = (f32x4){0.f, 0.f, 0.f, 0.f};
        c_pm = nxt.pm; c_pn = nxt.pn; c_e = nxt.e; cA = nA; cB = nB; ++ui;
        if constexpr (GATHER) { vA[0][0] = nvA[0][0]; vA[0][1] = nvA[0][1]; vA[1][0] = nvA[1][0]; vA[1][1] = nvA[1][1]; }
        if (wr == 1) PG8_BAR;
    }
    PG8_WAIT_V(0);
    PG8_BAR;
#undef PG8_SA
#undef PG8_SB
#undef PG8_STAGE
#undef PG8_LDA
#undef PG8_LDB
#undef PG8_MMA
#undef PG8_WAIT_V
#undef PG8_WAIT_L
#undef PG8_BAR
#undef PG8_SCHED
#undef PG8_GIDX
}
}
namespace epi {
using pg8::Acc; using pg8::Unit; using pg8::cvt_pk_bf16;
constexpr int HALF = 128;
__device__ __forceinline__ void row_stats(const float* stat, int row, int fq, float& mu, float& rstd) {
    const f32x4 a = *(const f32x4*)(stat + (size_t)row * 32 + fq * 8), b = *(const f32x4*)(stat + (size_t)row * 32 + fq * 8 + 4);
    float s1 = (a[0] + a[2]) + (b[0] + b[2]), s2 = (a[1] + a[3]) + (b[1] + b[3]);
    s1 += __shfl_xor(s1, 16); s1 += __shfl_xor(s1, 32); s2 += __shfl_xor(s2, 16); s2 += __shfl_xor(s2, 32);
    mu = s1 * (1.0f / 1024.0f); const float var = fmaxf(s2 * (1.0f / 1024.0f) - mu * mu, 0.f); rstd = 1.0f / sqrtf(var + LN_EPS);
}
__device__ __forceinline__ v4u pack8(const f32x4 v0, const f32x4 v1) { v4u w; w.x = cvt_pk_bf16(v0[0], v0[1]); w.y = cvt_pk_bf16(v0[2], v0[3]); w.z = cvt_pk_bf16(v1[0], v1[1]); w.w = cvt_pk_bf16(v1[2], v1[3]); return w; }

struct EpiBf16 {
    static constexpr bool PERM = true;
    bf16* out; int ldc;
    __device__ __forceinline__ void operator()(const Acc& acc, const Unit& u, int wr, int wc, int fr, int fq) const {
        const int row0 = u.pm * 256 + wr * 64 + fr, col0 = u.pn * 256 + wc * 32 + 8 * fq;
#pragma unroll
        for (int ai = 0; ai < 2; ++ai)
#pragma unroll
            for (int m = 0; m < 4; ++m) { bf16* rowp = out + (size_t)(row0 + ai * HALF + m * 16) * ldc + col0;
#pragma unroll
                for (int bj = 0; bj < 2; ++bj) *(v4u*)(rowp + bj * HALF) = pack8(acc[ai][bj][m][0], acc[ai][bj][m][1]); }
    }
};

struct EpiMem {
    static constexpr bool PERM = true;
    bf16* mk; size_t estride; int ldc0, ldc1;
    __device__ __forceinline__ void operator()(const Acc& acc, const Unit& u, int wr, int wc, int fr, int fq) const {
        bf16* out = mk + (size_t)u.e * estride; const int ldc = u.e ? ldc1 : ldc0;
        const int row0 = u.pm * 256 + wr * 64 + fr, col0 = u.pn * 256 + wc * 32 + 8 * fq;
#pragma unroll
        for (int ai = 0; ai < 2; ++ai)
#pragma unroll
            for (int m = 0; m < 4; ++m) { bf16* rowp = out + (size_t)(row0 + ai * HALF + m * 16) * ldc + col0;
#pragma unroll
                for (int bj = 0; bj < 2; ++bj) *(v4u*)(rowp + bj * HALF) = pack8(acc[ai][bj][m][0], acc[ai][bj][m][1]); }
    }
};

struct EpiHeads64 {
    static constexpr bool PERM = true;
    bf16* base0; size_t tstride; int nrope; const float* rot16;
    __device__ __forceinline__ void operator()(Acc& acc, const Unit& u, int wr, int wc, int fr, int fq) const {
        const int t = u.pn >> 2; bf16* base = base0 + (size_t)t * tstride;
        const int row0 = u.pm * 256 + wr * 64 + fr, col0 = (u.pn & 3) * 256 + wc * 32 + 8 * fq;
        const bool ropew = (t < nrope) && ((wc & 1) == 0);
        const float sg = fq == 0 ? -1.0f : 1.0f, rt = fq < 2 ? 1.0f : 0.0f;
#pragma unroll
        for (int ai = 0; ai < 2; ++ai)
#pragma unroll
            for (int m = 0; m < 4; ++m) { const int row = row0 + ai * HALF + m * 16; bf16* rowp = base + (size_t)row * 1024 + col0;
                if (ropew) {
#pragma unroll
                    for (int n = 0; n < 2; ++n) { const f32x4 c0 = *(const f32x4*)(rot16 + (size_t)row * 16 + n * 8), c1 = *(const f32x4*)(rot16 + (size_t)row * 16 + n * 8 + 4);
                        const float cs[4] = {c0[0], c0[2], c1[0], c1[2]}, sn[4] = {c0[1], c0[3], c1[1], c1[3]};
#pragma unroll
                        for (int bj = 0; bj < 2; ++bj)
#pragma unroll
                            for (int e = 0; e < 4; ++e) { const float x = acc[ai][bj][m][n][e], p = __shfl_xor(x, 16);
                                acc[ai][bj][m][n][e] = x + rt * ((x * cs[e] - x) + sg * (p * sn[e])); } } }
#pragma unroll
                for (int bj = 0; bj < 2; ++bj) *(v4u*)(rowp + bj * HALF) = pack8(acc[ai][bj][m][0], acc[ai][bj][m][1]); }
    }
};

struct EpiQfull {
    static constexpr bool PERM = true;
    bf16* qf; const float* rot32;
    __device__ __forceinline__ void operator()(const Acc& acc, const Unit& u, int wr, int wc, int fr, int fq) const {
        const int row0 = u.pm * 256 + wr * 64 + fr; const float sg = fq < 2 ? -1.0f : 1.0f;
#pragma unroll
        for (int ai = 0; ai < 2; ++ai)
#pragma unroll
            for (int m = 0; m < 4; ++m) { const int row = row0 + ai * HALF + m * 16; bf16* rowp = qf + (size_t)row * (8 * KVW);
                if (u.pn < 8) {
#pragma unroll
                    for (int bj = 0; bj < 2; ++bj) *(v4u*)(rowp + u.pn * KVW + bj * HALF + wc * 32 + 8 * fq) = pack8(acc[ai][bj][m][0], acc[ai][bj][m][1]);
                } else {
                    f32x4 cs[2][2];
#pragma unroll
                    for (int n = 0; n < 2; ++n) { const float* rp = rot32 + (size_t)row * 32 + ((fq & 1) * 8 + n * 4) * 2; cs[n][0] = *(const f32x4*)rp; cs[n][1] = *(const f32x4*)(rp + 4); }
#pragma unroll
                    for (int bj = 0; bj < 2; ++bj) { f32x4 v[2] = {acc[ai][bj][m][0], acc[ai][bj][m][1]};
#pragma unroll
                        for (int n = 0; n < 2; ++n)
#pragma unroll
                            for (int e = 0; e < 4; ++e) { const float p = __shfl_xor(v[n][e], 32); const float c = cs[n][e >> 1][(e & 1) * 2], s = cs[n][e >> 1][(e & 1) * 2 + 1];
                                const float x = v[n][e]; v[n][e] = x * c + sg * (p * s); }
                        *(v4u*)(rowp + (4 * bj + wc) * KVW + 256 + 8 * fq) = pack8(v[0], v[1]); } } }
    }
};

template <bool OUTF32> struct EpiFold {
    static constexpr bool PERM = true;
    const float* stat; const float* gw; const float* bw; void* out; int ldc;
    __device__ __forceinline__ void operator()(const Acc& acc, const Unit& u, int wr, int wc, int fr, int fq) const {
        const int row0 = u.pm * 256 + wr * 64 + fr, col0 = u.pn * 256 + wc * 32 + 8 * fq;
        f32x4 gv[2][2], bv[2][2];
#pragma unroll
        for (int bj = 0; bj < 2; ++bj)
#pragma unroll
            for (int n = 0; n < 2; ++n) { gv[bj][n] = *(const f32x4*)(gw + col0 + bj * HALF + 4 * n); bv[bj][n] = *(const f32x4*)(bw + col0 + bj * HALF + 4 * n); }
#pragma unroll
        for (int ai = 0; ai < 2; ++ai)
#pragma unroll
            for (int m = 0; m < 4; ++m) { const int row = row0 + ai * HALF + m * 16; float mu, rstd; row_stats(stat, row, fq, mu, rstd);
#pragma unroll
                for (int bj = 0; bj < 2; ++bj) { const f32x4 v0 = (acc[ai][bj][m][0] - mu * gv[bj][0]) * rstd + bv[bj][0], v1 = (acc[ai][bj][m][1] - mu * gv[bj][1]) * rstd + bv[bj][1];
                    if (OUTF32) { float* p = (float*)out + (size_t)row * ldc + col0 + bj * HALF; *(f32x4*)p = v0; *(f32x4*)(p + 4) = v1; }
                    else *(v4u*)((bf16*)out + (size_t)row * ldc + col0 + bj * HALF) = pack8(v0, v1); } }
    }
};

template <int MODE, bool AUX = true> struct EpiPre {
    static constexpr bool PERM = false;
    const float* resid; float* pre; bf16* preb; const float* stat_old; float* stat_new; const float* g; const float* b;
    __device__ __forceinline__ void operator()(const Acc& acc, const Unit& u, int wr, int wc, int fr, int fq) const {
        const int row0 = u.pm * 256 + wr * 64 + fr, col0 = u.pn * 256 + wc * 32 + 4 * fq;
#pragma unroll
        for (int ai = 0; ai < 2; ++ai)
#pragma unroll
            for (int m = 0; m < 4; ++m) { const int row = row0 + ai * HALF + m * 16; const size_t off = (size_t)row * 1024 + col0;
                float mu = 0.f, rstd = 1.f; if (MODE == 1) row_stats(stat_old, row, fq, mu, rstd);
                float s1 = 0.f, s2 = 0.f;
#pragma unroll
                for (int bj = 0; bj < 2; ++bj)
#pragma unroll
                    for (int n = 0; n < 2; ++n) { f32x4 r;
                        { const v2u rw = *(const v2u*)(preb + off + bj * HALF + n * 16); r = (f32x4){bflo(rw.x), bfhi(rw.x), bflo(rw.y), bfhi(rw.y)}; }
                        if (MODE == 1) { const f32x4 gv = *(const f32x4*)(g + col0 + bj * HALF + n * 16), bv = *(const f32x4*)(b + col0 + bj * HALF + n * 16); r = (r - mu) * rstd * gv + bv; }
                        const f32x4 v = r * ALPHA + acc[ai][bj][m][n];
                        { v2u w; w.x = cvt_pk_bf16(v[0], v[1]); w.y = cvt_pk_bf16(v[2], v[3]); *(v2u*)(preb + off + bj * HALF + n * 16) = w; }
                        s1 += (v[0] + v[1]) + (v[2] + v[3]); s2 += (v[0] * v[0] + v[1] * v[1]) + (v[2] * v[2] + v[3] * v[3]);
                        if (MODE == 1 && n == 1) asm volatile("" ::: "memory"); }
                if (AUX) { s1 += __shfl_xor(s1, 16); s1 += __shfl_xor(s1, 32); s2 += __shfl_xor(s2, 16); s2 += __shfl_xor(s2, 32); }
                if (AUX && fq == 0) *(f32x2*)(stat_new + (size_t)row * 32 + (u.pn * 4 + wc) * 2) = (f32x2){s1, s2};
                asm volatile("" ::: "memory"); }
    }
};

struct EpiSoftmax {
    static constexpr bool PERM = true;
    bf16* out; int ldc; LAS float* xch;
    __device__ __forceinline__ void operator()(Acc& acc, const Unit& u, int wr, int wc, int fr, int fq) const {
        const int row0 = u.pm * 256 + wr * 64 + fr, col0 = u.pn * 256 + wc * 32 + 8 * fq;
#pragma unroll
        for (int ai = 0; ai < 2; ++ai)
#pragma unroll
            for (int m = 0; m < 4; ++m) { float mx = -INFINITY;
#pragma unroll
                for (int bj = 0; bj < 2; ++bj)
#pragma unroll
                    for (int n = 0; n < 2; ++n) { const f32x4 v = acc[ai][bj][m][n]; mx = fmaxf(mx, fmaxf(fmaxf(v[0], v[1]), fmaxf(v[2], v[3]))); }
                mx = fmaxf(mx, __shfl_xor(mx, 16)); mx = fmaxf(mx, __shfl_xor(mx, 32));
                if (fq == 0) xch[(ai * HALF + wr * 64 + m * 16 + fr) * 4 + wc] = mx; }
        asm volatile("s_waitcnt lgkmcnt(0)" ::: "memory"); __builtin_amdgcn_s_barrier(); asm volatile("" ::: "memory");
#pragma unroll
        for (int ai = 0; ai < 2; ++ai)
#pragma unroll
            for (int m = 0; m < 4; ++m) { const int r = ai * HALF + wr * 64 + m * 16 + fr; const f32x4 mm = *(const LAS f32x4*)(xch + r * 4);
                const float M = fmaxf(fmaxf(mm[0], mm[1]), fmaxf(mm[2], mm[3])); float s = 0.f;
#pragma unroll
                for (int bj = 0; bj < 2; ++bj)
#pragma unroll
                    for (int n = 0; n < 2; ++n) { f32x4 v = acc[ai][bj][m][n];
#pragma unroll
                        for (int e = 0; e < 4; ++e) { v[e] = __builtin_amdgcn_exp2f(v[e] - M); s += v[e]; }
                        acc[ai][bj][m][n] = v; }
                s += __shfl_xor(s, 16); s += __shfl_xor(s, 32);
                if (fq == 0) xch[1024 + r * 4 + wc] = s; }
        asm volatile("s_waitcnt lgkmcnt(0)" ::: "memory"); __builtin_amdgcn_s_barrier(); asm volatile("" ::: "memory");
#pragma unroll
        for (int ai = 0; ai < 2; ++ai)
#pragma unroll
            for (int m = 0; m < 4; ++m) { const int r = ai * HALF + wr * 64 + m * 16 + fr; const f32x4 ss = *(const LAS f32x4*)(xch + 1024 + r * 4);
                const float inv = 1.0f / ((ss[0] + ss[1]) + (ss[2] + ss[3])); bf16* rowp = out + (size_t)(row0 + ai * HALF + m * 16) * ldc + col0;
#pragma unroll
                for (int bj = 0; bj < 2; ++bj) *(v4u*)(rowp + bj * HALF) = pack8(acc[ai][bj][m][0] * inv, acc[ai][bj][m][1] * inv); }
    }
};

struct EpiFoldSoftmax {
    static constexpr bool PERM = true;
    const float* stat; const float* gwb; const float* bwb; bf16* out; LAS float* xch;
    __device__ __forceinline__ void operator()(Acc& acc, const Unit& u, int wr, int wc, int fr, int fq) const {
        const int row0 = u.pm * 256 + wr * 64 + fr, col0 = u.pn * 256 + wc * 32 + 8 * fq; const float* gw = gwb + u.e * 1024; const float* bw = bwb + u.e * 1024;
        { f32x4 gv[2][2], bv[2][2];
#pragma unroll
        for (int bj = 0; bj < 2; ++bj)
#pragma unroll
            for (int n = 0; n < 2; ++n) { gv[bj][n] = *(const f32x4*)(gw + col0 + bj * HALF + 4 * n); bv[bj][n] = *(const f32x4*)(bw + col0 + bj * HALF + 4 * n); }
#pragma unroll
        for (int ai = 0; ai < 2; ++ai)
#pragma unroll
            for (int m = 0; m < 4; ++m) { const int row = row0 + ai * HALF + m * 16; float mu, rstd; row_stats(stat, row, fq, mu, rstd); float mx = -INFINITY;
#pragma unroll
                for (int bj = 0; bj < 2; ++bj)
#pragma unroll
                    for (int n = 0; n < 2; ++n) { const f32x4 v = (acc[ai][bj][m][n] - mu * gv[bj][n]) * rstd + bv[bj][n]; acc[ai][bj][m][n] = v; mx = fmaxf(mx, fmaxf(fmaxf(v[0], v[1]), fmaxf(v[2], v[3]))); }
                mx = fmaxf(mx, __shfl_xor(mx, 16)); mx = fmaxf(mx, __shfl_xor(mx, 32));
                if (fq == 0) xch[(ai * HALF + wr * 64 + m * 16 + fr) * 4 + wc] = mx; } }
        asm volatile("s_waitcnt lgkmcnt(0)" ::: "memory"); __builtin_amdgcn_s_barrier(); asm volatile("" ::: "memory");
#pragma unroll
        for (int ai = 0; ai < 2; ++ai)
#pragma unroll
            for (int m = 0; m < 4; ++m) { const int r = ai * HALF + wr * 64 + m * 16 + fr; const f32x4 mm = *(const LAS f32x4*)(xch + r * 4);
                const float M = fmaxf(fmaxf(mm[0], mm[1]), fmaxf(mm[2], mm[3])); float s = 0.f;
#pragma unroll
                for (int bj = 0; bj < 2; ++bj)
#pragma unroll
                    for (int n = 0; n < 2; ++n) { f32x4 v = acc[ai][bj][m][n];
#pragma unroll
                        for (int e = 0; e < 4; ++e) { v[e] = __builtin_amdgcn_exp2f(v[e] - M); s += v[e]; }
                        acc[ai][bj][m][n] = v; }
                s += __shfl_xor(s, 16); s += __shfl_xor(s, 32);
                if (fq == 0) xch[1024 + r * 4 + wc] = s; }
        asm volatile("s_waitcnt lgkmcnt(0)" ::: "memory"); __builtin_amdgcn_s_barrier(); asm volatile("" ::: "memory");
#pragma unroll
        for (int ai = 0; ai < 2; ++ai)
#pragma unroll
            for (int m = 0; m < 4; ++m) { const int r = ai * HALF + wr * 64 + m * 16 + fr; const f32x4 ss = *(const LAS f32x4*)(xch + 1024 + r * 4);
                const float inv = 1.0f / ((ss[0] + ss[1]) + (ss[2] + ss[3])); bf16* rowp = out + (size_t)(row0 + ai * HALF + m * 16) * 1024 + col0;
#pragma unroll
                for (int bj = 0; bj < 2; ++bj) *(v4u*)(rowp + bj * HALF) = pack8(acc[ai][bj][m][0] * inv, acc[ai][bj][m][1] * inv); }
    }
};

struct EpiGateUp {
    static constexpr bool PERM = true;
    bf16* hid;
    __device__ __forceinline__ void operator()(const Acc& acc, const Unit& u, int wr, int wc, int fr, int fq) const {
        const int row0 = u.pm * 256 + wr * 64 + fr, col0 = u.pn * 128 + wc * 16 + 4 * fq;
#pragma unroll
        for (int ai = 0; ai < 2; ++ai)
#pragma unroll
            for (int m = 0; m < 4; ++m) { bf16* rowp = hid + (size_t)(row0 + ai * HALF + m * 16) * FF + col0;
#pragma unroll
                for (int bj = 0; bj < 2; ++bj) { const f32x4 v0 = acc[ai][bj][m][0], v1 = acc[ai][bj][m][1];
                    float h[4]; const float gt[4] = {v0[0], v0[2], v1[0], v1[2]}, up[4] = {v0[1], v0[3], v1[1], v1[3]};
#pragma unroll
                    for (int j = 0; j < 4; ++j) h[j] = gt[j] * __builtin_amdgcn_rcpf(1.0f + __builtin_amdgcn_exp2f(-gt[j] * LOG2E)) * up[j];
                    v2u w; w.x = cvt_pk_bf16(h[0], h[1]); w.y = cvt_pk_bf16(h[2], h[3]); *(v2u*)(rowp + bj * 64) = w; } }
    }
};
struct EpiDown {
    static constexpr bool PERM = true;
    bf16* y; const float* wsort;
    __device__ __forceinline__ void operator()(const Acc& acc, const Unit& u, int wr, int wc, int fr, int fq) const {
        const int row0 = u.pm * 256 + wr * 64 + fr, col0 = u.pn * 256 + wc * 32 + 8 * fq;
#pragma unroll
        for (int ai = 0; ai < 2; ++ai)
#pragma unroll
            for (int m = 0; m < 4; ++m) { const int row = row0 + ai * HALF + m * 16; const float w = wsort[row]; bf16* rowp = y + (size_t)row * 1024 + col0;
#pragma unroll
                for (int bj = 0; bj < 2; ++bj) *(v4u*)(rowp + bj * HALF) = pack8(acc[ai][bj][m][0] * w, acc[ai][bj][m][1] * w); }
    }
};
}
#include <hip/hip_bf16.h>
#include <cmath>
namespace attn_body {
using bf16=__hip_bfloat16;
using bf16x8=__attribute__((ext_vector_type(8)))short;
using s16x4=__attribute__((ext_vector_type(4)))short;
using f32x16=__attribute__((ext_vector_type(16)))float;
using u32x4=__attribute__((ext_vector_type(4)))unsigned;
constexpr int BATCH=8,NHEAD=16,SEQ=8192,D=64,DM=NHEAD*D;
constexpr int NW=8,QBLK=32,QB=QBLK*NW,KVBLK=64,NQB=SEQ/QB;
constexpr int ATTN_PITCH=DM, ATTN_UNIT_ROWS=QB;
__device__ __forceinline__ int crow(int r,int hi){return (r&3)+8*(r>>2)+4*hi;}
#define SBAR() __builtin_amdgcn_sched_barrier(0)
__device__ __forceinline__ void cmask(f32x16&p0,f32x16&p1,int jb,int qrel,int hi){
  const float NEG=-INFINITY; (void)hi;
  if(jb>(qrel>>6)){
  #pragma unroll
  for(int r=0;r<16;++r){p0[r]=NEG;p1[r]=NEG;}}
}


constexpr int NSLOT=3, SLOTB=8192, VSLOTB=16384;
constexpr int LDS_K=0, LDS_V=NSLOT*SLOTB, LDS_WS=LDS_V+NSLOT*VSLOTB, LDS_OST=LDS_WS+NW*64*4, LDS_BYTES=LDS_OST+NW*8192;
constexpr float C2=0.125f*1.4426950408889634f;
__device__ __forceinline__ void glds16(const void*gsrc,unsigned lds_dst){unsigned keep;
  asm volatile("s_mov_b32 %0, m0\n\ts_mov_b32 m0, %2\n\ts_nop 0\n\tglobal_load_lds_dwordx4 %1, off\n\ts_mov_b32 m0, %0":"=&s"(keep):"v"(gsrc),"s"(lds_dst):"memory");}
__device__ __forceinline__ float max3f(float a,float b,float c){float r;asm("v_max3_f32 %0, %1, %2, %3":"=v"(r):"v"(a),"v"(b),"v"(c));return r;}
__device__ __forceinline__ float max2f(float a,float b){float r;asm("v_max_f32_e32 %0, %1, %2":"=v"(r):"v"(a),"v"(b));return r;}
__device__ __forceinline__ float fadd_s(float a,float b){float r;asm("v_add_f32_e32 %0, %1, %2":"=v"(r):"v"(a),"v"(b));return r;}
__device__ __forceinline__ float fsub_s(float a,float b){float r;asm("v_sub_f32_e32 %0, %1, %2":"=v"(r):"v"(a),"v"(b));return r;}
typedef float f32x2_t __attribute__((ext_vector_type(2))); typedef __bf16 bf16x2_t __attribute__((ext_vector_type(2)));
__device__ __forceinline__ unsigned cvtpk_s(float lo,float hi){f32x2_t v={lo,hi};bf16x2_t b=__builtin_convertvector(v,bf16x2_t);return __builtin_bit_cast(unsigned,b);}
#define WAIT_BAR(N) asm volatile("s_waitcnt vmcnt(" #N ") lgkmcnt(0)\n\ts_barrier":::"memory")

__device__ __forceinline__ void qkt(f32x16&p0,f32x16&p1,const char*Kslot,const __attribute__((address_space(3))) char*qst,const f32x16&negm,int r32,int hi){
  #define QR(d0) (*(const __attribute__((address_space(3))) bf16x8*)(qst+(d0)*1024))
  const char*kb=Kslot+hi*1024+r32*16;
  #pragma unroll
  for(int d0=0;d0<4;++d0){
    const bf16x8 b0=*reinterpret_cast<const bf16x8*>(kb+d0*2048);
    const bf16x8 b1=*reinterpret_cast<const bf16x8*>(kb+d0*2048+512);
    if(d0==0){p0=__builtin_amdgcn_mfma_f32_32x32x16_bf16(b0,QR(0),negm,0,0,0);p1=__builtin_amdgcn_mfma_f32_32x32x16_bf16(b1,QR(0),negm,0,0,0);}
    else{p0=__builtin_amdgcn_mfma_f32_32x32x16_bf16(b0,QR(d0),p0,0,0,0);p1=__builtin_amdgcn_mfma_f32_32x32x16_bf16(b1,QR(d0),p1,0,0,0);}}
  #undef QR
}
typedef __attribute__((address_space(3))) const char* lds_cptr;
typedef short v4i16_t __attribute__((ext_vector_type(4)));
__device__ __forceinline__ void kload8(bf16x8*kf,lds_cptr kp){
  kf[0]=*(const __attribute__((address_space(3))) bf16x8*)(kp);      kf[1]=*(const __attribute__((address_space(3))) bf16x8*)(kp+512);
  kf[2]=*(const __attribute__((address_space(3))) bf16x8*)(kp+2048); kf[3]=*(const __attribute__((address_space(3))) bf16x8*)(kp+2560);
  kf[4]=*(const __attribute__((address_space(3))) bf16x8*)(kp+4096); kf[5]=*(const __attribute__((address_space(3))) bf16x8*)(kp+4608);
  kf[6]=*(const __attribute__((address_space(3))) bf16x8*)(kp+6144); kf[7]=*(const __attribute__((address_space(3))) bf16x8*)(kp+6656);
}
__device__ __forceinline__ void kload2(bf16x8*kf,lds_cptr kp,int j){ kf[2*j]=*(const __attribute__((address_space(3))) bf16x8*)(kp+j*2048); kf[2*j+1]=*(const __attribute__((address_space(3))) bf16x8*)(kp+j*2048+512); }
__device__ __forceinline__ s16x4 vtr(lds_cptr p){ return __builtin_bit_cast(s16x4,__builtin_amdgcn_ds_read_tr16_b64_v4i16((__attribute__((address_space(3))) v4i16_t*)p)); }
__device__ __forceinline__ float rowmax(const f32x16&p0,const f32x16&p1){
  float a=max3f(p0[0],p0[1],p1[0]),b=max3f(p0[2],p0[3],p1[1]);a=max3f(a,p1[2],p1[3]);
  #pragma unroll
  for(int r=4;r<16;r+=4){a=max3f(a,p0[r],p0[r+1]);b=max3f(b,p0[r+2],p0[r+3]);a=max3f(a,p1[r],p1[r+1]);b=max3f(b,p1[r+2],p1[r+3]);}
  const float m=max2f(a,b);
  auto rr=__builtin_amdgcn_permlane32_swap(__float_as_uint(m),__float_as_uint(m),false,false);
  return max2f(__uint_as_float(rr[0]),__uint_as_float(rr[1]));
}
__device__ __forceinline__ void pv(f32x16*o,int vb,bf16x8 pa0,bf16x8 pa1,bf16x8 pa2,bf16x8 pa3){
  #pragma unroll
  for(int d0=0;d0<2;++d0){s16x4 lo[4],hi[4];
    #pragma unroll
    for(int ks=0;ks<4;++ks){
      asm volatile("ds_read_b64_tr_b16 %0,%1 offset:%c2":"=&v"(lo[ks]):"v"(vb),"i"(d0*4096+ks*1024):"memory");
      asm volatile("ds_read_b64_tr_b16 %0,%1 offset:%c2":"=&v"(hi[ks]):"v"(vb),"i"(d0*4096+ks*1024+512):"memory");}
    asm volatile("s_waitcnt lgkmcnt(0)":::"memory");SBAR();
    #define PK(k) (bf16x8){lo[k][0],lo[k][1],lo[k][2],lo[k][3],hi[k][0],hi[k][1],hi[k][2],hi[k][3]}
    o[d0]=__builtin_amdgcn_mfma_f32_32x32x16_bf16(pa0,PK(0),o[d0],0,0,0);
    o[d0]=__builtin_amdgcn_mfma_f32_32x32x16_bf16(pa1,PK(1),o[d0],0,0,0);
    o[d0]=__builtin_amdgcn_mfma_f32_32x32x16_bf16(pa2,PK(2),o[d0],0,0,0);
    o[d0]=__builtin_amdgcn_mfma_f32_32x32x16_bf16(pa3,PK(3),o[d0],0,0,0);
    #undef PK
  }
}

#ifndef ATTN_STORE16
#define ATTN_STORE16(p,v) (*(u32x4*)(p)=(v))
#endif
template<int THRL> __device__ __forceinline__ void attn_unit(const int wid,int b,int h,int hv,int qb,const bf16*Q,const bf16*__restrict__ K,const bf16*__restrict__ V,bf16*O,char*shm){
  int lane_; asm volatile("v_mbcnt_lo_u32_b32 %0, -1, 0\n\tv_mbcnt_hi_u32_b32 %0, -1, %0":"=v"(lane_)); const int lane=lane_,r32=lane&31,hi=lane>>5;
  const long rowbase=(long)b*SEQ; const int q0=qb*QB;
  const bf16*Qw=Q+(rowbase+q0+wid*QBLK)*DM+h*D;
  const bf16*Kh=K+rowbase*DM+h*D,*Vh=V+rowbase*DM+hv*D;
  const unsigned lds0=(unsigned)(uintptr_t)shm;
  float*wsf=(float*)(shm+LDS_WS)+wid*64;
  const bf16*ksrc=Kh+(long)lane*DM+wid*8;
  const bf16*vsrc=Vh+(long)(16*(wid&3)+(lane>>2))*DM+(wid>>2)*32+(lane&3)*8;
  const unsigned kdst=lds0+LDS_K+wid*1024, vdst=lds0+LDS_V+wid*1024;
  #define DMA_K(t,slot) glds16(ksrc+(long)(t)*KVBLK*DM,(unsigned)__builtin_amdgcn_readfirstlane(kdst+(slot)))
  #define DMA_V(t,slot) do{ glds16(vsrc+(long)(t)*KVBLK*DM,(unsigned)__builtin_amdgcn_readfirstlane(vdst+2*(slot))); glds16(vsrc+64+(long)(t)*KVBLK*DM,(unsigned)__builtin_amdgcn_readfirstlane(vdst+8192+2*(slot))); }while(0)
  const int vb0=(int)(lds0+LDS_V)+((lane>>4)&1)*32+(lane&3)*8+(4*hi+((lane&15)>>2))*64;
  const char*Kbase=shm+LDS_K; bf16x8 kf[8];
  const lds_cptr shm3=(lds_cptr)shm; const lds_cptr kp0=shm3+LDS_K+hi*1024+r32*16; const lds_cptr vp0=shm3+LDS_V+((lane>>4)&1)*32+(lane&3)*8+(4*hi+((lane&15)>>2))*64;
  const int NT=(q0+QB)/KVBLK;
  DMA_K(0,0);DMA_V(0,0);DMA_K(1,SLOTB);
  const lds_cptr qst=(lds_cptr)shm+LDS_OST+wid*8192+lane*16;
  { bf16x8 qtmp[4];
  #pragma unroll
  for(int d0=0;d0<4;++d0)qtmp[d0]=*reinterpret_cast<const bf16x8*>(&Qw[(long)r32*DM+d0*16+hi*8]);
  #pragma unroll
  for(int d0=0;d0<4;++d0)*(__attribute__((address_space(3))) bf16x8*)((__attribute__((address_space(3))) char*)qst+d0*1024)=qtmp[d0]; }
  #define QR(d0) (*(const __attribute__((address_space(3))) bf16x8*)(qst+(d0)*1024))
  float mhat=0.f,l_reg=0.f;f32x16 o[4];o[0]=f32x16{};o[1]=f32x16{};o[2]=f32x16{};o[3]=f32x16{};const f32x16 negm=f32x16{};
  const int qrel=wid*QBLK+r32;
  #define CMASK(P0,P1,t) do{int jb_=(t)-(NT-4); if(jb_>=0)cmask(P0,P1,jb_,qrel,hi);}while(0)
  bool resc=false;
  #define START(P0,P1) do{ const float rm=rowmax(P0,P1); resc=false; \
    { const float dl=rm; mhat=fadd_s(mhat,dl); \
      _Pragma("unroll") for(int r=0;r<16;++r){P0[r]=fsub_s(P0[r],dl);P1[r]=fsub_s(P1[r],dl);} \
      } \
    _Pragma("unroll") for(int r=0;r<16;++r)P0[r]=__builtin_amdgcn_exp2f(P0[r]); }while(0)
  #define RESC() do{ if(resc){ asm volatile("s_waitcnt lgkmcnt(0)":::"memory"); \
      _Pragma("unroll") for(int d_=0;d_<4;++d_) _Pragma("unroll") for(int r=0;r<16;++r)o[d_][r]*=wsf[crow(r,hi)]; } }while(0)
  f32x16 pA0,pA1,pB0,pB1;
  int sl_prev=0,sl_cur=0,sl_next=SLOTB;
  #define ROT() do{sl_prev=sl_cur;sl_cur=sl_next;sl_next=(sl_next==(NSLOT-1)*SLOTB)?0:sl_next+SLOTB;}while(0)
  DMA_K(2,2*SLOTB);
  WAIT_BAR(3);
  qkt(pA0,pA1,Kbase,qst,negm,r32,hi);asm volatile("s_nop 15\n\ts_nop 7":"+v"(pA0),"+v"(pA1));CMASK(pA0,pA1,0);
  START(pA0,pA1);
  _Pragma("unroll") for(int r=0;r<16;++r)pA1[r]=__builtin_amdgcn_exp2f(pA1[r]);
  WAIT_BAR(0);
  DMA_K(3,0);DMA_V(1,SLOTB);
  ROT();
  kload8(kf,kp0+sl_cur);
  WAIT_BAR(3);
  s16x4 vlo[8],vhi[8]; u32x4 pw0,pw1,pw2,pw3;
  #define PKW(P,B) cvtpk_s(P[B],P[B+1])
  #define PAF(k) __builtin_bit_cast(bf16x8,pw##k)
  #define VFR(i) (bf16x8){vlo[i][0],vlo[i][1],vlo[i][2],vlo[i][3],vhi[i][0],vhi[i][1],vhi[i][2],vhi[i][3]}
  #define PIN(x) asm volatile("":"+v"(x))
  #define MX3(a,b,c) __builtin_fmaxf(__builtin_fmaxf((a),(b)),(c))
  #define GAPA(MF,A0,A1,A2,A3,W0,W1,PW) do{ MF; sacc+=A0; sacc+=A1; sacc+=A2; sacc+=A3; PIN(sacc); W0; W1; PIN(PW); SBAR(); }while(0)
  #define EX(v) __builtin_amdgcn_exp2f(v)
  #define GAPB(MF,X,B) do{ MF; X[B]=EX(X[B]); X[B+1]=EX(X[B+1]); X[B+2]=EX(X[B+2]); X[B+3]=EX(X[B+3]); PIN(X); SBAR(); }while(0)
  #define VRD(i) do{ vlo[i]=vtr(vp_+(((i)>>2)*4096+((i)&3)*1024)); vhi[i]=vtr(vp_+(((i)>>2)*4096+((i)&3)*1024+512)); }while(0)
  #define KRD(G,j) do{ if(G){ kload2(kf,kp0+sl_next,j); SBAR(); } }while(0)
  #define STEP(C0,C1,P0,P1,t,GK,GV,GL) do{ SBAR(); \
    const lds_cptr vp_=vp0+2*sl_prev; \
    VRD(0); SBAR(); float sacc=(P0[0]+P0[1]); \
    GAPA(C0=__builtin_amdgcn_mfma_f32_32x32x16_bf16(kf[0],QR(0),negm,0,0,0), P0[2],P0[3],P0[4],P0[5],     pw0[0]=PKW(P0,0), pw0[1]=PKW(P0,2), pw0); \
    VRD(4); SBAR(); GAPA(C1=__builtin_amdgcn_mfma_f32_32x32x16_bf16(kf[1],QR(0),negm,0,0,0), P0[6],P0[7],P0[8],P0[9],     pw0[2]=PKW(P0,4), pw0[3]=PKW(P0,6), pw0); \
    VRD(1); SBAR(); GAPA(C0=__builtin_amdgcn_mfma_f32_32x32x16_bf16(kf[2],QR(1),C0,0,0,0),   P0[10],P0[11],P0[12],P0[13], pw1[0]=PKW(P0,8), pw1[1]=PKW(P0,10), pw1); \
    VRD(5); SBAR(); GAPA(C1=__builtin_amdgcn_mfma_f32_32x32x16_bf16(kf[3],QR(1),C1,0,0,0),   P0[14],P0[15],P1[0],P1[1],   pw1[2]=PKW(P0,12),pw1[3]=PKW(P0,14), pw1); \
    VRD(2); SBAR(); GAPA(C0=__builtin_amdgcn_mfma_f32_32x32x16_bf16(kf[4],QR(2),C0,0,0,0),   P1[2],P1[3],P1[4],P1[5],     pw2[0]=PKW(P1,0), pw2[1]=PKW(P1,2), pw2); \
    VRD(6); SBAR(); GAPA(C1=__builtin_amdgcn_mfma_f32_32x32x16_bf16(kf[5],QR(2),C1,0,0,0),   P1[6],P1[7],P1[8],P1[9],     pw2[2]=PKW(P1,4), pw2[3]=PKW(P1,6), pw2); \
    VRD(3); SBAR(); GAPA(C0=__builtin_amdgcn_mfma_f32_32x32x16_bf16(kf[6],QR(3),C0,0,0,0),   P1[10],P1[11],P1[12],P1[13], pw3[0]=PKW(P1,8), pw3[1]=PKW(P1,10), pw3); \
    VRD(7); SBAR(); GAPA(C1=__builtin_amdgcn_mfma_f32_32x32x16_bf16(kf[7],QR(3),C1,0,0,0),   P1[14],P1[15],0.f,0.f,       pw3[2]=PKW(P1,12),pw3[3]=PKW(P1,14), pw3); \
    l_reg+=sacc; \
    if(GK){DMA_K((t)+3,sl_cur);} if(GV){DMA_V((t)+1,sl_next);} \
    _Pragma("unroll") for(int r=0;r<16;++r){C0[r]-=mhat;C1[r]-=mhat;} \
    CMASK(C0,C1,t); \
    { float a=MX3(C0[0],C0[1],C1[0]),b=MX3(C0[2],C0[3],C1[1]); a=MX3(a,C1[2],C1[3]); \
      _Pragma("unroll") for(int r=4;r<16;r+=4){a=MX3(a,C0[r],C0[r+1]);b=MX3(b,C0[r+2],C0[r+3]);a=MX3(a,C1[r],C1[r+1]);b=MX3(b,C1[r+2],C1[r+3]);} \
      float rm=__builtin_fmaxf(a,b); { auto rr=__builtin_amdgcn_permlane32_swap(__float_as_uint(rm),__float_as_uint(rm),false,false); rm=__builtin_fmaxf(__uint_as_float(rr[0]),__uint_as_float(rr[1])); } \
      resc=false; \
      if(__builtin_expect(__any(rm>(float)THRL),0)){ const float dl=__builtin_fmaxf(rm,0.f); mhat+=dl; \
        _Pragma("unroll") for(int r=0;r<16;++r){C0[r]-=dl;C1[r]-=dl;} \
        const float f=__builtin_amdgcn_exp2f(-dl); l_reg*=f; if(hi==0)wsf[r32]=f; resc=true; } } \
    SBAR(); \
    GAPB(o[0]=__builtin_amdgcn_mfma_f32_32x32x16_bf16(PAF(0),VFR(0),o[0],0,0,0), C0,0); \
    GAPB(o[1]=__builtin_amdgcn_mfma_f32_32x32x16_bf16(PAF(0),VFR(4),o[1],0,0,0), C0,4); \
    KRD(GL,0); GAPB(o[0]=__builtin_amdgcn_mfma_f32_32x32x16_bf16(PAF(1),VFR(1),o[0],0,0,0), C0,8); \
    KRD(GL,1); GAPB(o[1]=__builtin_amdgcn_mfma_f32_32x32x16_bf16(PAF(1),VFR(5),o[1],0,0,0), C0,12); \
    KRD(GL,2); GAPB(o[0]=__builtin_amdgcn_mfma_f32_32x32x16_bf16(PAF(2),VFR(2),o[0],0,0,0), C1,0); \
    KRD(GL,3); GAPB(o[1]=__builtin_amdgcn_mfma_f32_32x32x16_bf16(PAF(2),VFR(6),o[1],0,0,0), C1,4); \
    GAPB(o[0]=__builtin_amdgcn_mfma_f32_32x32x16_bf16(PAF(3),VFR(3),o[0],0,0,0), C1,8); \
    GAPB(o[1]=__builtin_amdgcn_mfma_f32_32x32x16_bf16(PAF(3),VFR(7),o[1],0,0,0), C1,12); \
    pv(o+2,vb0+2*sl_prev+8192,PAF(0),PAF(1),PAF(2),PAF(3));   \
    }while(0)
  int t=1;
  #undef CMASK
  #define CMASK(P0,P1,t) do{}while(0)
  for(;t+5<NT;t+=2){
    STEP(pB0,pB1,pA0,pA1,t,true,true,true);     WAIT_BAR(3); RESC(); ROT();
    STEP(pA0,pA1,pB0,pB1,t+1,true,true,true);   WAIT_BAR(3); RESC(); ROT();
  }
  #undef CMASK
  #define CMASK(P0,P1,t) do{int jb_=(t)-(NT-4); if(jb_>=0)cmask(P0,P1,jb_,qrel,hi);}while(0)
  #define ENDW(tt) do{ if((tt)+3<NT){WAIT_BAR(3);} else if((tt)+2<NT){WAIT_BAR(2);} else {WAIT_BAR(0);} }while(0)
  for(;t+1<NT;t+=2){
    STEP(pB0,pB1,pA0,pA1,t,(t+3<NT),(t+1<NT),(t+1<NT));       ENDW(t);   RESC(); ROT();
    STEP(pA0,pA1,pB0,pB1,t+1,(t+4<NT),(t+2<NT),(t+2<NT));     ENDW(t+1); RESC(); ROT();
  }
  STEP(pB0,pB1,pA0,pA1,NT-1,false,false,false); RESC();
  { float sacc=pB0[0]+pB0[1]; _Pragma("unroll") for(int r=2;r<16;++r)sacc+=pB0[r]; _Pragma("unroll") for(int r=0;r<16;++r)sacc+=pB1[r]; l_reg+=sacc;
    pw0=(u32x4){PKW(pB0,0),PKW(pB0,2),PKW(pB0,4),PKW(pB0,6)};pw1=(u32x4){PKW(pB0,8),PKW(pB0,10),PKW(pB0,12),PKW(pB0,14)};pw2=(u32x4){PKW(pB1,0),PKW(pB1,2),PKW(pB1,4),PKW(pB1,6)};pw3=(u32x4){PKW(pB1,8),PKW(pB1,10),PKW(pB1,12),PKW(pB1,14)};
    SBAR(); pv(o,vb0+2*sl_cur,PAF(0),PAF(1),PAF(2),PAF(3)); pv(o+2,vb0+2*sl_cur+8192,PAF(0),PAF(1),PAF(2),PAF(3)); }
  #undef PKW
  #undef PAF
  #undef VFR
  #undef PIN
  #undef MX3
  #undef GAPA
  #undef GAPB
  #undef EX
  #undef VRD
  #undef KRD
  #undef STEP
  #undef ENDW
  {auto rr=__builtin_amdgcn_permlane32_swap(__float_as_uint(l_reg),__float_as_uint(l_reg),false,false);l_reg=__uint_as_float(rr[0])+__uint_as_float(rr[1]);}
  if(hi==0)wsf[32+r32]=l_reg;asm volatile("s_waitcnt lgkmcnt(0)":::"memory");
  float rli[16];
  #pragma unroll
  for(int r=0;r<16;++r)rli[r]=__builtin_amdgcn_rcpf(wsf[32+crow(r,hi)]);
  bf16*Ow=O+(rowbase+q0+wid*QBLK)*DM+hv*D;
  { bf16*stg=(bf16*)(shm+LDS_OST)+wid*4096;
    #pragma unroll
    for(int r=0;r<16;++r){const int orow=crow(r,hi);
      #pragma unroll
      for(int d0=0;d0<4;++d0)stg[orow*128+d0*32+r32]=__float2bfloat16(o[d0][r]*rli[r]);}
    asm volatile("s_waitcnt lgkmcnt(0)":::"memory");
    #pragma unroll
    for(int i=0;i<8;++i){const int row=i*4+(lane>>4),ch=lane&15; const u32x4 v=*(const u32x4*)(stg+row*128+ch*8); ATTN_STORE16(Ow+(long)row*DM+ch*8,v);} }
  asm volatile("s_waitcnt lgkmcnt(0)\n\ts_barrier":::"memory");
  #undef QR
  #undef DMA_K
  #undef DMA_V
  #undef CMASK
  #undef START
  #undef RESC
  #undef ROT
}
constexpr int ATTN_LDS_BYTES=LDS_BYTES;
struct AttnTensors { const bf16* Q; const bf16* K; const bf16* V; bf16* O0; bf16* O1; };
template<int THRL=8> __device__ __forceinline__ void attn_phase(char*lds,const AttnTensors&T,int vcu,const int wid){
  const int bhc=vcu>>1, part=vcu&1, b=bhc>>4, h=(bhc>>1)&7, c=bhc&1;
  bf16*O=c?T.O1:T.O0;
  for(int i=0;i<16;++i){ const int j=2*(i>>1)+part, qb=(i&1)?(NQB-1-j):j; attn_unit<THRL>(wid,b,2*h+c,2*h,qb,T.Q,T.K,T.V,O,lds); }
}
#undef SBAR
#undef WAIT_BAR
}
#define XB_TMO      128
#define XB_XCNT(j)  (256  + 64 * (j))
#define XB_XSUB(j)  (1280 + 64 * (j))
#define XB_XGEN(j)  (2304 + 64 * (j))
#define XB_TOP      3328
#define XB_TOPGEN   3392
#define XCD_BAR_WORDS 3456
#define XB_SPIN_CAP (1u << 18)

__device__ __forceinline__ unsigned xb_ld(unsigned* p)              { return __hip_atomic_load(p, __ATOMIC_RELAXED, __HIP_MEMORY_SCOPE_AGENT); }
__device__ __forceinline__ unsigned xb_add(unsigned* p, unsigned v) { return __hip_atomic_fetch_add(p, v, __ATOMIC_RELAXED, __HIP_MEMORY_SCOPE_AGENT); }
__device__ __forceinline__ unsigned xb_xcc_id() { return (unsigned)__builtin_amdgcn_s_getreg((3 << 11) | 20) & 0xFu; }
#define XB_SPIN(cond, bar) do { unsigned _sp = 0; while (cond) { __builtin_amdgcn_s_sleep(1); \
    if ((++_sp & 255u) == 0u) { if (xb_ld(&(bar)[XB_TMO])) break; if (_sp > XB_SPIN_CAP) { atomicAdd(&(bar)[XB_TMO], 1u); break; } } } } while (0)

struct XcdBarrier {
    unsigned* bar; unsigned x;
    int wave;
    volatile LAS unsigned* st;
};

__device__ __forceinline__ bool xb_thread0(int wave) { return wave == 0 && __builtin_amdgcn_mbcnt_hi(~0u, __builtin_amdgcn_mbcnt_lo(~0u, 0u)) == 0u; }
__device__ __forceinline__ XcdBarrier xcd_barrier_post(unsigned* bar, volatile LAS unsigned* st, int wave) {
    XcdBarrier b; b.bar = bar; b.x = xb_xcc_id(); b.st = st; b.wave = wave;
    if (xb_thread0(wave)) (void)xb_add(&bar[XB_XCNT(b.x)], 1u);
    return b;
}
__device__ __forceinline__ void xcd_barrier_complete(unsigned* bar, unsigned x, unsigned& nloc, unsigned& nx) {
    const unsigned G = gridDim.x * gridDim.y * gridDim.z;
    unsigned sum, cnt, mine, sp = 0u;
    for (;;) {
        sum = 0u; cnt = 0u; mine = 0u;
#pragma unroll
        for (unsigned j = 0; j < 16; ++j) { const unsigned c = xb_ld(&bar[XB_XCNT(j)]); sum += c; cnt += (c > 0u) ? 1u : 0u; mine = (j == x) ? c : mine; }
        if (sum == G) break;
        __builtin_amdgcn_s_sleep(1);
        if ((++sp & 255u) == 0u) { if (xb_ld(&bar[XB_TMO])) break; if (sp > XB_SPIN_CAP) { atomicAdd(&bar[XB_TMO], 1u); break; } }
    }
    nloc = mine > 0u ? mine : 1u; nx = cnt > 0u ? cnt : 1u;
}

__device__ __forceinline__ void xcd_barrier(const XcdBarrier& b) {
    asm volatile("s_waitcnt vmcnt(0)" ::: "memory");
    __syncthreads();
    if (xb_thread0(b.wave)) {
        unsigned* bar = b.bar;
        __builtin_amdgcn_s_waitcnt(0);
        unsigned nloc = b.st[0], nx = b.st[1];
        if (nloc == 0u) { xcd_barrier_complete(bar, b.x, nloc, nx); b.st[0] = nloc; b.st[1] = nx; }
        const unsigned old = xb_add(&bar[XB_XSUB(b.x)], 1u);
        const unsigned gen = old / nloc;
        if (old + 1u == (gen + 1u) * nloc) {
            __builtin_amdgcn_fence(__ATOMIC_RELEASE, "agent");
            asm volatile("s_waitcnt vmcnt(0)" ::: "memory");
            const unsigned og = xb_add(&bar[XB_TOP], 1u);
            const unsigned tg = og / nx;
            if (og + 1u == (tg + 1u) * nx) xb_add(&bar[XB_TOPGEN], 1u);
            else XB_SPIN(xb_ld(&bar[XB_TOPGEN]) == tg, bar);
            __builtin_amdgcn_fence(__ATOMIC_ACQUIRE, "agent");
            xb_add(&bar[XB_XGEN(b.x)], 1u);
            asm volatile("s_waitcnt vmcnt(0)" ::: "memory");
        } else {
            XB_SPIN(xb_ld(&bar[XB_XGEN(b.x)]) == gen, bar);
            __builtin_amdgcn_fence(__ATOMIC_ACQUIRE, "agent");
            asm volatile("s_waitcnt vmcnt(0)" ::: "memory");
        }
    }
    __syncthreads();
}
enum { I_X = 0, I_MEM, I_POS, I_AWIN, I_ALAM, I_ASUBG, I_AWOUT, I_BWIN, I_BQG, I_BKVG, I_BWUQ, I_BWQIDX, I_BWUK, I_BWUV, I_BWOUT, I_MEMWKV, I_XAWQ, I_XAWOUT,
       I_MWG, I_MBG, I_MWE, I_MBE, I_MWGATE, I_MWUP, I_MWDOWN, I_LNG, I_LNB, N_IN };
struct Frame {
    LAS unsigned char* lds;
    volatile LAS unsigned* MISC;
    gu32* ctl;
    unsigned char* ws;
    int vcu, G, wave;
    float* out;
};
#define CAS __attribute__((address_space(4)))
__device__ __forceinline__ const float* ld_in(int i) { const float* CAS const* tab = (const float* CAS const*)__builtin_amdgcn_kernarg_segment_ptr(); asm volatile("" : "+s"(tab)); return tab[i]; }
#define WSP(T_, off) ((T_*)(F.ws + (off)))
__device__ __forceinline__ int hw_lane() { int l; asm volatile("v_mbcnt_lo_u32_b32 %0, -1, 0\n\tv_mbcnt_hi_u32_b32 %0, -1, %0" : "=v"(l)); return l;     }
#define PHASE_IDS() const int wave = F.wave, lane = hw_lane(), tid = wave * 64 + lane; (void)tid; (void)lane; (void)wave

__device__ __forceinline__ void tr_item(const float* W, int ldw, int c0, int N, bf16* WT, int ldt, int row_off, int rs, const float* kscale, float cs, int cs_lim, LAS float* scr, int item, int lane) {
    const int nblk = (N + 31) / 32, kb = item / nblk, nb = item % nblk, k0 = 64 * kb, n0 = 32 * nb;
    if ((N & 3) == 0 && (ldw & 3) == 0 && (c0 & 3) == 0) {
        const int n4 = n0 + 4 * (lane & 7); const bool nok = n4 < N; const float csn = n4 < cs_lim ? cs : 1.0f; f32x4 v[8];
#pragma unroll
        for (int i = 0; i < 8; ++i) { const int kk = 8 * i + (lane >> 3); v[i] = nok ? *(const GAS f32x4*)(W + (size_t)(k0 + kk) * ldw + c0 + n4) : (f32x4){0.f, 0.f, 0.f, 0.f}; }
#pragma unroll
        for (int i = 0; i < 8; ++i) { const int kk = 8 * i + (lane >> 3); float sc = csn; if (kscale) sc *= kscale[k0 + kk];
#pragma unroll
            for (int e = 0; e < 4; ++e) scr[kk * 33 + 4 * (lane & 7) + e] = v[i][e] * sc; }
    } else {
    const int nl = n0 + (lane & 31); const bool nok = nl < N; const float csn = nl < cs_lim ? cs : 1.0f;
#pragma unroll 8
    for (int i = 0; i < 32; ++i) { const int kk = 2 * i + (lane >> 5); float v = 0.f;
        if (nok) { v = W[(size_t)(k0 + kk) * ldw + c0 + nl] * csn; if (kscale) v *= kscale[k0 + kk]; }
        scr[kk * 33 + (lane & 31)] = v; }
    }
    LDS_WAIT(); asm volatile("" ::: "memory");
    const int c = lane & 7;
#pragma unroll
    for (int j = 0; j < 4; ++j) { const int n = (lane >> 3) + 8 * j; const LAS float* s = scr + (8 * c) * 33 + n;
        v4u o; o.x = pk2(s[0 * 33], s[1 * 33]); o.y = pk2(s[2 * 33], s[3 * 33]); o.z = pk2(s[4 * 33], s[5 * 33]); o.w = pk2(s[6 * 33], s[7 * 33]);
        if (n0 + n < N) *(GAS v4u*)(WT + (size_t)(row_off + (n0 + n) * rs) * ldt + k0 + 8 * c) = o; }
    LDS_WAIT(); asm volatile("" ::: "memory");
}
#ifndef MK_REP
#define MK_REP 0ull
#endif
#define P0REP(b) (1 + (int)((MK_REP >> (b)) & 1ull))
__device__ __forceinline__ void p0_prologue(Frame& F) {
    PHASE_IDS();
    LAS float* scr = (LAS float*)(F.lds + RING_OFF + wave * 16384);
    const int gw = F.vcu * NWAVES + wave, NGW = F.G * NWAVES;
    constexpr int IT_QKV = 16 * 96, IT_O = 16 * 32, IT_MKV = 16 * 64, IT_XQ = 16 * 32, IT_BIN = 16 * 20, IT_G = 16 * 16, IT_D = 8 * 32, IT_QIDX = 4 * 32, IT_QR = 4 * 1;
    constexpr int N1 = IT_QKV, N2 = N1 + IT_O, N3 = N2 + IT_MKV, N4 = N3 + 2 * IT_XQ, N5 = N4 + 2 * IT_XQ, N6 = N5 + IT_BIN, N7 = N6 + IT_QIDX, N8 = N7 + 8 * IT_QR;
    constexpr int PER_E = 2 * IT_G + IT_D, NITEMS = N8 + 32 * PER_E;
    const float* lng = ld_in(I_LNG);
    for (int rp = 0; rp < P0REP(22); ++rp)
    for (int it = gw; it < NITEMS; it += NGW) {
        if (it < N1) tr_item(ld_in(I_AWIN), 3072, 0, 3072, WSP(bf16, W_QKV), 1024, 0, 1, nullptr, C2, 1024, scr, it, lane);
        else if (it < N2) tr_item(ld_in(I_AWOUT), 1024, 0, 1024, WSP(bf16, W_O), 1024, 0, 1, nullptr, 1.f, 0, scr, it - N1, lane);
        else if (it < N3) tr_item(ld_in(I_MEMWKV), 2048, 0, 2048, WSP(bf16, W_MKV), 1024, 0, 1, nullptr, 1.f, 0, scr, it - N2, lane);
        else if (it < N4) { }
        else if (it < N5) { const int l = (it - N4) / IT_XQ; tr_item(ld_in(I_XAWOUT) + (size_t)l * 1048576, 1024, 0, 1024, WSP(bf16, W_XO) + (size_t)l * 1048576, 1024, 0, 1, nullptr, 1.f, 0, scr, (it - N4) % IT_XQ, lane); }
        else if (it < N6) tr_item(ld_in(I_BWIN), BIN_W, 0, BIN_W, WSP(bf16, W_BIN), 1024, 0, 1, lng + 2 * 1024, 1.f, 0, scr, it - N5, lane);
        else if (it < N7) tr_item(ld_in(I_BWQIDX), 1024, 0, 1024, WSP(bf16, W_Q2), 256, 2304, 1, nullptr, 1.f, 0, scr, it - N6, lane);
        else if (it < N8) { const int h = (it - N7) / IT_QR; tr_item(ld_in(I_BWUQ), 1024, h * 128, 32, WSP(bf16, W_Q2), 256, 2048 + h * 32, 1, nullptr, SC2, 1 << 30, scr, (it - N7) % IT_QR, lane); }
        else { const int r = it - N8, le = r / PER_E, q = r % PER_E;
            if (q < IT_G) tr_item(ld_in(I_MWGATE) + (size_t)le * 524288, 512, 0, 512, WSP(bf16, W_GU) + (size_t)le * 1048576, 1024, 0, 2, nullptr, 1.f, 0, scr, q, lane);
            else if (q < 2 * IT_G) tr_item(ld_in(I_MWUP) + (size_t)le * 524288, 512, 0, 512, WSP(bf16, W_GU) + (size_t)le * 1048576, 1024, 1, 2, nullptr, 1.f, 0, scr, q - IT_G, lane);
            else tr_item(ld_in(I_MWDOWN) + (size_t)le * 524288, 1024, 0, 1024, WSP(bf16, W_DN) + (size_t)le * 524288, 512, 0, 1, nullptr, 1.f, 0, scr, q - 2 * IT_G, lane); }
    }
    for (int rp = 0; rp < P0REP(23); ++rp) {
        const float* wuq = ld_in(I_BWUQ); const float* wuk = ld_in(I_BWUK); bf16* dst = WSP(bf16, W_Q2);
        for (int it = gw; it < 8 * 4 * 64; it += NGW) { const int rb = it & 63, kb = (it >> 6) & 3, h = it >> 8, k = kb * 64 + lane;
            const float* a = wuq + (size_t)k * 1024 + h * 128 + 32; float av[96];
#pragma unroll
            for (int n = 0; n < 96; n += 4) { const f32x4 v = *(const GAS f32x4*)(a + n); av[n] = v[0]; av[n + 1] = v[1]; av[n + 2] = v[2]; av[n + 3] = v[3]; }
#pragma unroll 1
            for (int r = rb * 4; r < rb * 4 + 4; ++r) { const float* bb = wuk + ((size_t)h * 256 + r) * 96; float s = 0.f;
#pragma unroll
                for (int n = 0; n < 96; n += 16) { const f32x4 b0 = *(const GAS f32x4*)(bb + n), b1 = *(const GAS f32x4*)(bb + n + 4), b2 = *(const GAS f32x4*)(bb + n + 8), b3 = *(const GAS f32x4*)(bb + n + 12);
                    s += (av[n] * b0[0] + av[n + 1] * b0[1]) + (av[n + 2] * b0[2] + av[n + 3] * b0[3]); s += (av[n + 4] * b1[0] + av[n + 5] * b1[1]) + (av[n + 6] * b1[2] + av[n + 7] * b1[3]);
                    s += (av[n + 8] * b2[0] + av[n + 9] * b2[1]) + (av[n + 10] * b2[2] + av[n + 11] * b2[3]); s += (av[n + 12] * b3[0] + av[n + 13] * b3[1]) + (av[n + 14] * b3[2] + av[n + 15] * b3[3]);
                    asm volatile("" ::: "memory"); }
                dst[(size_t)(h * 256 + r) * 256 + k] = (bf16)f2bf(s * SC2); } }
        const float* wuv = ld_in(I_BWUV); const float* wo = ld_in(I_BWOUT); bf16* d2 = WSP(bf16, W_UVO);
        for (int it = gw; it < 8 * 32 * 16; it += NGW) { const int nb = it & 15, r8 = (it >> 4) & 31, h = it >> 9, n = nb * 64 + lane;
            const float* a = wuv + ((size_t)h * 256 + r8 * 8) * 128; const float* bb = wo + (size_t)(h * 128) * 1024 + n; float acc[8];
#pragma unroll
            for (int jr = 0; jr < 8; ++jr) acc[jr] = 0.f;
#pragma unroll 8
            for (int v = 0; v < 128; v += 4) { const float b0 = bb[(size_t)v * 1024], b1 = bb[(size_t)(v + 1) * 1024], b2 = bb[(size_t)(v + 2) * 1024], b3 = bb[(size_t)(v + 3) * 1024];
#pragma unroll
                for (int jr = 0; jr < 8; ++jr) { const f32x4 av = *(const GAS f32x4*)(a + jr * 128 + v); acc[jr] += (av[0] * b0 + av[1] * b1) + (av[2] * b2 + av[3] * b3); } }
#pragma unroll
            for (int jr = 0; jr < 8; ++jr) d2[(size_t)n * 2048 + h * 256 + r8 * 8 + jr] = (bf16)f2bf(acc[jr]); }
    }
    const int gt = F.vcu * (NWAVES * 64) + tid, NGT = F.G * NWAVES * 64;
    for (int rp = 0; rp < P0REP(24); ++rp) {   const GAS f32x4* x4 = (const GAS f32x4*)ld_in(I_X); GAS v4u* xb = (GAS v4u*)WSP(bf16, S_XB);
        for (int i0 = gt; i0 < T * D / 8; i0 += 4 * NGT) { f32x4 a[4], b[4];
#pragma unroll
            for (int u = 0; u < 4; ++u) { a[u] = x4[2 * (size_t)(i0 + u * NGT)]; b[u] = x4[2 * (size_t)(i0 + u * NGT) + 1]; }
#pragma unroll
            for (int u = 0; u < 4; ++u) { v4u o; o.x = pk2(a[u][0], a[u][1]); o.y = pk2(a[u][2], a[u][3]); o.z = pk2(b[u][0], b[u][1]); o.w = pk2(b[u][2], b[u][3]); xb[i0 + u * NGT] = o; } }
        const GAS f32x4* m4 = (const GAS f32x4*)ld_in(I_MEM); GAS v4u* mb = (GAS v4u*)WSP(bf16, WS_MEMB);
        for (int i = gt; i < MEMROWS * D / 8; i += NGT) { const f32x4 a = m4[2 * (size_t)i], b = m4[2 * (size_t)i + 1]; v4u o; o.x = pk2(a[0], a[1]); o.y = pk2(a[2], a[3]); o.z = pk2(b[0], b[1]); o.w = pk2(b[2], b[3]); mb[i] = o; }
        { const GAS f32x4* q4 = (const GAS f32x4*)ld_in(I_XAWQ); GAS v4u* qb = (GAS v4u*)WSP(bf16, W_XQ); const float* lg = ld_in(I_LNG);
          for (int i = gt; i < 2 * 1024 * 1024 / 8; i += NGT) { const int l = i >> 17, k = (i >> 7) & 1023; const float sc = lg[(l * 3 + 0) * 1024 + k] * XQS; const f32x4 a = q4[2 * (size_t)i] * sc, b = q4[2 * (size_t)i + 1] * sc;
              v4u o; o.x = pk2(a[0], a[1]); o.y = pk2(a[2], a[3]); o.z = pk2(b[0], b[1]); o.w = pk2(b[2], b[3]); qb[i] = o; } }
        GAS v4u* zb = (GAS v4u*)(WSP(bf16, W_BIN) + (size_t)BIN_W * 1024);
        for (int i = gt; i < (BIN_LD - BIN_W) * 1024 / 8; i += NGT) zb[i] = (v4u){0u, 0u, 0u, 0u};
    }
    for (int rp = 0; rp < P0REP(25); ++rp) {   const int* pos = (const int*)ld_in(I_POS); float* r16 = WSP(float, WS_ROT16); float* r32 = WSP(float, WS_ROT32);
        for (int i = gt; i < T * 24; i += NGT) { const int t = i / 24, q = i % 24; const int jj = q < 8 ? 2 * q : q - 8;
            const double invf = exp2(-(double)jj * 1.1832230355827609), ang = (double)pos[t] * invf, n = rint(ang * 0.15915494309189535), red = fma(-n, 6.283185307179586, ang);
            const float rf = (float)red, c = cosf(rf), s = sinf(rf);
            float* d = q < 8 ? r16 + (size_t)t * 16 + q * 2 : r32 + (size_t)t * 32 + (q - 8) * 2; d[0] = c; d[1] = s; }
    }
    if (gt == 0) { const float* lam = ld_in(I_ALAM); float s01 = 0.f, s23 = 0.f; for (int i = 0; i < 64; ++i) { s01 += lam[i] * lam[64 + i]; s23 += lam[128 + i] * lam[192 + i]; }
        WSP(float, WS_SMALL)[SM_LAM] = expf(s01) - expf(s23) + 0.2f; }
}
__device__ __forceinline__ void fold_vectors(Frame& F) {
    PHASE_IDS();
    const int gw = F.vcu * NWAVES + wave, NGW = F.G * NWAVES;
    for (int it = gw; it < 3 * 1024; it += NGW) { const int f = it >> 10, n = it & 1023;
        const bf16* wt = f < 2 ? WSP(bf16, W_XQ) + (size_t)f * 1048576 : WSP(bf16, W_BIN);
        const float* w = f < 2 ? ld_in(I_XAWQ) + (size_t)f * 1048576 : ld_in(I_BWIN); const int ldw = f < 2 ? 1024 : BIN_W, nv = f < 2 ? 1024 : BIN_W;
        const float* bb = ld_in(I_LNB) + (f < 2 ? (f * 3 + 0) * 1024 : 2 * 1024); const float cs = f < 2 ? XQS : 1.0f;
        float* dst = WSP(float, WS_SMALL) + SM_GW + f * 2048;
        float sg = 0.f, sb = 0.f;
        if (n < nv) { v4u a = (v4u){0u, 0u, 0u, 0u}, b = a; if (f == 2) { a = *(const GAS v4u*)(wt + (size_t)n * 1024 + lane * 16); b = *(const GAS v4u*)(wt + (size_t)n * 1024 + lane * 16 + 8); }
            sg = ((bflo(a.x) + bfhi(a.x)) + (bflo(a.y) + bfhi(a.y))) + ((bflo(a.z) + bfhi(a.z)) + (bflo(a.w) + bfhi(a.w))) + ((bflo(b.x) + bfhi(b.x)) + (bflo(b.y) + bfhi(b.y))) + ((bflo(b.z) + bfhi(b.z)) + (bflo(b.w) + bfhi(b.w)));
            for (int k = lane; k < 1024; k += 64) sb += bb[k] * w[(size_t)k * ldw + n]; }
        sg = wave_sum(sg); sb = wave_sum(sb) * cs;
        if (lane == 0) { dst[n] = sg; dst[1024 + n] = sb; } }
}

__device__ __forceinline__ void diff_combine(Frame& F) {
    PHASE_IDS();
    const int gw = F.vcu * NWAVES + wave, NGW = F.G * NWAVES;
    const float lam = WSP(float, WS_SMALL)[SM_LAM]; const float* sg = ld_in(I_ASUBG);
    float gv[16];
#pragma unroll
    for (int i = 0; i < 16; ++i) gv[i] = sg[(lane & 7) * 16 + i] * 0.8f;
    const bf16* O0 = WSP(bf16, S_O0); const bf16* O1 = WSP(bf16, S_O1); bf16* ON = WSP(bf16, S_ON);
    constexpr int RB = 4;
    for (int m0 = gw; m0 < T; m0 += RB * NGW) {
        v4u a0v[RB], a1v[RB], b0v[RB], b1v[RB];
#pragma unroll
        for (int u = 0; u < RB; ++u) { const size_t mo = (size_t)(m0 + u * NGW) * 1024 + lane * 16;
            a0v[u] = *(const GAS v4u*)(O0 + mo); a1v[u] = *(const GAS v4u*)(O0 + mo + 8); b0v[u] = *(const GAS v4u*)(O1 + mo); b1v[u] = *(const GAS v4u*)(O1 + mo + 8); }
#pragma unroll
        for (int u = 0; u < RB; ++u) { const int m = m0 + u * NGW; const v4u a0 = a0v[u], a1 = a1v[u], b0 = b0v[u], b1 = b1v[u];
        const unsigned aw[8] = {a0.x, a0.y, a0.z, a0.w, a1.x, a1.y, a1.z, a1.w}, bw[8] = {b0.x, b0.y, b0.z, b0.w, b1.x, b1.y, b1.z, b1.w};
        float o[16]; float ss = 0.f;
#pragma unroll
        for (int i = 0; i < 8; ++i) { o[2 * i] = bflo(aw[i]) - lam * bflo(bw[i]); o[2 * i + 1] = bfhi(aw[i]) - lam * bfhi(bw[i]); ss += o[2 * i] * o[2 * i] + o[2 * i + 1] * o[2 * i + 1]; }
        ss += __shfl_xor(ss, 1); ss += __shfl_xor(ss, 2); ss += __shfl_xor(ss, 4);
        const float r = 1.0f / sqrtf(ss * (1.0f / 128.0f) + LN_EPS);
        v4u w0, w1;
        w0.x = pk2(o[0] * r * gv[0], o[1] * r * gv[1]); w0.y = pk2(o[2] * r * gv[2], o[3] * r * gv[3]); w0.z = pk2(o[4] * r * gv[4], o[5] * r * gv[5]); w0.w = pk2(o[6] * r * gv[6], o[7] * r * gv[7]);
        w1.x = pk2(o[8] * r * gv[8], o[9] * r * gv[9]); w1.y = pk2(o[10] * r * gv[10], o[11] * r * gv[11]); w1.z = pk2(o[12] * r * gv[12], o[13] * r * gv[13]); w1.w = pk2(o[14] * r * gv[14], o[15] * r * gv[15]);
        *(GAS v4u*)(ON + (size_t)m * 1024 + lane * 16) = w0; *(GAS v4u*)(ON + (size_t)m * 1024 + lane * 16 + 8) = w1; }
    }
}

__device__ __forceinline__ void moe_route(Frame& F, int layer) {
    PHASE_IDS();
    const int gw = F.vcu * NWAVES + wave, NGW = F.G * NWAVES;
    LAS float* wl = (LAS float*)(F.lds + RING_OFF);
    { const float* wg = ld_in(I_MWG) + (size_t)layer * 1024 * 4; const float* we = ld_in(I_MWE) + (size_t)layer * 1024 * 16;
      float tg[8], te[32];
#pragma unroll
      for (int k = 0; k < 8; ++k) tg[k] = wg[tid + k * (NWAVES * 64)];
#pragma unroll
      for (int k = 0; k < 32; ++k) te[k] = we[tid + k * (NWAVES * 64)];
#pragma unroll
      for (int k = 0; k < 8; ++k) { const int i = tid + k * (NWAVES * 64); wl[(i & 3) * 1024 + (i >> 2)] = tg[k]; }
#pragma unroll
      for (int k = 0; k < 32; ++k) { const int i = tid + k * (NWAVES * 64); wl[(4 + (i & 15)) * 1024 + (i >> 4)] = te[k]; } }
    LAS unsigned* lcnt = (LAS unsigned*)(F.lds + RING_OFF + 81920);
    if (tid < 16) lcnt[tid] = 0u;
    __syncthreads();
    const bf16* preb = WSP(bf16, WS_PREB); const float* g = ld_in(I_LNG) + (layer * 3 + 1) * 1024; const float* b = ld_in(I_LNB) + (layer * 3 + 1) * 1024;
    const float* bg = ld_in(I_MBG) + layer * 4; const float* be = ld_in(I_MBE) + layer * 16;
    f32x4 gl[4], bl[4];
#pragma unroll
    for (int j = 0; j < 4; ++j) { gl[j] = *(const f32x4*)(g + 256 * j + 4 * lane); bl[j] = *(const f32x4*)(b + 256 * j + 4 * lane); }
    bf16* XH = WSP(bf16, S_XH); f32x2* statf = WSP(f32x2, WS_STATF); int* route = WSP(int, WS_ROUTE); f32x2* routew = WSP(f32x2, WS_ROUTEW);
    gu32* cnt = F.ctl + CW_CNT + layer * 16 * 64;
    constexpr int RB = 4;
    auto rows_load = [&](v2u (&r)[RB][4], const int m0) __attribute__((always_inline)) {
#pragma unroll
        for (int u = 0; u < RB; ++u) { const bf16* xr = preb + (size_t)(m0 + u * NGW) * 1024 + 4 * lane;
#pragma unroll
            for (int j = 0; j < 4; ++j) r[u][j] = *(const GAS v2u*)(xr + 256 * j); } };
    auto rows_body = [&](v2u (&r)[RB][4], const int m0) __attribute__((always_inline)) {
        float mean[RB], rstd[RB]; f32x4 v[RB][4];
#pragma unroll
        for (int u = 0; u < RB; ++u)
#pragma unroll
            for (int j = 0; j < 4; ++j) v[u][j] = (f32x4){bflo(r[u][j].x), bfhi(r[u][j].x), bflo(r[u][j].y), bfhi(r[u][j].y)};
#pragma unroll
        for (int u = 0; u < RB; ++u) { float s = 0.f;
#pragma unroll
            for (int j = 0; j < 4; ++j) s += (v[u][j][0] + v[u][j][1]) + (v[u][j][2] + v[u][j][3]);
            mean[u] = wave_sum(s) * (1.f / 1024.f); }
#pragma unroll
        for (int u = 0; u < RB; ++u) { float s2 = 0.f;
#pragma unroll
            for (int j = 0; j < 4; ++j) { v[u][j] = v[u][j] - mean[u]; s2 += (v[u][j][0] * v[u][j][0] + v[u][j][1] * v[u][j][1]) + (v[u][j][2] * v[u][j][2] + v[u][j][3] * v[u][j][3]); }
            rstd[u] = 1.f / sqrtf(wave_sum(s2) * (1.f / 1024.f) + LN_EPS); }
#pragma unroll
        for (int u = 0; u < RB; ++u) { const int m = m0 + u * NGW;
#pragma unroll
            for (int j = 0; j < 4; ++j) { v[u][j] = v[u][j] * rstd[u] * gl[j] + bl[j];
                v2u w; w.x = pk2(v[u][j][0], v[u][j][1]); w.y = pk2(v[u][j][2], v[u][j][3]); *(GAS v2u*)(XH + (size_t)m * 1024 + 256 * j + 4 * lane) = w; } }
        float gq[RB][4];
#pragma unroll
        for (int o = 0; o < 4; ++o) { f32x4 w[4];
#pragma unroll
            for (int j = 0; j < 4; ++j) w[j] = *(const LAS f32x4*)(wl + o * 1024 + 256 * j + 4 * lane);
#pragma unroll
            for (int u = 0; u < RB; ++u) { float p = 0.f;
#pragma unroll
                for (int j = 0; j < 4; ++j) p += (v[u][j][0] * w[j][0] + v[u][j][1] * w[j][1]) + (v[u][j][2] * w[j][2] + v[u][j][3] * w[j][3]);
                gq[u][o] = wave_sum(p) + bg[o]; } }
#pragma unroll
        for (int u = 0; u < RB; ++u) { const int m = m0 + u * NGW;
            const float g0 = gq[u][0], g1 = gq[u][1], g2 = gq[u][2], g3 = gq[u][3];
            int gs = 0; float gm = g0; if (g1 > gm) { gm = g1; gs = 1; } if (g2 > gm) { gm = g2; gs = 2; } if (g3 > gm) { gm = g3; gs = 3; }
            const float gate = __builtin_amdgcn_rcpf(__builtin_amdgcn_exp2f((g0 - gm) * LOG2E) + __builtin_amdgcn_exp2f((g1 - gm) * LOG2E) + __builtin_amdgcn_exp2f((g2 - gm) * LOG2E) + __builtin_amdgcn_exp2f((g3 - gm) * LOG2E));
            gs = __builtin_amdgcn_readfirstlane(gs);
            float e[4];
#pragma unroll
            for (int o = 0; o < 4; ++o) { float p = 0.f; const LAS float* wp = wl + (4 + gs * 4 + o) * 1024;
#pragma unroll
                for (int j = 0; j < 4; ++j) { const f32x4 w = *(const LAS f32x4*)(wp + 256 * j + 4 * lane); p += (v[u][j][0] * w[0] + v[u][j][1] * w[1]) + (v[u][j][2] * w[2] + v[u][j][3] * w[3]); }
                e[o] = wave_sum(p) + be[gs * 4 + o]; }
            int i1 = 0; float v1 = e[0]; if (e[1] > v1) { v1 = e[1]; i1 = 1; } if (e[2] > v1) { v1 = e[2]; i1 = 2; } if (e[3] > v1) { v1 = e[3]; i1 = 3; }
            int i2 = -1; float v2 = -INFINITY;
#pragma unroll
            for (int i = 0; i < 4; ++i) if (i != i1 && (i2 < 0 || e[i] > v2)) { v2 = e[i]; i2 = i; }
            const float e2 = __builtin_amdgcn_exp2f((v2 - v1) * LOG2E), w1 = gate * __builtin_amdgcn_rcpf(1.0f + e2), w2 = gate - w1;
            if (lane == 0) { const int ea = gs * 4 + i1, eb = gs * 4 + i2;
                const int pa = (int)__hip_atomic_fetch_add(lcnt + ea, 1u, __ATOMIC_RELAXED, __HIP_MEMORY_SCOPE_WORKGROUP), pb = (int)__hip_atomic_fetch_add(lcnt + eb, 1u, __ATOMIC_RELAXED, __HIP_MEMORY_SCOPE_WORKGROUP);
                *(GAS v4i*)(route + (size_t)m * 4) = (v4i){ea, eb, pa, pb}; routew[m] = (f32x2){w1, w2}; statf[m] = (f32x2){mean[u], rstd[u]}; } }
        };
    v2u va[RB][4], vb[RB][4];
    rows_load(va, gw);
    for (int m0 = gw; m0 < T; m0 += 2 * RB * NGW) { const int m1 = m0 + RB * NGW, m2 = m0 + 2 * RB * NGW;
        if (m1 < T) rows_load(vb, m1);
        rows_body(va, m0);
        if (m1 < T) { if (m2 < T) rows_load(va, m2); rows_body(vb, m1); }
    }
    __syncthreads();
    if (tid < 16) WSP(int, WS_WGB)[F.vcu * 16 + tid] = (int)__hip_atomic_fetch_add(cnt + tid * 64, lcnt[tid], RLX_AGENT);
}
__device__ __forceinline__ void moe_index(Frame& F, int layer) {
    PHASE_IDS();
    gu32* cnt = F.ctl + CW_CNT + layer * 16 * 64;
    int c[16], off[16]; int acc = 0;
#pragma unroll
    for (int e = 0; e < 16; ++e) { c[e] = (int)__hip_atomic_load(cnt + e * 64, RLX_AGENT); off[e] = acc; acc += ((c[e] + 255) >> 8) << 8; }
    int* rowidx = WSP(int, WS_ROWIDX); float* wsort = WSP(float, WS_WSORT); int* tile_e = WSP(int, WS_TILEE); int* pos2 = WSP(int, WS_POS2);
    const int* route = WSP(int, WS_ROUTE); const f32x2* routew = WSP(f32x2, WS_ROUTEW);
    const int gt = F.vcu * (NWAVES * 64) + tid, NGT = F.G * NWAVES * 64;
    for (int t = gt; t < T; t += NGT) { const v4i r = *(const GAS v4i*)(route + (size_t)t * 4); const f32x2 w = routew[t];
        int oa = 0, ob = 0;
#pragma unroll
        for (int e = 0; e < 16; ++e) { oa = r[0] == e ? off[e] : oa; ob = r[1] == e ? off[e] : ob; }
        const int* wgb = WSP(int, WS_WGB) + ((t & (F.G * NWAVES - 1)) >> 3) * 16;
        const int ra = oa + wgb[r[0]] + r[2], rb = ob + wgb[r[1]] + r[3];
        rowidx[ra] = t; wsort[ra] = w[0]; rowidx[rb] = t; wsort[rb] = w[1]; pos2[2 * t] = ra; pos2[2 * t + 1] = rb; }
    if (F.vcu == 0) {
#pragma unroll
        for (int e = 0; e < 16; ++e) { const int pad = (((c[e] + 255) >> 8) << 8) - c[e];
            for (int i = tid; i < pad; i += NWAVES * 64) { rowidx[off[e] + c[e] + i] = 0; wsort[off[e] + c[e] + i] = 0.f; }
            for (int i = tid; i < ((c[e] + 255) >> 8); i += NWAVES * 64) tile_e[16 + (off[e] >> 8) + i] = e; }
        if (tid == 0) tile_e[0] = acc >> 8;
    }
}
struct MoeOrder {
    const int* tile_e; int ntiles, G, c; long wstride; int nn;
    __device__ bool next(int i, pg8::Unit& u) const {
        const long L = (long)i * G + c; if (L >= (long)ntiles * nn) return false;
        const int rt = (int)(L / nn), pn = (int)(L % nn), e = tile_e[16 + rt];
        u.pm = rt; u.pn = pn; u.e = e; u.aoff = 0; u.boff = (long)e * wstride + (long)pn * 256 * (wstride / 1024); return true;
    }
};
__device__ __forceinline__ void moe_combine(Frame& F, int layer) {
    PHASE_IDS();
    const int gw = F.vcu * NWAVES + wave, NGW = F.G * NWAVES;
    float* pre = F.out; const float* g = ld_in(I_LNG) + (layer * 3 + 1) * 1024; const float* b = ld_in(I_LNB) + (layer * 3 + 1) * 1024;
    const float* g2 = ld_in(I_LNG) + (layer * 3 + 2) * 1024; const float* b2 = ld_in(I_LNB) + (layer * 3 + 2) * 1024;
    const f32x2* statf = WSP(f32x2, WS_STATF); const int* pos2 = WSP(int, WS_POS2); const bf16* Y = WSP(bf16, S_Y);
    bf16* preb = WSP(bf16, WS_PREB); float* stat_new = WSP(float, WS_STAT) + (size_t)((layer * 3 + 2) & 1) * T * 32;
    constexpr int RB = 4;
    for (int m0 = gw; m0 < T; m0 += RB * NGW) {
        v2u xv[RB][4]; v2u ya[RB][4], yb[RB][4]; f32x2 st[RB];
#pragma unroll
        for (int u = 0; u < RB; ++u) { const int m = m0 + u * NGW; st[u] = statf[m]; const int ra = pos2[2 * m], rb = pos2[2 * m + 1];
#pragma unroll
            for (int j = 0; j < 4; ++j) { xv[u][j] = *(const GAS v2u*)(preb + (size_t)m * 1024 + 256 * j + 4 * lane); ya[u][j] = *(const GAS v2u*)(Y + (size_t)ra * 1024 + 256 * j + 4 * lane); yb[u][j] = *(const GAS v2u*)(Y + (size_t)rb * 1024 + 256 * j + 4 * lane); } }
#pragma unroll
        for (int u = 0; u < RB; ++u) { const int m = m0 + u * NGW;
        GAS f32x4* xr = (GAS f32x4*)(pre + (size_t)m * 1024) + lane;
        f32x4 v[4]; float s = 0.f, s2 = 0.f;
#pragma unroll
        for (int j = 0; j < 4; ++j) { const f32x4 gj = *(const f32x4*)(g + 256 * j + 4 * lane), bj = *(const f32x4*)(b + 256 * j + 4 * lane);
            const f32x4 xf = (f32x4){bflo(xv[u][j].x), bfhi(xv[u][j].x), bflo(xv[u][j].y), bfhi(xv[u][j].y)};
            const f32x4 h = (xf - st[u][0]) * st[u][1] * gj + bj;
            const f32x4 y = (f32x4){bflo(ya[u][j].x) + bflo(yb[u][j].x), bfhi(ya[u][j].x) + bfhi(yb[u][j].x), bflo(ya[u][j].y) + bflo(yb[u][j].y), bfhi(ya[u][j].y) + bfhi(yb[u][j].y)};
            v[j] = h * ALPHA + y; s += (v[j][0] + v[j][1]) + (v[j][2] + v[j][3]); s2 += (v[j][0] * v[j][0] + v[j][1] * v[j][1]) + (v[j][2] * v[j][2] + v[j][3] * v[j][3]); }
        if (layer == 0) {
#pragma unroll
            for (int j = 0; j < 4; ++j) { v2u w; w.x = pk2(v[j][0], v[j][1]); w.y = pk2(v[j][2], v[j][3]); *(GAS v2u*)(preb + (size_t)m * 1024 + 256 * j + 4 * lane) = w; }
            s = wave_sum(s); s2 = wave_sum(s2);
            if (lane < 16) *(GAS f32x2*)(stat_new + (size_t)m * 32 + lane * 2) = lane == 0 ? (f32x2){s, s2} : (f32x2){0.f, 0.f};
        } else {
            const float mean = wave_sum(s) * (1.f / 1024.f); float q = 0.f;
#pragma unroll
            for (int j = 0; j < 4; ++j) { v[j] = v[j] - mean; q += (v[j][0] * v[j][0] + v[j][1] * v[j][1]) + (v[j][2] * v[j][2] + v[j][3] * v[j][3]); }
            const float rstd = 1.f / sqrtf(wave_sum(q) * (1.f / 1024.f) + LN_EPS);
#pragma unroll
            for (int j = 0; j < 4; ++j) { const f32x4 gj = *(const f32x4*)(g2 + 256 * j + 4 * lane), bj = *(const f32x4*)(b2 + 256 * j + 4 * lane); xr[64 * j] = v[j] * rstd * gj + bj; }
        } }
    }
}
__device__ __forceinline__ void dsa_prep(Frame& F) {
    PHASE_IDS();
    const int gw = F.vcu * NWAVES + wave, NGW = F.G * NWAVES;
    const bf16* bin = WSP(bf16, S_BIN); bf16* cq = WSP(bf16, S_CQ); bf16* kvl = WSP(bf16, S_KVL); bf16* kidx = WSP(bf16, S_KIDX); float* widx = WSP(float, S_WIDX);
    const float* r16 = WSP(float, WS_ROT16); const float* r32 = WSP(float, WS_ROT32);
    const f32x4 gq = *(const f32x4*)(ld_in(I_BQG) + 4 * lane), gk = *(const f32x4*)(ld_in(I_BKVG) + 4 * lane);
    constexpr int RB = 4;
    for (int m0 = gw; m0 < T; m0 += RB * NGW) {
        f32x4 av[RB], cv[RB]; float x1v[RB], x2v[RB], c32v[RB], s32v[RB], xkv[RB], pkv[RB], c16v[RB], s16v[RB], wwv[RB];
#pragma unroll
        for (int u = 0; u < RB; ++u) { const int m = m0 + u * NGW; const bf16* row = bin + (size_t)m * BIN_LD;
            { const v2u aw = *(const GAS v2u*)(row + 4 * lane), cw = *(const GAS v2u*)(row + 256 + 4 * lane);
              av[u] = (f32x4){bflo(aw.x), bfhi(aw.x), bflo(aw.y), bfhi(aw.y)}; cv[u] = (f32x4){bflo(cw.x), bfhi(cw.x), bflo(cw.y), bfhi(cw.y)}; }
            x1v[u] = bf2f(row[512 + (lane & 15)]); x2v[u] = bf2f(row[528 + (lane & 15)]); c32v[u] = r32[(size_t)m * 32 + 2 * (lane & 15)]; s32v[u] = r32[(size_t)m * 32 + 2 * (lane & 15) + 1];
            xkv[u] = bf2f(row[544 + lane]); pkv[u] = bf2f(row[544 + ((lane ^ 8) & 63)]); c16v[u] = r16[(size_t)m * 16 + 2 * (lane & 7)]; s16v[u] = r16[(size_t)m * 16 + 2 * (lane & 7) + 1]; wwv[u] = bf2f(row[608 + (lane & 15)]); }
#pragma unroll
        for (int u = 0; u < RB; ++u) { const int m = m0 + u * NGW; const f32x4 a = av[u], c = cv[u];
        const float sa = wave_sum((a[0] * a[0] + a[1] * a[1]) + (a[2] * a[2] + a[3] * a[3])), sc = wave_sum((c[0] * c[0] + c[1] * c[1]) + (c[2] * c[2] + c[3] * c[3]));
        const float ra = 1.f / sqrtf(sa * (1.f / 256.f) + LN_EPS), rc = 1.f / sqrtf(sc * (1.f / 256.f) + LN_EPS);
        v2u w; w.x = pk2(a[0] * ra * gq[0], a[1] * ra * gq[1]); w.y = pk2(a[2] * ra * gq[2], a[3] * ra * gq[3]); *(GAS v2u*)(cq + (size_t)m * 256 + 4 * lane) = w;
        w.x = pk2(c[0] * rc * gk[0], c[1] * rc * gk[1]); w.y = pk2(c[2] * rc * gk[2], c[3] * rc * gk[3]); *(GAS v2u*)(kvl + (size_t)m * KVW + 4 * lane) = w;
        if (lane < 16) { const float x1 = x1v[u], x2 = x2v[u], cs = c32v[u], sn = s32v[u];
            kvl[(size_t)m * KVW + 256 + lane] = (bf16)f2bf(x1 * cs - x2 * sn); kvl[(size_t)m * KVW + 272 + lane] = (bf16)f2bf(x2 * cs + x1 * sn); }
        { const float x = xkv[u]; float o = x; const float p = pkv[u];
          if (lane < 16) { const float cs = c16v[u], sn = s16v[u]; o = lane < 8 ? x * cs - p * sn : x * cs + p * sn; }
          kidx[(size_t)m * 64 + lane] = (bf16)f2bf(o); }
        if (lane < 16) widx[(size_t)m * 16 + lane] = wwv[u] * 0.03125f; }
    }
    for (int i = F.vcu * (NWAVES * 64) + tid; i < NB * 256 * TOPK; i += F.G * NWAVES * 64) { const int bb = i >> 16, s = (i >> 8) & 255, j = i & 255; WSP(unsigned short, S_IDX)[((size_t)bb * SEQ + s) * TOPK + j] = (unsigned short)j; }
}
struct bfrx { bf16x8 f[4]; };
__device__ __forceinline__ float relu_s(float x) { float r; asm("v_max_f32_e32 %0, 0, %1" : "=v"(r) : "v"(x)); return r; }
__device__ __forceinline__ float fma_s(float a, float b, float c) { float r; asm("v_fma_f32 %0, %1, %2, %3" : "=v"(r) : "v"(a), "v"(b), "v"(c)); return r; }
__device__ __forceinline__ void lds_add(LAS unsigned* p, unsigned v) { asm volatile("ds_add_u32 %0, %1" :: "v"((unsigned)(unsigned long)p), "v"(v) : "memory"); }
__device__ __forceinline__ unsigned pk_max_u16(unsigned a, unsigned b) { unsigned r; asm("v_pk_max_u16 %0, %1, %2" : "=v"(r) : "v"(a), "v"(b)); return r; }
__device__ __forceinline__ unsigned pk_min_u16(unsigned a, unsigned b) { unsigned r; asm("v_pk_min_u16 %0, %1, %2" : "=v"(r) : "v"(a), "v"(b)); return r; }
template <int CTRL> __device__ __forceinline__ unsigned dpp_u(unsigned x) { return (unsigned)__builtin_amdgcn_update_dpp((int)x, (int)x, CTRL, 0xf, 0xf, false); }
__device__ __forceinline__ unsigned half_min_pk(unsigned x) {
    x = pk_min_u16(x, dpp_u<0xB1>(x)); x = pk_min_u16(x, dpp_u<0x4E>(x)); x = pk_min_u16(x, dpp_u<0x141>(x)); x = pk_min_u16(x, dpp_u<0x140>(x));
    return pk_min_u16(x, (unsigned)__shfl_xor((int)x, 16));
}
__device__ __forceinline__ float relu_v(float x) { float r; asm volatile("v_max_f32_e32 %0, 0, %1" : "=v"(r) : "v"(x)); return r; }
__device__ __forceinline__ float fma_v(float a, float b, float c) { float r; asm volatile("v_fma_f32 %0, %1, %2, %3" : "=v"(r) : "v"(a), "v"(b), "v"(c)); return r; }
__device__ __forceinline__ unsigned fkey(float x) { const unsigned u = __float_as_uint(x + 0.0f); return (u & 0x80000000u) ? ~u : (u | 0x80000000u); }
__device__ __forceinline__ unsigned wave_excl_prefix(unsigned x, int lane, unsigned& total) {
    unsigned v = x;
#pragma unroll
    for (int d = 1; d < 64; d <<= 1) { const unsigned y = __shfl_up(v, d); if (lane >= d) v += y; }
    total = (unsigned)__builtin_amdgcn_readlane((int)v, 63); return v - x;
}
template <int NP>
__device__ __forceinline__ void topk16_select(const unsigned short* sc16, int n, unsigned short* out, LAS unsigned* h0, LAS unsigned* hw, LAS unsigned short* cidx, LAS float* csc,
                                              const bf16* qrow, const bf16* KI, const float* wrow, int lane, const unsigned th16) {
    unsigned kp[NP * 4];
    int l8 = 8 * lane;
#pragma unroll
    for (int i = 0; i < NP; ++i) { const v4u v = *(const GAS v4u*)(sc16 + 512 * i + 8 * lane);
        if ((i & 3) == 0) asm volatile("" : "+v"(l8));
        const unsigned m = (512 * i + l8 < n) ? 0xffffffffu : 0u;
        kp[4 * i] = v.x & m; kp[4 * i + 1] = v.y & m; kp[4 * i + 2] = v.z & m; kp[4 * i + 3] = v.w & m; }
    const unsigned ninv = (unsigned)(NP * 512 - n);
    unsigned want = TOPK, T = 0u;
#pragma unroll
    for (int pass = 0; pass < 2; ++pass) {
        LAS unsigned* hist = pass == 0 ? h0 : hw;
        if (pass == 1) {
            *(LAS v4u*)(hw + 4 * lane) = (v4u){0u, 0u, 0u, 0u};
            LDS_WAIT();
#pragma unroll
            for (int i = 0; i < NP * 4; ++i) {
#pragma unroll
                for (int hf = 0; hf < 2; ++hf) { const unsigned k = hf ? kp[i] >> 16 : kp[i] & 0xffffu;
                    if ((k >> 8) == T && k >= th16) __hip_atomic_fetch_add(hw + (k & 255u), 1u, __ATOMIC_RELAXED, __HIP_MEMORY_SCOPE_WORKGROUP); } }
            LDS_WAIT();
        }
        v4u c4;
        if (pass == 0) {
            const v4u a = *(const LAS v4u*)(h0 + 8 * lane), e = *(const LAS v4u*)(h0 + 8 * lane + 4);
            c4.x = ((a.x & 0xffffu) + (a.y & 0xffffu)) + ((a.z & 0xffffu) + (a.w & 0xffffu)); c4.y = ((a.x >> 16) + (a.y >> 16)) + ((a.z >> 16) + (a.w >> 16));
            c4.z = ((e.x & 0xffffu) + (e.y & 0xffffu)) + ((e.z & 0xffffu) + (e.w & 0xffffu)); c4.w = ((e.x >> 16) + (e.y >> 16)) + ((e.z >> 16) + (e.w >> 16));
        } else c4 = *(const LAS v4u*)(hist + 4 * lane);
        const unsigned tl = c4.x + c4.y + c4.z + c4.w; unsigned S = tl;
#pragma unroll
        for (int d = 1; d < 64; d <<= 1) { const unsigned v = __shfl_down(S, d); if (lane + d < 64) S += v; }
        const unsigned long long bal = __ballot(S >= want);
        const int L = 63 - __clzll(bal | 1ull);
        const unsigned above = __shfl(S - tl, L), c1 = __shfl(c4.y, L), c2 = __shfl(c4.z, L), c3 = __shfl(c4.w, L);
        unsigned cum = above; int d;
        if (cum + c3 >= want) d = 3; else { cum += c3; if (cum + c2 >= want) d = 2; else { cum += c2; if (cum + c1 >= want) d = 1; else { cum += c1; d = 0; } } }
        want -= cum; T = pass == 0 ? (unsigned)(4 * L + d) : ((T << 8) | (unsigned)(4 * L + d));
    }
    if (lane == 0) { hw[0] = 0u; hw[1] = 0u; }
    LDS_WAIT();
    int l4 = 8 * lane;
#pragma unroll
    for (int i = 0; i < NP * 4; ++i) { if ((i & 7) == 0) asm volatile("" : "+v"(l4));
#pragma unroll
        for (int hf = 0; hf < 2; ++hf) { const unsigned k = hf ? kp[i] >> 16 : kp[i] & 0xffffu; const int idx = 512 * (i >> 2) + l4 + 2 * (i & 3) + hf;
            if (k >= T) {
                if (k > T) { const unsigned pos = __hip_atomic_fetch_add(hw, 1u, __ATOMIC_RELAXED, __HIP_MEMORY_SCOPE_WORKGROUP); out[pos] = (unsigned short)idx; }
                else { const unsigned cp = __hip_atomic_fetch_add(hw + 1, 1u, __ATOMIC_RELAXED, __HIP_MEMORY_SCOPE_WORKGROUP); if (cp < 512u) cidx[cp] = (unsigned short)idx; } } }
        if ((i & 7) == 7) asm volatile("" ::: "memory"); }
    LDS_WAIT();
    const unsigned nab = (unsigned)__builtin_amdgcn_readfirstlane((int)hw[0]), c = (unsigned)__builtin_amdgcn_readfirstlane((int)hw[1]);
    if (c == want) { for (unsigned jj = lane; jj < c; jj += 64) out[nab + jj] = cidx[jj]; }
    else if (c <= 512u) {
        const int hh = lane >> 2, dq = lane & 3; const float wh = wrow[hh];
        const v4u q0 = *(const GAS v4u*)(qrow + hh * 64 + 16 * dq), q1 = *(const GAS v4u*)(qrow + hh * 64 + 16 * dq + 8);
        for (unsigned jj = 0; jj < c; ++jj) { const int idx = (int)cidx[jj]; const bf16* kr = KI + (size_t)idx * 64 + 16 * dq;
            const v4u k0 = *(const GAS v4u*)kr, k1 = *(const GAS v4u*)(kr + 8);
            float dsum = ((bflo(q0.x) * bflo(k0.x) + bfhi(q0.x) * bfhi(k0.x)) + (bflo(q0.y) * bflo(k0.y) + bfhi(q0.y) * bfhi(k0.y))) + ((bflo(q0.z) * bflo(k0.z) + bfhi(q0.z) * bfhi(k0.z)) + (bflo(q0.w) * bflo(k0.w) + bfhi(q0.w) * bfhi(k0.w)))
                       + ((bflo(q1.x) * bflo(k1.x) + bfhi(q1.x) * bfhi(k1.x)) + (bflo(q1.y) * bflo(k1.y) + bfhi(q1.y) * bfhi(k1.y))) + ((bflo(q1.z) * bflo(k1.z) + bfhi(q1.z) * bfhi(k1.z)) + (bflo(q1.w) * bflo(k1.w) + bfhi(q1.w) * bfhi(k1.w)));
            dsum += dpp_f(dsum, dsum, 0xB1, 0xf); dsum += dpp_f(dsum, dsum, 0x4E, 0xf);
            const float sc = wave_sum(wh * fmaxf(dsum, 0.f)) * 0.25f;
            if (lane == 0) csc[jj] = sc; }
        LDS_WAIT();
        for (unsigned jj = lane; jj < c; jj += 64) { const float sj = csc[jj]; const unsigned ij = cidx[jj]; unsigned r = 0u;
            for (unsigned ii = 0; ii < c; ++ii) { const float si = csc[ii]; const unsigned ix = cidx[ii]; r += (si > sj || (si == sj && ix < ij)) ? 1u : 0u; }
            if (r < want) out[nab + r] = (unsigned short)ij; }
    } else {
        unsigned run = 0u; int l5 = 8 * lane;
#pragma unroll
        for (int i = 0; i < NP; ++i) { if ((i & 1) == 0) asm volatile("" : "+v"(l5));
            unsigned fl = 0u;
#pragma unroll
            for (int e = 0; e < 8; ++e) { const unsigned k = (e & 1) ? kp[4 * i + (e >> 1)] >> 16 : kp[4 * i + (e >> 1)] & 0xffffu; fl |= (k == T ? 1u : 0u) << e; }
            unsigned tot; unsigned base = run + wave_excl_prefix((unsigned)__popc(fl), lane, tot);
#pragma unroll
            for (int e = 0; e < 8; ++e) if ((fl >> e) & 1u) { if (base < want) out[nab + base] = (unsigned short)(512 * i + l5 + e); ++base; }
            run += tot; }
    }
    LDS_WAIT();
}
__device__ __forceinline__ void dsa_index(Frame& F) {
    PHASE_IDS();
    const int w = wave, b = F.vcu >> 5, iw = F.vcu & 31, r32 = lane & 31, hi = lane >> 5;
    const bf16* QI = WSP(bf16, S_QI) + (size_t)b * SEQ * 1024; const bf16* KI = WSP(bf16, S_KIDX) + (size_t)b * SEQ * 64; const float* WI = WSP(float, S_WIDX) + (size_t)b * SEQ * 16;
    unsigned short* IDX = WSP(unsigned short, S_IDX) + (size_t)b * SEQ * TOPK;
    unsigned short* sc = WSP(unsigned short, S_SC) + (size_t)F.vcu * 32 * SEQ;
    LAS unsigned* h4 = (LAS unsigned*)(F.lds + RING_OFF + w * 10240);
    LAS float* csc = (LAS float*)(h4 + 2048);
    LAS unsigned char* kb = F.lds + RING_OFF + 81920;
    for (int ui = 0; ui < 4; ++ui) {
        const int c = ui == 0 ? 127 - iw : (ui == 1 ? 64 + iw : (ui == 2 ? 63 - iw : iw));
        if (c < 4) continue;
        const int n = (c + 1) * 64, ntile = n / 32, nblk = (n + 255) >> 8;
        for (int sub = 0; sub < 2; ++sub) { const int qbase = c * 64 + sub * 32 + 4 * w;
            bf16x8 af[2][4]; float wv[2][16];
#pragma unroll
            for (int tt = 0; tt < 2; ++tt) { const int q = qbase + 2 * tt + ((r32 >> 2) & 1), head = (r32 & 3) + 4 * (r32 >> 3);
#pragma unroll
                for (int ks = 0; ks < 4; ++ks) af[tt][ks] = *(const GAS bf16x8*)(QI + (size_t)q * 1024 + head * 64 + 16 * ks + 8 * hi);
                const float* wp = WI + (size_t)(qbase + 2 * tt + hi) * 16;
#pragma unroll
                for (int j = 0; j < 4; ++j) { const f32x4 v = *(const GAS f32x4*)(wp + 4 * j); wv[tt][4 * j] = v[0]; wv[tt][4 * j + 1] = v[1]; wv[tt][4 * j + 2] = v[2]; wv[tt][4 * j + 3] = v[3]; } }
            unsigned short* scw = sc + (size_t)(4 * w) * SEQ;
            LAS unsigned* hq = h4 + hi * 512 + (lane & 3);
            for (int rp_ = 0; rp_ < P0REP(26); ++rp_) {
#pragma unroll
            for (int j = 0; j < 8; ++j) *(LAS v4u*)(h4 + 256 * j + 4 * lane) = (v4u){0u, 0u, 0u, 0u};
            LDS_WAIT();
#define IDX_DMA(j_) do { _Pragma("unroll") for (int p_ = 0; p_ < 4; ++p_) { const int kn_ = 256 * (j_) + 8 * (4 * w + p_) + (lane >> 3), kr_ = kn_ < n ? kn_ : n - 1, ch_ = (lane & 7) ^ (kn_ & 7); \
                __builtin_amdgcn_global_load_lds((const unsigned*)(KI + (size_t)kr_ * 64 + ch_ * 8), (LAS unsigned*)(kb + ((j_) & 1) * 32768 + (4 * w + p_) * 1024), 16, 0, 0); } } while (0)
#define IDX_LDF(ks_, t_) KF.f[ks_] = *(const LAS bf16x8*)(kb + (((t_) >> 3) & 1) * 32768 + (32 * ((t_) & 7) + r32) * 128 + (((2 * (ks_) + hi) ^ (r32 & 7)) << 4))
#define MF0(acc, a, b) asm volatile("v_mfma_f32_32x32x16_bf16 %0, %1, %2, 0" : "=&v"(acc) : "v"(a), "v"(b))
#define MFA(acc, a, b) asm volatile("v_mfma_f32_32x32x16_bf16 %0, %1, %2, %0" : "+v"(acc) : "v"(a), "v"(b))
#define VAL4(C, W, sa, sb, r) do { sa = fma_v(W[r], relu_v(C[r]), sa); sb = fma_v(W[(r) + 1], relu_v(C[(r) + 1]), sb); sa = fma_v(W[(r) + 2], relu_v(C[(r) + 2]), sa); sb = fma_v(W[(r) + 3], relu_v(C[(r) + 3]), sb); } while (0)
            IDX_DMA(0);
            if (nblk > 1) { IDX_DMA(1); asm volatile("s_waitcnt vmcnt(4)" ::: "memory"); } else asm volatile("s_waitcnt vmcnt(0)" ::: "memory");
            __builtin_amdgcn_s_barrier(); asm volatile("" ::: "memory");
            bfrx KF; f32x16 A0a, A0b, A1a, A1b;
#pragma unroll
            for (int ks = 0; ks < 4; ++ks) IDX_LDF(ks, 0);
            MF0(A0a, af[0][0], KF.f[0]); MF0(A0b, af[1][0], KF.f[0]); IDX_LDF(0, 1);
            MFA(A0a, af[0][1], KF.f[1]); MFA(A0b, af[1][1], KF.f[1]); IDX_LDF(1, 1);
            MFA(A0a, af[0][2], KF.f[2]); MFA(A0b, af[1][2], KF.f[2]); IDX_LDF(2, 1);
            MFA(A0a, af[0][3], KF.f[3]); MFA(A0b, af[1][3], KF.f[3]); IDX_LDF(3, 1);
#define IDX_STEP(t_, j_, Ca, Cb, Na, Nb) do { const int tq_ = (t_), t2_ = tq_ + 2 < ntile ? tq_ + 2 : tq_ + 1; \
                if (tq_ + 2 < ntile && ((tq_ + 2) & 7) == 0) { const int jn_ = (tq_ + 2) >> 3; asm volatile("s_waitcnt vmcnt(8) lgkmcnt(0)" ::: "memory"); __builtin_amdgcn_s_barrier(); asm volatile("" ::: "memory"); if (jn_ + 1 < nblk) IDX_DMA(jn_ + 1); } \
                float s0a = 0.f, s0b = 0.f, s1a = 0.f, s1b = 0.f; \
                if (tq_ + 1 < ntile) { \
                    MF0(Na, af[0][0], KF.f[0]); VAL4(Ca, wv[0], s0a, s0b, 0); MF0(Nb, af[1][0], KF.f[0]); IDX_LDF(0, t2_); VAL4(Cb, wv[1], s1a, s1b, 0); \
                    MFA(Na, af[0][1], KF.f[1]); VAL4(Ca, wv[0], s0a, s0b, 4); MFA(Nb, af[1][1], KF.f[1]); IDX_LDF(1, t2_); VAL4(Cb, wv[1], s1a, s1b, 4); \
                    MFA(Na, af[0][2], KF.f[2]); VAL4(Ca, wv[0], s0a, s0b, 8); MFA(Nb, af[1][2], KF.f[2]); IDX_LDF(2, t2_); VAL4(Cb, wv[1], s1a, s1b, 8); \
                    MFA(Na, af[0][3], KF.f[3]); VAL4(Ca, wv[0], s0a, s0b, 12); MFA(Nb, af[1][3], KF.f[3]); IDX_LDF(3, t2_); VAL4(Cb, wv[1], s1a, s1b, 12); \
                } else { VAL4(Ca, wv[0], s0a, s0b, 0); VAL4(Cb, wv[1], s1a, s1b, 0); VAL4(Ca, wv[0], s0a, s0b, 4); VAL4(Cb, wv[1], s1a, s1b, 4); VAL4(Ca, wv[0], s0a, s0b, 8); VAL4(Cb, wv[1], s1a, s1b, 8); VAL4(Ca, wv[0], s0a, s0b, 12); VAL4(Cb, wv[1], s1a, s1b, 12); } \
                const float s0 = s0a + s0b, s1 = s1a + s1b; const unsigned k0 = fkey(s0), k1 = fkey(s1); \
                scw[(size_t)hi * SEQ + 32 * tq_ + r32] = (unsigned short)(k0 >> 16); scw[(size_t)(2 + hi) * SEQ + 32 * tq_ + r32] = (unsigned short)(k1 >> 16); \
                RM[j_] = pk_max_u16(RM[j_], (k1 & 0xffff0000u) | (k0 >> 16)); \
                if (k0 >= (th << 16)) lds_add(hq + ((k0 >> 25) << 2), (k0 & 0x1000000u) ? 65536u : 1u);     \
                if (k1 >= (th & 0xffff0000u)) lds_add(hq + 1024 + ((k1 >> 25) << 2), (k1 & 0x1000000u) ? 65536u : 1u); \
            } while (0)
            unsigned RM[8], th = 0u;
#pragma unroll
            for (int j = 0; j < 8; ++j) RM[j] = 0u;
#define IDX_TH() do { th = half_min_pk(pk_min_u16(pk_min_u16(pk_min_u16(RM[0], RM[1]), pk_min_u16(RM[2], RM[3])), pk_min_u16(pk_min_u16(RM[4], RM[5]), pk_min_u16(RM[6], RM[7])))); } while (0)
            for (int t = 0; t < ntile; t += 8) {
                IDX_STEP(t, 0, A0a, A0b, A1a, A1b); IDX_STEP(t + 1, 1, A1a, A1b, A0a, A0b); if (t + 2 >= ntile) break;
                IDX_STEP(t + 2, 2, A0a, A0b, A1a, A1b); IDX_STEP(t + 3, 3, A1a, A1b, A0a, A0b); if (t + 4 >= ntile) break;
                IDX_STEP(t + 4, 4, A0a, A0b, A1a, A1b); IDX_STEP(t + 5, 5, A1a, A1b, A0a, A0b); if (t + 6 >= ntile) break;
                IDX_STEP(t + 6, 6, A0a, A0b, A1a, A1b); IDX_STEP(t + 7, 7, A1a, A1b, A0a, A0b);
                IDX_TH();
            }
            IDX_TH();
            if (r32 == 0) { F.MISC[16 + 4 * w + hi] = th & 0xffffu; F.MISC[16 + 4 * w + 2 + hi] = th >> 16; }
#undef IDX_TH
            asm volatile("s_waitcnt lgkmcnt(0)" ::: "memory"); __builtin_amdgcn_s_barrier(); asm volatile("" ::: "memory");
#undef IDX_STEP
#undef VAL4
#undef MFA
#undef MF0
#undef IDX_LDF
#undef IDX_DMA
            LDS_WAIT(); }
            VM_WAIT(); __builtin_amdgcn_fence(__ATOMIC_ACQUIRE, "agent"); VM_WAIT(); LDS_WAIT();
            for (int rp_ = 0; rp_ < P0REP(27); ++rp_)
            for (int qq = 0; qq < 4; ++qq) { const unsigned short* row = scw + (size_t)qq * SEQ; unsigned short* o = IDX + (size_t)(qbase + qq) * TOPK; LAS unsigned* h0 = h4 + 512 * qq; LAS unsigned* hw = h0; LAS unsigned short* cidx = (LAS unsigned short*)(h0 + 256);
                unsigned th16 = F.MISC[16 + 4 * w + qq]; th16 = th16 > 1u ? th16 : 1u;
                const bf16* qrow = QI + (size_t)(qbase + qq) * 1024; const float* wrow = WI + (size_t)(qbase + qq) * 16;
                if (n <= 2048) topk16_select<4>(row, n, o, h0, hw, cidx, csc, qrow, KI, wrow, lane, th16); else if (n <= 4096) topk16_select<8>(row, n, o, h0, hw, cidx, csc, qrow, KI, wrow, lane, th16);
                else if (n <= 6144) topk16_select<12>(row, n, o, h0, hw, cidx, csc, qrow, KI, wrow, lane, th16); else topk16_select<16>(row, n, o, h0, hw, cidx, csc, qrow, KI, wrow, lane, th16); }
        }
    }
}

__device__ __forceinline__ s16x4 tr16(LAS const unsigned char* p) { typedef short v4i16_t __attribute__((ext_vector_type(4))); return __builtin_bit_cast(s16x4, __builtin_amdgcn_ds_read_tr16_b64_v4i16((LAS v4i16_t*)p)); }
__device__ __forceinline__ void sparse_attn(Frame& F) {
    PHASE_IDS();
    const int w = wave, b = F.vcu >> 5, wb = (F.vcu & 31) * 8 + w, n16 = lane & 15, g = lane >> 4;
    constexpr int RS = 592;
    LAS unsigned char* tile = F.lds + RING_OFF + w * 19456;
    const bf16* QF = WSP(bf16, S_QF); const unsigned char* KV = (const unsigned char*)(WSP(bf16, S_KVL) + (size_t)b * SEQ * KVW);
    const unsigned short* IDX = WSP(unsigned short, S_IDX); bf16* OL = WSP(bf16, S_OL);
    const int trq = (n16 >> 2), trp = n16 & 3;
    int koff[19];
    { const int mi = (int)IDX[((size_t)b * SEQ + wb) * TOPK + (lane & 31)];
#pragma unroll
      for (int j = 0; j < 19; ++j) { const int L = j * 1024 + lane * 16, row = L / RS; koff[j] = __shfl(mi, row & 31) * (KVW * 2); } }
    for (int i = 0; i < 32; ++i) {
        const int s = wb + 256 * i; const size_t t = (size_t)b * SEQ + s, tnx = (size_t)b * SEQ + wb + 256 * (i < 31 ? i + 1 : i);
        const int nv = ((s >> 6) + 1) * 64 < TOPK ? ((s >> 6) + 1) * 64 : TOPK, ntile = nv >> 5;
        bf16x8 qb[9]; { int qo = (n16 & 7) * KVW + 8 * g; asm volatile("" : "+v"(qo)); const bf16* qp = QF + t * (8 * KVW) + qo;
#pragma unroll
            for (int ks = 0; ks < 9; ++ks) qb[ks] = *(const GAS bf16x8*)(qp + 32 * ks); }
        float mrun = -INFINITY, lrun = 0.f;
        f32x4 o[16];
#pragma unroll
        for (int dt = 0; dt < 16; ++dt) o[dt] = (f32x4){0.f, 0.f, 0.f, 0.f};
        for (int tl = 0; tl < ntile; ++tl) {
#pragma unroll
            for (int j = 0; j < 19; ++j) { const int L = j * 1024 + lane * 16, row = L / RS, col = L - row * RS;
                const unsigned char* src = (col < KVW * 2 && row < 32) ? KV + (size_t)(unsigned)koff[j] + col : KV;
                __builtin_amdgcn_global_load_lds((const unsigned*)src, (LAS unsigned*)(tile + j * 1024), 16, 0, 0); }
            const int mi_n = (int)IDX[(tl + 1 < ntile ? t * TOPK + 32 * (tl + 1) : tnx * TOPK) + (lane & 31)];
            asm volatile("s_waitcnt vmcnt(0)" ::: "memory");
            LDS_WAIT();
            f32x4 s0 = (f32x4){0.f, 0.f, 0.f, 0.f}, s1 = s0;
#pragma unroll
            for (int ks = 0; ks < 9; ++ks) { const bf16x8 a0 = *(const LAS bf16x8*)(tile + n16 * RS + (32 * ks + 8 * g) * 2), a1 = *(const LAS bf16x8*)(tile + (16 + n16) * RS + (32 * ks + 8 * g) * 2);
                s0 = __builtin_amdgcn_mfma_f32_16x16x32_bf16(a0, qb[ks], s0, 0, 0, 0); s1 = __builtin_amdgcn_mfma_f32_16x16x32_bf16(a1, qb[ks], s1, 0, 0, 0); }
            float mx = fmaxf(fmaxf(fmaxf(s0[0], s0[1]), fmaxf(s0[2], s0[3])), fmaxf(fmaxf(s1[0], s1[1]), fmaxf(s1[2], s1[3])));
            { auto r16 = __builtin_amdgcn_permlane16_swap(__float_as_uint(mx), __float_as_uint(mx), false, false); mx = fmaxf(__uint_as_float(r16[0]), __uint_as_float(r16[1]));
              auto r32 = __builtin_amdgcn_permlane32_swap(__float_as_uint(mx), __float_as_uint(mx), false, false); mx = fmaxf(__uint_as_float(r32[0]), __uint_as_float(r32[1])); }
            const bool resc = __ballot(mx > mrun + 8.0f) != 0ull;
            const float mnew = resc ? fmaxf(mrun, mx) : mrun, alpha = resc ? __builtin_amdgcn_exp2f(mrun - mnew) : 1.0f;
            float p0[4], p1[4], ps = 0.f;
#pragma unroll
            for (int r = 0; r < 4; ++r) { p0[r] = __builtin_amdgcn_exp2f(s0[r] - mnew); p1[r] = __builtin_amdgcn_exp2f(s1[r] - mnew); ps += p0[r] + p1[r]; }
            lrun = lrun * alpha + ps; mrun = mnew;
            v4u pw; pw.x = pg8::cvt_pk_bf16(p0[0], p0[1]); pw.y = pg8::cvt_pk_bf16(p0[2], p0[3]); pw.z = pg8::cvt_pk_bf16(p1[0], p1[1]); pw.w = pg8::cvt_pk_bf16(p1[2], p1[3]);
            const bf16x8 pa = __builtin_bit_cast(bf16x8, pw);
            if (resc) { float ar[4];
#pragma unroll
                for (int r = 0; r < 4; ++r) ar[r] = __shfl(alpha, 4 * g + r);
#pragma unroll
                for (int dt = 0; dt < 16; ++dt)
#pragma unroll
                    for (int r = 0; r < 4; ++r) o[dt][r] *= ar[r]; }
#pragma unroll
            for (int j = 0; j < 19; ++j) { const int L = j * 1024 + lane * 16, row = L / RS; koff[j] = __shfl(mi_n, row & 31) * (KVW * 2); }
#pragma unroll
            for (int dt = 0; dt < 16; ++dt) {
                const s16x4 lo = tr16(tile + (4 * g + trq) * RS + (16 * dt + 4 * trp) * 2), hi4 = tr16(tile + (16 + 4 * g + trq) * RS + (16 * dt + 4 * trp) * 2);
                const bf16x8 vb = (bf16x8){lo[0], lo[1], lo[2], lo[3], hi4[0], hi4[1], hi4[2], hi4[3]};
                o[dt] = __builtin_amdgcn_mfma_f32_16x16x32_bf16(pa, vb, o[dt], 0, 0, 0); }
            LDS_WAIT();
        }
        lrun += __shfl_xor(lrun, 16); lrun += __shfl_xor(lrun, 32);
        const float linv = 1.0f / lrun; float li[4];
#pragma unroll
        for (int r = 0; r < 4; ++r) li[r] = __shfl(linv, 4 * g + r);
        if (g < 2) {
#pragma unroll
            for (int dt = 0; dt < 16; ++dt)
#pragma unroll
                for (int r = 0; r < 4; ++r) ((LAS bf16*)tile)[(4 * g + r) * 256 + 16 * dt + n16] = (bf16)f2bf(o[dt][r] * li[r]); }
        LDS_WAIT();
#pragma unroll
        for (int j = 0; j < 4; ++j) { const int c = lane + 64 * j; *(GAS v4u*)(OL + t * 2048 + c * 8) = *(const LAS v4u*)(tile + c * 16); }
        LDS_WAIT();
    }
}
#if !MK_DBG
#define DBG_AFTER_PHASE(p) do { } while (0)
#else
#define DBGK 256
__device__ __forceinline__ unsigned hsh(unsigned x) { x ^= x >> 16; x *= 0x7feb352du; x ^= x >> 15; x *= 0x846ca68bu; x ^= x >> 16; return x; }
__device__ __forceinline__ void err_max(unsigned char* ws, int id, float v) { if (!(v >= 0.f)) v = 1e30f; atomicMax((unsigned*)(ws + WS_CTL) + CW_ERR + id, __float_as_uint(v)); }
__device__ __forceinline__ float block_sum(float v, float* sh) { const int t = threadIdx.x; sh[t] = v; __syncthreads(); for (int o = DBGK / 2; o > 0; o >>= 1) { if (t < o) sh[t] += sh[t + o]; __syncthreads(); } const float r = sh[0]; __syncthreads(); return r; }
__device__ __forceinline__ float block_max(float v, float* sh) { const int t = threadIdx.x; sh[t] = v; __syncthreads(); for (int o = DBGK / 2; o > 0; o >>= 1) { if (t < o) sh[t] = fmaxf(sh[t], sh[t + o]); __syncthreads(); } const float r = sh[0]; __syncthreads(); return r; }
__device__ __forceinline__ void rope_cs(const int* pos, int t, int jj  , float& c, float& s) { const double a = (double)pos[t] * pow(500000.0, -(double)jj / 16.0); c = (float)cos(a); s = (float)sin(a); }
__device__ __forceinline__ void ln_row(const float* row, const float* g, const float* b, float* sh_h, float* sh) {
    const int t = threadIdx.x; float v[4], s = 0.f; for (int j = 0; j < 4; ++j) { v[j] = row[t + 256 * j]; s += v[j]; }
    const float mean = block_sum(s, sh) * (1.f / 1024.f); float q = 0.f; for (int j = 0; j < 4; ++j) { v[j] -= mean; q += v[j] * v[j]; }
    const float rstd = 1.f / sqrtf(block_sum(q, sh) * (1.f / 1024.f) + LN_EPS);
    for (int j = 0; j < 4; ++j) sh_h[t + 256 * j] = v[j] * rstd * g[t + 256 * j] + b[t + 256 * j];
    __syncthreads();
}
struct DArgs { const float* in[N_IN]; float* out; unsigned char* ws; int layer, pad; };
#define DWS(T_, off) ((T_*)(a.ws + (off)))
__global__ void __launch_bounds__(DBGK) chk_topk(DArgs a) {
    __shared__ float sc[SEQ]; __shared__ unsigned char sel[SEQ]; __shared__ float sh[DBGK]; __shared__ int cnt;
    const int smp = blockIdx.x, t = threadIdx.x, b = smp & 7; const int s = 256 + (hsh(smp * 7 + 1) % (SEQ - 256)), n = ((s >> 6) + 1) * 64; const size_t tok = (size_t)b * SEQ + s;
    const bf16* QI = DWS(bf16, S_QI) + tok * 1024; const bf16* KI = DWS(bf16, S_KIDX) + (size_t)b * SEQ * 64; const float* WI = DWS(float, S_WIDX) + tok * 16;
    for (int k = t; k < n; k += DBGK) { float acc = 0.f; for (int h = 0; h < 16; ++h) { float l = 0.f; for (int d = 0; d < 64; ++d) l += bf2f(QI[h * 64 + d]) * bf2f(KI[(size_t)k * 64 + d]); acc += WI[h] * fmaxf(l, 0.f); } sc[k] = acc; sel[k] = 0; }
    if (t == 0) cnt = 0; __syncthreads();
    const unsigned short* idx = DWS(unsigned short, S_IDX) + tok * TOPK;
    { const int k = idx[t]; bool ok = k < n; if (ok) { sel[k] = 1; } else atomicAdd(&cnt, 1000); }
    __syncthreads();
    int c = 0; float mn = 1e30f, mxu = -1e30f, lo = 1e30f, hi = -1e30f; for (int k = t; k < n; k += DBGK) { c += sel[k]; if (sel[k]) mn = fminf(mn, sc[k]); else mxu = fmaxf(mxu, sc[k]); lo = fminf(lo, sc[k]); hi = fmaxf(hi, sc[k]); }
    const float nsel = block_sum((float)c, sh), smin = -block_max(-mn, sh), umax = block_max(mxu, sh), rlo = -block_max(-lo, sh), rhi = block_max(hi, sh);
    if (t == 0) { float e = fmaxf(0.f, umax - smin) / (rhi - rlo + 1e-20f); if (nsel != 256.f || cnt != 0) e = 1e3f; err_max(a.ws, 1, e); }
}
__global__ void __launch_bounds__(DBGK) chk_sparse(DArgs a) {
    __shared__ float p[256]; __shared__ float sh[DBGK];
    const int smp = blockIdx.x, t = threadIdx.x, b = smp & 7; const int s = (smp < 16) ? (smp * 13) % 256 : hsh(smp * 11 + 3) % SEQ; const size_t tok = (size_t)b * SEQ + s;
    const int nv = ((s >> 6) + 1) * 64 < TOPK ? ((s >> 6) + 1) * 64 : TOPK;
    const bf16* QF = DWS(bf16, S_QF) + tok * 8 * KVW; const bf16* KV = DWS(bf16, S_KVL) + (size_t)b * SEQ * KVW; const unsigned short* idx = DWS(unsigned short, S_IDX) + tok * TOPK; const bf16* OL = DWS(bf16, S_OL) + tok * 2048;
    float emax = 0.f, omax = 0.f;
    for (int h = 0; h < 8; ++h) { float sc = -INFINITY; if (t < nv) { sc = 0.f; const bf16* kr = KV + (size_t)idx[t] * KVW; for (int d = 0; d < KVW; ++d) sc += bf2f(QF[h * KVW + d]) * bf2f(kr[d]); }
        const float m = block_max(sc, sh); const float e = t < nv ? exp2f(sc - m) : 0.f; const float l = block_sum(e, sh); p[t] = e / l; __syncthreads();
        float o = 0.f; for (int k = 0; k < nv; ++k) o += p[k] * bf2f(KV[(size_t)idx[k] * KVW + t]);
        emax = fmaxf(emax, fabsf(o - bf2f(OL[h * 256 + t]))); omax = fmaxf(omax, fabsf(o)); __syncthreads(); }
    const float e = block_max(emax, sh), o = block_max(omax, sh); if (t == 0) err_max(a.ws, 2, e / (o + 1e-20f));
}
__global__ void __launch_bounds__(DBGK) chk_x1p(DArgs a) {
    __shared__ float hrow[1024]; __shared__ float q[1024]; __shared__ float sh[DBGK];
    const int smp = blockIdx.x, t = threadIdx.x, L = a.layer; const size_t tok = hsh(smp * 5 + 9 + L) % T; const int b = (int)(tok / SEQ);
    ln_row(a.out + tok * 1024, a.in[I_LNG] + (L * 3) * 1024, a.in[I_LNB] + (L * 3) * 1024, hrow, sh);
    const float* W = a.in[I_XAWQ] + (size_t)L * 1048576;
    for (int j = 0; j < 4; ++j) { const int c = t + 256 * j; float o = 0.f; for (int k = 0; k < 1024; ++k) o += hrow[k] * W[(size_t)k * 1024 + c]; q[c] = o * XQS; }
    __syncthreads();
    const bf16* MK = DWS(bf16, WS_MK) + (size_t)b * 256 * 1024; const bf16* P = DWS(bf16, S_P) + tok * 1024; float emax = 0.f;
    for (int h = 0; h < 4; ++h) { float sc = 0.f; for (int d = 0; d < 256; ++d) sc += q[h * 256 + d] * bf2f(MK[(size_t)t * 1024 + h * 256 + d]);
        const float m = block_max(sc, sh); const float e = exp2f(sc - m); const float l = block_sum(e, sh); emax = fmaxf(emax, fabsf(e / l - bf2f(P[h * 256 + t]))); }
    const float e = block_max(emax, sh); if (t == 0) err_max(a.ws, 4, e * 16.f);
}
__global__ void __launch_bounds__(DBGK) chk_x4p(DArgs a, int salt) {
    __shared__ float hrow[1024]; __shared__ float ov[1024]; __shared__ float sh[DBGK];
    const int t = threadIdx.x, L = a.layer; const size_t tok = hsh(blockIdx.x * 29 + salt) % T; const int b = (int)(tok / SEQ); const float* snap = DWS(float, WS_SMALL) + 65536 + (size_t)blockIdx.x * 1024;
    ln_row(snap, a.in[I_LNG] + (L * 3) * 1024, a.in[I_LNB] + (L * 3) * 1024, hrow, sh);
    const bf16* P = DWS(bf16, S_P) + tok * 1024; const bf16* MV = DWS(bf16, WS_MVT) + (size_t)b * 256 * 1024;
    for (int j = 0; j < 4; ++j) { const int c = t + 256 * j, h = c >> 8; float o = 0.f; for (int m = 0; m < 256; ++m) o += bf2f(P[h * 256 + m]) * bf2f(MV[(size_t)m * 1024 + c]); ov[c] = o; }
    __syncthreads();
    const float* W = a.in[I_XAWOUT] + (size_t)L * 1048576; float emax = 0.f, omax = 0.f;
    for (int j = 0; j < 4; ++j) { const int c = t + 256 * j; float o = 0.f; for (int k = 0; k < 1024; ++k) o += ov[k] * W[(size_t)k * 1024 + c]; emax = fmaxf(emax, fabsf(ALPHA * hrow[c] + o - a.out[tok * 1024 + c])); omax = fmaxf(omax, fabsf(o)); }
    const float e = block_max(emax, sh), o = block_max(omax, sh); if (t == 0) err_max(a.ws, 3, e / (o + 1e-20f));
}
__global__ void __launch_bounds__(DBGK) chk_fold(DArgs a, int which  ) {
    __shared__ float hrow[1024]; __shared__ float sh[DBGK];
    const int smp = blockIdx.x, t = threadIdx.x; const size_t tok = hsh(smp * 3 + 17 + which + a.layer) % T;
    const int ln = which == 0 ? a.layer * 3 + 0 : 2;
    ln_row(a.out + tok * 1024, a.in[I_LNG] + ln * 1024, a.in[I_LNB] + ln * 1024, hrow, sh);
    float emax = 0.f, omax = 0.f;
    if (which == 0) { const float* W = a.in[I_XAWQ] + (size_t)a.layer * 1048576; const bf16* QX = DWS(bf16, S_QX) + tok * 1024;
        for (int j = 0; j < 4; ++j) { const int c = t + 256 * j; float o = 0.f; for (int k = 0; k < 1024; ++k) o += hrow[k] * W[(size_t)k * 1024 + c]; o *= XQS; emax = fmaxf(emax, fabsf(o - bf2f(QX[c]))); omax = fmaxf(omax, fabsf(o)); } }
    else { const float* W = a.in[I_BWIN]; const float* BIN = DWS(float, S_BIN) + tok * BIN_LD;
        for (int c = t; c < BIN_W; c += DBGK) { float o = 0.f; for (int k = 0; k < 1024; ++k) o += hrow[k] * W[(size_t)k * BIN_W + c]; emax = fmaxf(emax, fabsf(o - BIN[c])); omax = fmaxf(omax, fabsf(o)); } }
    const float e = block_max(emax, sh), o = block_max(omax, sh); if (t == 0) err_max(a.ws, 4 + which, e / (o + 1e-20f));
}
__global__ void __launch_bounds__(DBGK) chk_moe(DArgs a) {
    __shared__ float hrow[1024]; __shared__ float hid[512]; __shared__ float sh[DBGK]; __shared__ float lg[20]; __shared__ int se[2]; __shared__ float sw[2];
    const int smp = blockIdx.x, t = threadIdx.x, L = a.layer; const size_t tok = hsh(smp * 13 + 5 + L) % T;
    ln_row(a.out + tok * 1024, a.in[I_LNG] + (L * 3 + 1) * 1024, a.in[I_LNB] + (L * 3 + 1) * 1024, hrow, sh);
    for (int o = 0; o < 20; ++o) { float p = 0.f; for (int j = 0; j < 4; ++j) { const int k = t + 256 * j; p += hrow[k] * (o < 4 ? a.in[I_MWG][(size_t)L * 4096 + k * 4 + o] : a.in[I_MWE][(size_t)L * 16384 + k * 16 + (o - 4)]); }
        const float v = block_sum(p, sh); if (t == 0) lg[o] = v + (o < 4 ? a.in[I_MBG][L * 4 + o] : a.in[I_MBE][L * 16 + o - 4]); }
    __syncthreads();
    if (t == 0) { int gs = 0; for (int i = 1; i < 4; ++i) if (lg[i] > lg[gs]) gs = i; float den = 0.f; for (int i = 0; i < 4; ++i) den += expf(lg[i] - lg[gs]); const float gate = 1.f / den;
        const float* e = lg + 4 + gs * 4; int i1 = 0; for (int i = 1; i < 4; ++i) if (e[i] > e[i1]) i1 = i; int i2 = -1; for (int i = 0; i < 4; ++i) if (i != i1 && (i2 < 0 || e[i] > e[i2])) i2 = i;
        const float m = e[i1], z = expf(e[i1] - m) + expf(e[i2] - m); se[0] = gs * 4 + i1; se[1] = gs * 4 + i2; sw[0] = expf(e[i1] - m) / z * gate; sw[1] = expf(e[i2] - m) / z * gate; }
    __syncthreads();
    const int* route = DWS(int, WS_ROUTE) + tok * 4; const float* rw = DWS(float, WS_ROUTEW) + tok * 2; const int* pos2 = DWS(int, WS_POS2) + tok * 2;
    float emax = 0.f, omax = 0.f; float rerr = 0.f;
    if (route[0] != se[0] || route[1] != se[1]) rerr = 1e3f; rerr = fmaxf(rerr, fabsf(rw[0] - sw[0]) / sw[0]); rerr = fmaxf(rerr, fabsf(rw[1] - sw[1]) / sw[1]);
    if (DWS(int, WS_ROWIDX)[pos2[0]] != (int)tok || DWS(int, WS_ROWIDX)[pos2[1]] != (int)tok) rerr = 2e3f;
    for (int j = 0; j < 2; ++j) { const int e = se[j]; const float* Wg = a.in[I_MWGATE] + ((size_t)L * 16 + e) * 524288; const float* Wu = a.in[I_MWUP] + ((size_t)L * 16 + e) * 524288; const float* Wd = a.in[I_MWDOWN] + ((size_t)L * 16 + e) * 524288;
        for (int f = t; f < 512; f += DBGK) { float g = 0.f, u = 0.f; for (int k = 0; k < 1024; ++k) { g += hrow[k] * Wg[(size_t)k * 512 + f]; u += hrow[k] * Wu[(size_t)k * 512 + f]; } hid[f] = g / (1.f + expf(-g)) * u; }
        __syncthreads();
        const bf16* Y = DWS(bf16, S_Y) + (size_t)pos2[j] * 1024;
        for (int jj = 0; jj < 4; ++jj) { const int c = t + 256 * jj; float o = 0.f; for (int f = 0; f < 512; ++f) o += hid[f] * Wd[(size_t)f * 1024 + c]; o *= sw[j]; emax = fmaxf(emax, fabsf(o - bf2f(Y[c]))); omax = fmaxf(omax, fabsf(o)); }
        __syncthreads(); }
    const float e = block_max(emax, sh), o = block_max(omax, sh); if (t == 0) { err_max(a.ws, 6, e / (o + 1e-20f)); err_max(a.ws, 7, rerr); }
}
__global__ void __launch_bounds__(DBGK) chk_q2(DArgs a) {
    __shared__ float cq[256]; __shared__ float q[1024]; __shared__ float sh[DBGK];
    const int smp = blockIdx.x, t = threadIdx.x; const size_t tok = hsh(smp * 19 + 2) % T; const int* pos = (const int*)a.in[I_POS];
    cq[t] = bf2f(DWS(bf16, S_CQ)[tok * 256 + t]); __syncthreads();
    for (int j = 0; j < 4; ++j) { const int c = t + 256 * j; float o = 0.f; for (int k = 0; k < 256; ++k) o += cq[k] * a.in[I_BWUQ][(size_t)k * 1024 + c]; q[c] = o; }
    __syncthreads();
    float emax = 0.f, omax = 0.f; const bf16* QF = DWS(bf16, S_QF) + tok * 8 * KVW;
    for (int h = 0; h < 8; ++h) { float o = 0.f; for (int n = 0; n < 96; ++n) o += q[h * 128 + 32 + n] * a.in[I_BWUK][((size_t)h * 256 + t) * 96 + n]; o *= SC2;
        emax = fmaxf(emax, fabsf(o - bf2f(QF[h * KVW + t]))); omax = fmaxf(omax, fabsf(o));
        if (t < 32) { const int j = t & 15; float c, s; rope_cs(pos, (int)tok, j, c, s); const float x1 = q[h * 128 + j], x2 = q[h * 128 + 16 + j]; const float r = (t < 16 ? x1 * c - x2 * s : x2 * c + x1 * s) * SC2;
            emax = fmaxf(emax, fabsf(r - bf2f(QF[h * KVW + 256 + t]))); omax = fmaxf(omax, fabsf(r)); } }
    const float e = block_max(emax, sh), o = block_max(omax, sh); if (t == 0) err_max(a.ws, 8, e / (o + 1e-20f));
    __syncthreads();
    if (tok >= T / 4 + 64) { float e2 = 0.f, o2 = 0.f; const bf16* QI = DWS(bf16, S_QI) + tok * 1024;
        for (int j = 0; j < 4; ++j) { const int c = t + 256 * j; float o = 0.f; for (int k = 0; k < 256; ++k) o += cq[k] * a.in[I_BWQIDX][(size_t)k * 1024 + c]; q[c] = o; }
        __syncthreads();
        for (int j = 0; j < 4; ++j) { const int c = t + 256 * j, d = c & 63; float r = q[c]; if (d < 16) { float cs, sn; rope_cs(pos, (int)tok, 2 * (d & 7), cs, sn); r = d < 8 ? q[c] * cs - q[c + 8] * sn : q[c] * cs + q[c - 8] * sn; }
            e2 = fmaxf(e2, fabsf(r - bf2f(QI[c]))); o2 = fmaxf(o2, fabsf(r)); }
        const float ee = block_max(e2, sh), oo = block_max(o2, sh); if (t == 0) err_max(a.ws, 9, ee / (oo + 1e-20f)); }
}
__global__ void __launch_bounds__(DBGK) chk_prep(DArgs a) {
    __shared__ float sh[DBGK];
    const int smp = blockIdx.x, t = threadIdx.x; const size_t tok = hsh(smp * 23 + 4) % T; const float* row = DWS(float, S_BIN) + tok * BIN_LD; const int* pos = (const int*)a.in[I_POS];
    const float sa = block_sum(row[t] * row[t], sh), scv = block_sum(row[256 + t] * row[256 + t], sh); const float ra = 1.f / sqrtf(sa / 256.f + LN_EPS), rc = 1.f / sqrtf(scv / 256.f + LN_EPS);
    float e = fabsf(row[t] * ra * a.in[I_BQG][t] - bf2f(DWS(bf16, S_CQ)[tok * 256 + t])); e = fmaxf(e, fabsf(row[256 + t] * rc * a.in[I_BKVG][t] - bf2f(DWS(bf16, S_KVL)[tok * KVW + t])));
    if (t < 32) { const int j = t & 15; float c, s; rope_cs(pos, (int)tok, j, c, s); const float x1 = row[512 + j], x2 = row[528 + j]; const float r = t < 16 ? x1 * c - x2 * s : x2 * c + x1 * s; e = fmaxf(e, fabsf(r - bf2f(DWS(bf16, S_KVL)[tok * KVW + 256 + t]))); }
    if (t < 64) { float r = row[544 + t]; if (t < 16) { float c, s; rope_cs(pos, (int)tok, 2 * (t & 7), c, s); r = t < 8 ? row[544 + t] * c - row[552 + t] * s : row[544 + t] * c + row[536 + t] * s; } e = fmaxf(e, fabsf(r - bf2f(DWS(bf16, S_KIDX)[tok * 64 + t]))); }
    if (t < 16) e = fmaxf(e, 32.f * fabsf(row[608 + t] / 32.f - DWS(float, S_WIDX)[tok * 16 + t]));
    const float ee = block_max(e, sh); if (t == 0) err_max(a.ws, 10, ee);
}
__global__ void __launch_bounds__(DBGK) dbg_snap(DArgs a, int salt) { const size_t tok = hsh(blockIdx.x * 29 + salt) % T; float* snap = DWS(float, WS_SMALL) + 65536 + (size_t)blockIdx.x * 1024; for (int j = 0; j < 4; ++j) snap[threadIdx.x + 256 * j] = a.out[tok * 1024 + threadIdx.x + 256 * j]; }
__global__ void __launch_bounds__(DBGK) chk_b6(DArgs a, int salt) {
    __shared__ float hrow[1024]; __shared__ float ov[1024]; __shared__ float sh[DBGK];
    const int t = threadIdx.x; const size_t tok = hsh(blockIdx.x * 29 + salt) % T; const float* snap = DWS(float, WS_SMALL) + 65536 + (size_t)blockIdx.x * 1024;
    ln_row(snap, a.in[I_LNG] + 2 * 1024, a.in[I_LNB] + 2 * 1024, hrow, sh);
    const bf16* OL = DWS(bf16, S_OL) + tok * 2048;
    for (int j = 0; j < 4; ++j) { const int c = t + 256 * j, h = c >> 7, v = c & 127; float o = 0.f; for (int r = 0; r < 256; ++r) o += bf2f(OL[h * 256 + r]) * a.in[I_BWUV][((size_t)h * 256 + r) * 128 + v]; ov[c] = o; }
    __syncthreads();
    float emax = 0.f, omax = 0.f;
    for (int j = 0; j < 4; ++j) { const int c = t + 256 * j; float o = 0.f; for (int k = 0; k < 1024; ++k) o += ov[k] * a.in[I_BWOUT][(size_t)k * 1024 + c]; const float ref = ALPHA * hrow[c] + o; emax = fmaxf(emax, fabsf(ref - a.out[tok * 1024 + c])); omax = fmaxf(omax, fabsf(o)); }
    const float e = block_max(emax, sh), o = block_max(omax, sh); if (t == 0) err_max(a.ws, 11, e / (o + 1e-20f));
}
__global__ void __launch_bounds__(DBGK) chk_m3(DArgs a, int salt) {
    __shared__ float hrow[1024]; __shared__ float sh[DBGK];
    const int t = threadIdx.x; const size_t tok = hsh(blockIdx.x * 29 + salt) % T; const float* snap = DWS(float, WS_SMALL) + 65536 + (size_t)blockIdx.x * 1024;
    ln_row(snap, a.in[I_LNG] + 1 * 1024, a.in[I_LNB] + 1 * 1024, hrow, sh);
    const int* pos2 = DWS(int, WS_POS2) + tok * 2; const bf16* Y = DWS(bf16, S_Y); float emax = 0.f, omax = 0.f;
    for (int j = 0; j < 4; ++j) { const int c = t + 256 * j; const float y = bf2f(Y[(size_t)pos2[0] * 1024 + c]) + bf2f(Y[(size_t)pos2[1] * 1024 + c]); emax = fmaxf(emax, fabsf(ALPHA * hrow[c] + y - a.out[tok * 1024 + c])); omax = fmaxf(omax, fabsf(y)); }
    const float e = block_max(emax, sh), o = block_max(omax, sh); if (t == 0) err_max(a.ws, 12, e / (o + 1e-20f));
}
__global__ void __launch_bounds__(DBGK) chk_attn(DArgs a) {
    __shared__ float sh[DBGK]; __shared__ float pm[DBGK];
    const int smp = blockIdx.x, t = threadIdx.x, b = smp & 7, hc = (smp >> 3) & 15; const int s = hsh(smp * 31 + 7) % SEQ; const size_t tok = (size_t)b * SEQ + s; const int n = ((s >> 6) + 1) * 64, c = hc & 1, h = hc >> 1;
    const bf16* Q = DWS(bf16, S_Q) + tok * 1024 + hc * 64; const bf16* K = DWS(bf16, S_K) + (size_t)b * SEQ * 1024 + hc * 64; const bf16* V = DWS(bf16, S_V) + (size_t)b * SEQ * 1024 + h * 128;
    const bf16* O = (c ? DWS(bf16, S_O1) : DWS(bf16, S_O0)) + tok * 1024 + h * 128;
    float m = -INFINITY; for (int k = t; k < n; k += DBGK) { float sc = 0.f; for (int d = 0; d < 64; ++d) sc += bf2f(Q[d]) * bf2f(K[(size_t)k * 1024 + d]); m = fmaxf(m, sc); }
    m = block_max(m, sh);
    float l = 0.f, o[128]; for (int d = 0; d < 128; ++d) o[d] = 0.f;
    float emax = 0.f, omax = 0.f;
    for (int d0 = 0; d0 < 128; d0 += 1) { float acc = 0.f, ll = 0.f; for (int k = t; k < n; k += DBGK) { float sc = 0.f; for (int d = 0; d < 64; ++d) sc += bf2f(Q[d]) * bf2f(K[(size_t)k * 1024 + d]); const float p = exp2f(sc - m); ll += p; acc += p * bf2f(V[(size_t)k * 1024 + d0]); }
        const float num = block_sum(acc, sh), den = block_sum(ll, sh); const float ref = num / den; emax = fmaxf(emax, fabsf(ref - bf2f(O[d0]))); omax = fmaxf(omax, fabsf(ref)); }
    (void)l; (void)o; (void)pm;
    if (t == 0) err_max(a.ws, 13, emax / (omax + 1e-20f));
}
__global__ void dbg_encode(DArgs a) {
    const float tol[16] = {0, 2e-3f, 0.03f, 0.03f, 0.03f, 0.03f, 0.03f, 1e-3f, 0.03f, 0.03f, 0.02f, 0.03f, 0.03f, 0.03f, 0, 0};
    const unsigned* err = (const unsigned*)(a.ws + WS_CTL) + CW_ERR; int bad = 0; float ev = 0.f;
#if MK_DBG >= 100
    bad = MK_DBG - 100; ev = __uint_as_float(err[bad]); const float f = 1.0f + fminf(100.f * (ev + 0.001f), 10.f);
#else
    for (int i = 1; i < 16; ++i) if (tol[i] > 0.f && __uint_as_float(err[i]) > tol[i]) { bad = i; break; }
    const float f = 1.0f + 0.1f * bad; (void)ev;
#endif
    for (size_t i = (size_t)blockIdx.x * blockDim.x + threadIdx.x; i < (size_t)T * D; i += (size_t)gridDim.x * blockDim.x) a.out[i] *= f;
}
static void dbg_after_phase(int p, const void* argsv, hipStream_t stream);
#define DBG_AFTER_PHASE(p) dbg_after_phase((p), (const void*)&a, stream)
#endif
struct XOrder {
    int vcu; long a_rt, a_h, b_b, b_h;
    __device__ bool next(int i, pg8::Unit& u) const {
        if (i >= 4) return false;
        const int idx = i * 32 + (vcu & 31), b = vcu >> 5, h = idx >> 5, rt = idx & 31;
        u.pm = b * 32 + rt; u.pn = h; u.e = 0; u.aoff = (long)(b * 32 + rt) * a_rt + h * a_h; u.boff = (long)b * b_b + (long)h * b_h; return true;
    }
};
struct MemOrder {
    int G, c;
    __device__ bool next(int i, pg8::Unit& u) const {
        const int L = i * G + c; if (L >= 64) return false;
        const int j = L >> 5, r = L & 31; u.e = j;
        u.pm = r >> 2; u.pn = r & 3; u.aoff = (long)WS_MEMB + (long)u.pm * 256 * 2048; u.boff = (long)W_MKV + (long)(j * 1024 + u.pn * 256) * 2048;
        return true;
    }
};
struct ProdOrder {
    int G, c, l;
    __device__ bool next(int i, pg8::Unit& u) const {
        const int L = i * G + c; if (L >= 256) return false;
        const int e = L >> 7, r = L & 127, t4 = r & 3, bh = r >> 2, b = bh >> 2, h = bh & 3; u.e = e;
        if (e == 0) { u.pm = bh; u.pn = t4; u.aoff = (long)WS_MK + ((long)b * 256 * 1024 + h * 256) * 2; u.boff = (long)W_XQ + (long)l * 2097152 + ((long)t4 * 256 * 1024 + h * 256) * 2; }
        else { u.pm = t4; u.pn = bh; u.aoff = (long)W_XO + (long)l * 2097152 + ((long)t4 * 256 * 1024 + h * 256) * 2; u.boff = (long)WS_MVT + ((long)b * 256 * 1024 + h * 256) * 2; }
        return true;
    }
};
struct XbOrder {
    int vcu; long b_b, b_pn;
    __device__ bool next(int i, pg8::Unit& u) const {
        if (i >= 4) return false;
        const int idx = i * 32 + (vcu & 31), b = vcu >> 5, rt = idx >> 2, pn = idx & 3;
        u.pm = b * 32 + rt; u.pn = pn; u.e = b; u.aoff = (long)u.pm * 256 * 1024 * 2; u.boff = (long)b * b_b + (long)pn * b_pn; return true;
    }
};
struct MoeOrderA : MoeOrder { long astride; __device__ bool next(int i, pg8::Unit& u) const { const bool ok = MoeOrder::next(i, u); if (ok) u.aoff = (long)u.pm * astride; return ok; } };

constexpr int NPH = 30;
struct Args { const float* in[N_IN]; float* out; unsigned char* ws; int ph_lo, ph_hi; };
static_assert(sizeof(Args) == (N_IN + 2) * 8 + 8, "Args has no holes");
extern __shared__ __attribute__((aligned(16))) unsigned char lds[];
__device__ __forceinline__ Frame make_frame(const int wave_s) {
    const CAS Args* a = (const CAS Args*)__builtin_amdgcn_kernarg_segment_ptr(); asm volatile("" : "+s"(a));
    Frame F;
    F.lds = (LAS unsigned char*)lds;
    F.MISC = (volatile LAS unsigned*)(F.lds + MISC_OFF);
    F.wave = wave_s;
    F.G = gridDim.x; { const int bx = blockIdx.x; F.vcu = (F.G % 8 == 0) ? (bx % 8) * (F.G / 8) + bx / 8 : bx; }
    F.ws = a->ws; F.ctl = (gu32*)(a->ws + WS_CTL); F.out = a->out;
    return F;
}
__device__ __forceinline__ void xattn_products(Frame& F, LAS unsigned char* ring, int l) {
    pg8::Gemm g{WSP(bf16, 0), WSP(bf16, 0), 1024, 1024, 256, nullptr}; ProdOrder S{F.G, F.vcu, l};
    epi::EpiMem E{WSP(bf16, S_WQK), (size_t)(S_WVO - S_WQK) / 2, 1024, 8192};
    pg8::gemm_phase<epi::EpiMem, ProdOrder>(ring, g, S, E, F.wave);
}
__device__ __forceinline__ void xattn_vectors(Frame& F, int l) {
    PHASE_IDS();
    const int gw = F.vcu * NWAVES + wave, NGW = F.G * NWAVES; float* dst = WSP(float, WS_SMALL) + SM_GWB; const float* bwq = WSP(float, WS_SMALL) + SM_GW + l * 2048 + 1024;
    for (int it = gw; it < 8192; it += NGW) { const int b = it >> 10, hm = it & 1023, h = hm >> 8, m = hm & 255;
        const bf16* wt = WSP(bf16, S_WQK) + (size_t)it * 1024;
        const v4u a = *(const GAS v4u*)(wt + lane * 16), c = *(const GAS v4u*)(wt + lane * 16 + 8);
        float sg = ((bflo(a.x) + bfhi(a.x)) + (bflo(a.y) + bfhi(a.y))) + ((bflo(a.z) + bfhi(a.z)) + (bflo(a.w) + bfhi(a.w))) + ((bflo(c.x) + bfhi(c.x)) + (bflo(c.y) + bfhi(c.y))) + ((bflo(c.z) + bfhi(c.z)) + (bflo(c.w) + bfhi(c.w)));
        const bf16* mk = WSP(bf16, WS_MK) + (size_t)(b * 256 + m) * 1024 + h * 256; const v2u kv = *(const GAS v2u*)(mk + 4 * lane); const f32x4 bq = *(const f32x4*)(bwq + h * 256 + 4 * lane);
        float sb = (bflo(kv.x) * bq[0] + bfhi(kv.x) * bq[1]) + (bflo(kv.y) * bq[2] + bfhi(kv.y) * bq[3]);
        sg = wave_sum(sg); sb = wave_sum(sb);
        if (lane == 0) { dst[it] = sg; dst[8192 + it] = sb; } }
}
template <int LO, int HI, int layer> __device__ __forceinline__ void layer_phases(const int wave_s);
template <int LO, int HI> __device__ __forceinline__ void run_phases(const int wave_s) {
    constexpr int lo = LO, hi = HI;
#ifndef MK_PHMASK
#define MK_PHMASK 0x3fffffffull
#endif
#define IN(k) (((MK_PHMASK >> ((k) < 14 ? (k) : ((k) >= 21 ? (k) - 16 : (k)))) & 1ull) && lo <= (k) && (k) < hi)
#ifndef MK_REP
#define MK_REP 0ull
#endif
#define REPS(k) (1 + (int)((MK_REP >> ((k) < 14 ? (k) : ((k) >= 21 ? (k) - 16 : (k)))) & 1ull))
#define SEAM(k) do { if (IN((k) + 1)) { XcdBarrier bar_; bar_.bar = (unsigned*)(F.ctl + CW_BAR); bar_.x = xb_xcc_id(); bar_.st = F.MISC + 8; bar_.wave = wave_s; xcd_barrier(bar_); } } while (0)
#define PRE (F.out)
#define PREB WSP(bf16, WS_PREB)
#define STAT0 WSP(float, WS_STAT)
#define STAT1 (WSP(float, WS_STAT) + (size_t)T * 32)
#define SMALL WSP(float, WS_SMALL)
#define PH_BEGIN() Frame F = make_frame(wave_s); LAS unsigned char* ring = F.lds + RING_OFF; const int bx = (int)blockIdx.x; (void)ring; (void)bx

    if (IN(0)) { PH_BEGIN(); for (int rep_ = 0; rep_ < REPS(0); ++rep_) { p0_prologue(F); } SEAM(0); }

    if constexpr (hi > 1 && lo < 14) layer_phases<LO, HI, 0>(wave_s);
    if constexpr (hi > 14) layer_phases<LO, HI, 1>(wave_s);
}
template <int LO, int HI, int layer> __device__ __forceinline__ void layer_phases(const int wave_s) {
    constexpr int lo = LO, hi = HI;
    {
        if constexpr (layer == 0) {
            if (IN(1)) { PH_BEGIN(); for (int rep_ = 0; rep_ < REPS(1); ++rep_) {
                { pg8::Gemm g{WSP(bf16, S_XB), WSP(bf16, W_QKV), 1024, 1024, 1024, nullptr}; pg8::StaticOrder S; S.init(T, 3072, 1024, 1024, F.G, bx);
                  epi::EpiHeads64 E{WSP(bf16, S_Q), (size_t)(S_K - S_Q) / 2, 2, WSP(float, WS_ROT16)};
                  static_assert(S_V - S_K == S_K - S_Q, "Q, K, V arrays at one stride");
                  pg8::gemm_phase<epi::EpiHeads64, pg8::StaticOrder>(ring, g, S, E, F.wave); }
                {
                  pg8::Gemm g{WSP(bf16, 0), WSP(bf16, 0), 1024, 1024, 1024, nullptr}; MemOrder S{F.G, F.vcu};
                  epi::EpiMem E{WSP(bf16, WS_MK), (size_t)(WS_MVT - WS_MK) / 2, 1024, 1024};
                  pg8::gemm_phase<epi::EpiMem, MemOrder>(ring, g, S, E, F.wave); }
                fold_vectors(F);
                } SEAM(1); }
            if (IN(2)) { PH_BEGIN(); for (int rep_ = 0; rep_ < REPS(2); ++rep_) {
                const attn_body::AttnTensors AT{(const attn_body::bf16*)WSP(bf16, S_Q), (const attn_body::bf16*)WSP(bf16, S_K), (const attn_body::bf16*)WSP(bf16, S_V), (attn_body::bf16*)WSP(bf16, S_O0), (attn_body::bf16*)WSP(bf16, S_O1)};
                attn_body::attn_phase<8>((char*)lds + RING_OFF, AT, F.vcu, F.wave);
                } SEAM(2); }
            if (IN(3)) { PH_BEGIN(); for (int rep_ = 0; rep_ < REPS(3); ++rep_) { diff_combine(F); xattn_products(F, ring, 0); } SEAM(3); }
            if (IN(4)) { PH_BEGIN(); for (int rep_ = 0; rep_ < REPS(4); ++rep_) {
                pg8::Gemm g{WSP(bf16, S_ON), WSP(bf16, W_O), 1024, 1024, 1024, nullptr}; pg8::StaticOrder S; S.init(T, 1024, 1024, 1024, F.G, bx);
                epi::EpiPre<0> E{ld_in(I_X), PRE, PREB, nullptr, STAT0, nullptr, nullptr};
                pg8::gemm_phase<epi::EpiPre<0>, pg8::StaticOrder>(ring, g, S, E, F.wave);
                xattn_vectors(F, 0);
                } SEAM(4); }
        } else {
            if (IN(14)) { PH_BEGIN(); for (int rep_ = 0; rep_ < REPS(14); ++rep_) {
                pg8::Gemm g{PREB, WSP(bf16, W_BIN), 1024, 1024, 1024, nullptr}; pg8::StaticOrder S; S.init(T, BIN_LD, 1024, 1024, F.G, bx);
                epi::EpiFold<false> E{STAT0, SMALL + SM_GW + 2 * 2048, SMALL + SM_GW + 2 * 2048 + 1024, WSP(bf16, S_BIN), BIN_LD};
                pg8::gemm_phase<epi::EpiFold<false>, pg8::StaticOrder>(ring, g, S, E, F.wave);
                } SEAM(14); }
            if (IN(15)) { PH_BEGIN(); for (int rep_ = 0; rep_ < REPS(15); ++rep_) { dsa_prep(F); xattn_products(F, ring, 1); } SEAM(15); }
            if (IN(16)) { PH_BEGIN(); for (int rep_ = 0; rep_ < REPS(16); ++rep_) {
                pg8::Gemm g{WSP(bf16, S_CQ), WSP(bf16, W_Q2) + 2304 * 256, 256, 256, 256, nullptr}; pg8::StaticOrder S; S.init(T, 1024, 256, 256, F.G, bx);
                epi::EpiHeads64 E{WSP(bf16, S_QI), 0, 1, WSP(float, WS_ROT16)};
                pg8::gemm_phase<epi::EpiHeads64, pg8::StaticOrder>(ring, g, S, E, F.wave);
                xattn_vectors(F, 1);
                } SEAM(16); }
            if (IN(17)) { PH_BEGIN(); for (int rep_ = 0; rep_ < REPS(17); ++rep_) { dsa_index(F); } SEAM(17); }
            if (IN(18)) { PH_BEGIN(); for (int rep_ = 0; rep_ < REPS(18); ++rep_) {
                pg8::Gemm g{WSP(bf16, S_CQ), WSP(bf16, W_Q2), 256, 256, 256, nullptr}; pg8::StaticOrder S; S.init(T, 2304, 256, 256, F.G, bx);
                epi::EpiQfull E{WSP(bf16, S_QF), WSP(float, WS_ROT32)};
                pg8::gemm_phase<epi::EpiQfull, pg8::StaticOrder>(ring, g, S, E, F.wave);
                } SEAM(18); }
            if (IN(19)) { PH_BEGIN(); for (int rep_ = 0; rep_ < REPS(19); ++rep_) { sparse_attn(F); } SEAM(19); }
            if (IN(20)) { PH_BEGIN(); for (int rep_ = 0; rep_ < REPS(20); ++rep_) {
                pg8::Gemm g{WSP(bf16, S_OL), WSP(bf16, W_UVO), 2048, 2048, 2048, nullptr}; pg8::StaticOrder S; S.init(T, 1024, 2048, 2048, F.G, bx);
                epi::EpiPre<1> E{PRE, PRE, PREB, STAT0, STAT1, ld_in(I_LNG) + 2 * 1024, ld_in(I_LNB) + 2 * 1024};
                pg8::gemm_phase<epi::EpiPre<1>, pg8::StaticOrder>(ring, g, S, E, F.wave);
                } SEAM(20); }
        }
        constexpr int px = layer == 0 ? 5 : 21;
#define st_mix (WSP(float, WS_STAT) + (size_t)(layer == 0 ? 0 : 1) * T * 32)
#define st_x (WSP(float, WS_STAT) + (size_t)(layer == 0 ? 1 : 0) * T * 32)
        if (IN(px)) { PH_BEGIN(); for (int rep_ = 0; rep_ < REPS(px); ++rep_) {
            pg8::Gemm g{PREB, WSP(bf16, S_WQK), 1024, 1024, 1024, nullptr};
            XbOrder S{F.vcu, 2097152L, 256L * 1024 * 2};
            epi::EpiFoldSoftmax E{st_mix, SMALL + SM_GWB, SMALL + SM_GWB + 8192, WSP(bf16, S_P), (LAS float*)(F.lds + XCH_OFF)};
            pg8::gemm_phase<epi::EpiFoldSoftmax, XbOrder>(ring, g, S, E, F.wave);
            } SEAM(px); }
        if (IN(px + 1)) { PH_BEGIN(); for (int rep_ = 0; rep_ < REPS(px + 1); ++rep_) {
            pg8::Gemm g{WSP(bf16, S_P), WSP(bf16, S_WVO), 1024, 8192, 1024, nullptr};
            XbOrder S{F.vcu, 1024L * 2, 256L * 8192 * 2};
            epi::EpiPre<1, false> E{PRE, PRE, PREB, st_mix, st_x, ld_in(I_LNG) + (layer * 3 + 0) * 1024, ld_in(I_LNB) + (layer * 3 + 0) * 1024};
            pg8::gemm_phase<epi::EpiPre<1, false>, XbOrder>(ring, g, S, E, F.wave);
            } SEAM(px + 3); }
        if (IN(px + 4)) { PH_BEGIN(); for (int rep_ = 0; rep_ < REPS(px + 4); ++rep_) { moe_route(F, layer); } SEAM(px + 4); }
        if (IN(px + 5)) { PH_BEGIN(); for (int rep_ = 0; rep_ < REPS(px + 5); ++rep_) { moe_index(F, layer); } SEAM(px + 5); }
        if (IN(px + 6)) { PH_BEGIN(); for (int rep_ = 0; rep_ < REPS(px + 6); ++rep_) {
            const int* tile_e = WSP(int, WS_TILEE);
            pg8::Gemm g{WSP(bf16, S_XH), WSP(bf16, W_GU) + (size_t)layer * 16 * 1048576, 1024, 1024, 1024, WSP(int, WS_ROWIDX)};
            MoeOrder S{tile_e, tile_e[0], F.G, F.vcu, 2L * 1048576, 4};
            epi::EpiGateUp E{WSP(bf16, S_HID)};
            pg8::gemm_phase<epi::EpiGateUp, MoeOrder, true>(ring, g, S, E, F.wave);
            } SEAM(px + 6); }
        if (IN(px + 7)) { PH_BEGIN(); for (int rep_ = 0; rep_ < REPS(px + 7); ++rep_) {
            const int* tile_e = WSP(int, WS_TILEE);
            pg8::Gemm g{WSP(bf16, S_HID), WSP(bf16, W_DN) + (size_t)layer * 16 * 524288, 512, 512, 512, nullptr};
            MoeOrderA S; S.tile_e = tile_e; S.ntiles = tile_e[0]; S.G = F.G; S.c = F.vcu; S.wstride = 1048576L; S.nn = 4; S.astride = 256L * 512 * 2;
            epi::EpiDown E{WSP(bf16, S_Y), WSP(float, WS_WSORT)};
            pg8::gemm_phase<epi::EpiDown, MoeOrderA>(ring, g, S, E, F.wave);
            } SEAM(px + 7); }
        if (IN(px + 8)) { PH_BEGIN(); for (int rep_ = 0; rep_ < REPS(px + 8); ++rep_) { moe_combine(F, layer); } if (layer == 0) SEAM(px + 8); }
    }
#undef IN
#undef SEAM
}
template <int LO, int HI> __global__ void __launch_bounds__(NWAVES * 64, 2) fwd(Args args) {
    const int wave_s = __builtin_amdgcn_readfirstlane((int)threadIdx.x >> 6);
    if constexpr (HI - LO > 1) {
        Frame F = make_frame(wave_s);
        if (wave_s == 0) ((LAS unsigned*)(F.lds + MISC_OFF))[__builtin_amdgcn_mbcnt_hi(~0u, __builtin_amdgcn_mbcnt_lo(~0u, 0u))] = 0u;
        __syncthreads();
        (void)xcd_barrier_post((unsigned*)(F.ctl + CW_BAR), F.MISC + 8, wave_s);
    }
    run_phases<LO, HI>(wave_s);
}

#if MK_DBG
static void dbg_after_phase(int p, const void* argsv, hipStream_t stream) {
    const Args& A = *(const Args*)argsv; DArgs a{}; for (int i = 0; i < N_IN; ++i) a.in[i] = A.in[i]; a.out = A.out; a.ws = A.ws; a.layer = p >= 14 ? 1 : 0; a.pad = 0;
    const dim3 g(64), b(DBGK);
    if (p == 2) hipLaunchKernelGGL(chk_attn, g, b, 0, stream, a);
    if (p == 14) hipLaunchKernelGGL(chk_fold, g, b, 0, stream, a, 1);
    if (p == 15) hipLaunchKernelGGL(chk_prep, g, b, 0, stream, a);
    if (p == 17) hipLaunchKernelGGL(chk_topk, g, b, 0, stream, a);
    if (p == 18) hipLaunchKernelGGL(chk_q2, g, b, 0, stream, a);
    if (p == 19) { hipLaunchKernelGGL(chk_sparse, g, b, 0, stream, a); hipLaunchKernelGGL(dbg_snap, g, b, 0, stream, a, 101); }
    if (p == 20) hipLaunchKernelGGL(chk_b6, g, b, 0, stream, a, 101);
    if (p == 5 || p == 21) { hipLaunchKernelGGL(chk_x1p, g, b, 0, stream, a); hipLaunchKernelGGL(dbg_snap, g, b, 0, stream, a, 303); }
    if (p == 6 || p == 22) hipLaunchKernelGGL(chk_x4p, g, b, 0, stream, a, 303);
    if (p == 12 || p == 28) { hipLaunchKernelGGL(chk_moe, g, b, 0, stream, a); if (p == 12) hipLaunchKernelGGL(dbg_snap, g, b, 0, stream, a, 202); }
    if (p == 13) hipLaunchKernelGGL(chk_m3, g, b, 0, stream, a, 202);
    if (p == NPH - 1) hipLaunchKernelGGL(dbg_encode, dim3(2048), dim3(256), 0, stream, a);
}
#endif
#if MK_PER_PHASE
template <int P> static void launch_phases(int grid, hipStream_t stream, Args a) {
    if constexpr (P < NPH) {
        static bool once = false; if (!once) { once = true; (void)hipFuncSetAttribute((const void*)fwd<P, P + 1>, hipFuncAttributeMaxDynamicSharedMemorySize, LDS_BYTES); }
        a.ph_lo = P; a.ph_hi = P + 1; hipLaunchKernelGGL((fwd<P, P + 1>), dim3(grid), dim3(NWAVES * 64), LDS_BYTES, stream, a); DBG_AFTER_PHASE(P);
        launch_phases<P + 1>(grid, stream, a);
    }
}
#endif
extern "C" void kernel_launch(void* const* d_in, const int* in_sizes, int n_in, void* d_out, int out_size, void* d_ws, size_t ws_size, hipStream_t stream) {
    static int grid = 0;
    if (grid == 0) {
        if (n_in != N_IN || in_sizes[0] != T * D || out_size != T * D || ws_size < WS_END) { fprintf(stderr, "kernel_launch: shape / workspace mismatch (n_in %d, in0 %d, out %d, ws %zu); nothing launched\n", n_in, n_in > 0 ? in_sizes[0] : -1, out_size, ws_size); grid = -1; return; }
#if !MK_PER_PHASE
        if (hipFuncSetAttribute((const void*)fwd<0, NPH>, hipFuncAttributeMaxDynamicSharedMemorySize, LDS_BYTES) != hipSuccess) { fprintf(stderr, "kernel_launch: hipFuncSetAttribute failed\n"); grid = -1; return; }
        int per_cu = 0;
        if (hipOccupancyMaxActiveBlocksPerMultiprocessor(&per_cu, (const void*)fwd<0, NPH>, NWAVES * 64, LDS_BYTES) != hipSuccess || per_cu < 1) fprintf(stderr, "kernel_launch: note: occupancy query reports %d workgroups per CU\n", per_cu);
        (void)hipGetLastError();
#endif
        grid = 256;
    }
    if (grid < 0) return;
    if (hipMemsetAsync((char*)d_ws + WS_CTL, 0, CTL_ZERO_BYTES, stream) != hipSuccess) { fprintf(stderr, "kernel_launch: hipMemsetAsync failed\n"); return; }
    Args a{};
    for (int i = 0; i < N_IN; ++i) a.in[i] = (const float*)d_in[i];
    a.out = (float*)d_out; a.ws = (unsigned char*)d_ws;
#if MK_PER_PHASE
    launch_phases<0>(grid, stream, a);
#else
    a.ph_lo = 0; a.ph_hi = NPH; hipLaunchKernelGGL((fwd<0, NPH>), dim3(grid), dim3(NWAVES * 64), LDS_BYTES, stream, a);
#endif
    const hipError_t le = hipPeekAtLastError();
    if (le != hipSuccess) fprintf(stderr, "kernel_launch: launch failed: %s\n", hipGetErrorName(le));
}
```
